# Optimizing an MI355X kernel written in HIP

```python
import jax, jax.numpy as jnp
from jax import lax
import numpy as np

D_MODEL = 1024
BATCH = 4
SEQ = 4096
DEPTH = 1

SB_HEADS = 8
SB_HEAD_DIM = 64
SB_WIDTH = SB_HEADS * SB_HEAD_DIM
CONV_CHANNELS = 512
CONV_WIDTH = 3
MEM_TOKENS = 256
MEM_HEADS = 4
MEM_HEAD_DIM = 128
MEM_WIDTH = MEM_HEADS * MEM_HEAD_DIM
N_BRANCHES = 3
N_EXPERTS = 32
TOP_K = 4
D_FF_EXPERT = 1024
SWIGLU_LIMIT = 7.0
SWIGLU_ALPHA = 1.702
Q_BLOCK = 128
MOE_BLOCK = 128
RMS_EPS = 1e-6

IN_PARTS = (SB_WIDTH, SB_WIDTH, SB_WIDTH,
            CONV_CHANNELS, CONV_CHANNELS, CONV_CHANNELS,
            MEM_WIDTH, N_BRANCHES * D_MODEL)
IN_WIDTH = sum(IN_PARTS)
IN_SPLITS = tuple(int(v) for v in np.cumsum(IN_PARTS)[:-1])

kernel_name = "hybrid_stickbreak_shortconv_memattn_moe"


def rms_norm(x, g):
    xf = x.astype(jnp.float32)
    y = xf * lax.rsqrt(jnp.mean(xf * xf, axis=-1, keepdims=True) + RMS_EPS)
    return (y * g.astype(jnp.float32)).astype(x.dtype)


def stick_breaking_attention(q, k, v):
    b, s, h, dh = q.shape
    nb = s // Q_BLOCK
    scale = dh ** -0.5
    kt = k.transpose(0, 2, 1, 3).astype(jnp.float32)
    vt = v.transpose(0, 2, 1, 3).astype(jnp.float32)
    qb = q.reshape(b, nb, Q_BLOCK, h, dh).transpose(1, 0, 3, 2, 4)
    key_pos = jnp.arange(s)

    def block(args):
        q_blk, blk = args
        z = jnp.einsum('bhqd,bhkd->bhqk', q_blk.astype(jnp.float32), kt) * scale
        q_pos = blk * Q_BLOCK + jnp.arange(Q_BLOCK)
        causal = key_pos[None, :] < q_pos[:, None]
        log_stay = jnp.where(causal, jax.nn.log_sigmoid(-z), 0.0)
        log_between = lax.cumsum(log_stay, axis=3, reverse=True) - log_stay
        w = jnp.where(causal, jnp.exp(jax.nn.log_sigmoid(z) + log_between), 0.0)
        return jnp.einsum('bhqk,bhkd->bhqd', w, vt)

    o = lax.map(block, (qb, jnp.arange(nb)))
    return o.transpose(1, 0, 3, 2, 4).reshape(b, s, h * dh).astype(q.dtype)


def short_gated_conv(u_b, u_c, u_x, conv_w):
    c = u_x.shape[-1]
    u = u_c * u_x
    z = lax.conv_general_dilated(
        u, conv_w[:, None, :].astype(u.dtype), window_strides=(1,),
        padding=[(CONV_WIDTH - 1, 0)], dimension_numbers=('NWC', 'WIO', 'NWC'),
        feature_group_count=c)
    return u_b * z


def memory_attention(q, mem_n, w_mem_kv, q_g, k_g):
    b, s, _ = q.shape
    m = mem_n.shape[1]
    kv = mem_n @ w_mem_kv
    k, v = jnp.split(kv, 2, axis=-1)
    q = rms_norm(q.reshape(b, s, MEM_HEADS, MEM_HEAD_DIM), q_g)
    k = rms_norm(k.reshape(b, m, MEM_HEADS, MEM_HEAD_DIM), k_g)
    v = v.reshape(b, m, MEM_HEADS, MEM_HEAD_DIM)
    sc = jnp.einsum('bshd,bmhd->bhsm', q.astype(jnp.float32), k.astype(jnp.float32)) * (MEM_HEAD_DIM ** -0.5)
    p = jax.nn.softmax(sc, axis=-1)
    o = jnp.einsum('bhsm,bmhd->bshd', p, v.astype(jnp.float32))
    return o.reshape(b, s, MEM_WIDTH).astype(q.dtype)


def moe_ffn(h, w_router, b_router, w_gate_up, b_gate_up, w_down, b_down):
    t, d = h.shape
    a = t * TOP_K
    logits = (h @ w_router + b_router).astype(jnp.float32)
    top_val, top_idx = lax.top_k(logits, TOP_K)
    gate = jax.nn.softmax(top_val, axis=-1)
    flat_e = top_idx.reshape(a)
    flat_tok = jnp.arange(a) // TOP_K
    order = jnp.argsort(flat_e, stable=True)
    e_sorted = flat_e[order]
    counts = jnp.bincount(flat_e, length=N_EXPERTS)
    padded = (counts + MOE_BLOCK - 1) // MOE_BLOCK * MOE_BLOCK
    start = jnp.cumsum(counts) - counts
    pend = jnp.cumsum(padded)
    pstart = pend - padded
    dest = pstart[e_sorted] + (jnp.arange(a) - start[e_sorted])
    n_blocks = -(-a // MOE_BLOCK) + N_EXPERTS
    n_rows = n_blocks * MOE_BLOCK
    x_pad = jnp.zeros((n_rows, d), h.dtype).at[dest].set(h[flat_tok[order]])
    block_e = jnp.clip(jnp.searchsorted(pend, jnp.arange(n_blocks) * MOE_BLOCK, side='right'), 0, N_EXPERTS - 1)

    def expert_block(args):
        xb, e = args
        gu = xb @ w_gate_up[e] + b_gate_up[e]
        g, lin = jnp.split(gu, 2, axis=-1)
        g = jnp.minimum(g, SWIGLU_LIMIT)
        lin = jnp.clip(lin, -SWIGLU_LIMIT, SWIGLU_LIMIT)
        act = g * jax.nn.sigmoid(SWIGLU_ALPHA * g) * (lin + 1.0)
        return act @ w_down[e] + b_down[e]

    y_pad = lax.map(expert_block, (x_pad.reshape(n_blocks, MOE_BLOCK, d), block_e)).reshape(n_rows, d)
    y_assign = jnp.zeros((a, d), y_pad.dtype).at[order].set(y_pad[dest]).reshape(t, TOP_K, d)
    return jnp.einsum('tk,tkd->td', gate.astype(y_assign.dtype), y_assign)


def setup_inputs(seed: int = 0) -> dict:
    key = jax.random.key(seed)
    ks = jax.random.split(key, 24)
    f32 = jnp.float32
    nrm = lambda k, shape, s: jax.random.normal(k, shape, f32) * s
    gain = lambda k, shape: 1.0 + 0.02 * jax.random.normal(k, shape, f32)
    L, D, E, F = DEPTH, D_MODEL, N_EXPERTS, D_FF_EXPERT
    return {
        "x": nrm(ks[0], (BATCH, SEQ, D), 1.0),
        "mem": nrm(ks[1], (BATCH, MEM_TOKENS, D), 1.0),
        "mix_norm_g": gain(ks[2], (L, D)),
        "w_in": nrm(ks[3], (L, D, IN_WIDTH), D ** -0.5),
        "sb_q_norm_g": gain(ks[4], (L, SB_HEAD_DIM)),
        "sb_k_norm_g": gain(ks[5], (L, SB_HEAD_DIM)),
        "conv_w": nrm(ks[6], (L, CONV_WIDTH, CONV_CHANNELS), CONV_WIDTH ** -0.5),
        "mem_norm_g": gain(ks[7], (L, D)),
        "w_mem_kv": nrm(ks[8], (L, D, 2 * MEM_WIDTH), D ** -0.5),
        "mem_q_norm_g": gain(ks[9], (L, MEM_HEAD_DIM)),
        "mem_k_norm_g": gain(ks[10], (L, MEM_HEAD_DIM)),
        "w_br_sb": nrm(ks[11], (L, SB_WIDTH, D), SB_WIDTH ** -0.5),
        "w_br_conv": nrm(ks[12], (L, CONV_CHANNELS, D), CONV_CHANNELS ** -0.5),
        "w_br_mem": nrm(ks[13], (L, MEM_WIDTH, D), MEM_WIDTH ** -0.5),
        "w_o": nrm(ks[14], (L, D, D), D ** -0.5),
        "ffn_norm_g": gain(ks[15], (L, D)),
        "w_router": nrm(ks[16], (L, D, E), D ** -0.5),
        "b_router": nrm(ks[17], (L, E), 0.01),
        "w_gate_up": nrm(ks[18], (L, E, D, 2 * F), D ** -0.5),
        "b_gate_up": nrm(ks[19], (L, E, 2 * F), 0.01),
        "w_down": nrm(ks[20], (L, E, F, D), F ** -0.5),
        "b_down": nrm(ks[21], (L, E, D), 0.01),
    }


def reference(x, mem, mix_norm_g, w_in, sb_q_norm_g, sb_k_norm_g, conv_w, mem_norm_g,
              w_mem_kv, mem_q_norm_g, mem_k_norm_g, w_br_sb, w_br_conv, w_br_mem, w_o,
              ffn_norm_g, w_router, b_router, w_gate_up, b_gate_up, w_down, b_down):
    b, s, d = x.shape
    for l in range(DEPTH):
        h = rms_norm(x, mix_norm_g[l])
        proj = h @ w_in[l]
        q_sb, k_sb, v_sb, cb, cc, cx, q_mem, gates = jnp.split(proj, IN_SPLITS, axis=-1)
        q_sb = rms_norm(q_sb.reshape(b, s, SB_HEADS, SB_HEAD_DIM), sb_q_norm_g[l])
        k_sb = rms_norm(k_sb.reshape(b, s, SB_HEADS, SB_HEAD_DIM), sb_k_norm_g[l])
        v_sb = v_sb.reshape(b, s, SB_HEADS, SB_HEAD_DIM)
        o_sb = stick_breaking_attention(q_sb, k_sb, v_sb)
        o_conv = short_gated_conv(cb, cc, cx, conv_w[l])
        mem_n = rms_norm(mem, mem_norm_g[l])
        o_mem = memory_attention(q_mem, mem_n, w_mem_kv[l], mem_q_norm_g[l], mem_k_norm_g[l])
        g = jax.nn.sigmoid(gates.reshape(b, s, N_BRANCHES, d))
        merged = (g[:, :, 0] * (o_sb @ w_br_sb[l])
                  + g[:, :, 1] * (o_conv @ w_br_conv[l])
                  + g[:, :, 2] * (o_mem @ w_br_mem[l]))
        x = x + merged @ w_o[l]
        hf = rms_norm(x, ffn_norm_g[l]).reshape(b * s, d)
        y = moe_ffn(hf, w_router[l], b_router[l], w_gate_up[l], b_gate_up[l], w_down[l], b_down[l])
        x = x + y.reshape(b, s, d).astype(x.dtype)
    return x
```

```cpp
#include <hip/hip_runtime.h>
#include <cstdio>
#include <cstdint>
namespace pg8 {
#define PG8_LAS __attribute__((address_space(3)))
typedef unsigned short bf16_t;
typedef short bf16x8 __attribute__((ext_vector_type(8)));
typedef float f32x4 __attribute__((ext_vector_type(4)));
typedef unsigned u32x4 __attribute__((ext_vector_type(4)));
constexpr int BM = 256, BK = 64, HALF = 128, HTB = HALF * BK * 2  , STAGE_BYTES = 8 * HTB, NXCD = 8, WGM = 8;

__host__ __device__ __forceinline__ int lds_byte(int r, int c) { const int st = (r >> 4) * 2 + (c >> 5), rr = r & 15, cc = c & 31, ob = rr * 64 + cc * 2; return st * 1024 + (ob ^ (((ob >> 9) & 1) << 5)); }
__host__ __device__ __forceinline__ void stage_rc(int b, int& R, int& C) { const int st = b / 1024, sb = b % 1024, swz = sb ^ (((sb >> 9) & 1) << 5); R = (st >> 1) * 16 + swz / 64; C = (st & 1) * 32 + (swz % 64) / 2; }
__host__ __device__ __forceinline__ int perm32(int rho) { const int n = rho >> 4, i = rho & 15; return 8 * (i >> 2) + 4 * n + (i & 3); }

struct Unit { int pm, pn; };
struct Gemm { const bf16_t* A; const bf16_t* Bt; int M, N, K; };

struct StaticOrder {
    int nM, nN, nwg, G, c;
    __host__ __device__ void init(int M, int N, int G_, int c_) { nM = M / BM; nN = N / BM; nwg = nM * nN; G = G_; c = c_; }
    __host__ __device__ bool next(int i, Unit& u) const {
        const long L = (long)i * G + c; if (L >= nwg) return false;
        int wgid = (int)L; { const int q = nwg / NXCD, r = nwg % NXCD, xcd = wgid % NXCD, off = wgid / NXCD; wgid = (xcd < r ? xcd * (q + 1) : r * (q + 1) + (xcd - r) * q) + off; }
        const int nig = WGM * nN, gid = wgid / nig, fm = gid * WGM, gsz = (nM - fm) < WGM ? (nM - fm) : WGM;
        u.pm = fm + ((wgid % nig) % gsz); u.pn = (wgid % nig) / gsz; return true;
    }
    __device__ __forceinline__ void a_ready(const Unit&) const {}
    __device__ __forceinline__ void done(const Unit&) const {}
};

__device__ __forceinline__ unsigned cvt_pk_bf16(float lo, float hi) { unsigned r; asm volatile("v_cvt_pk_bf16_f32 %0, %1, %2" : "=v"(r) : "v"(lo), "v"(hi)); return r; }
typedef float f32x2 __attribute__((ext_vector_type(2)));
__device__ __forceinline__ f32x2 gelu_pk(f32x2 v) {
    const f32x2 av = __builtin_elementwise_abs(v), d = av * 0.2316418882f + 1.0f;
    f32x2 t; t.x = __builtin_amdgcn_rcpf(d.x); t.y = __builtin_amdgcn_rcpf(d.y);
    f32x2 q = t * 0.5307027145f + (-0.7265760135f); q = q * t + 0.7107068705f; q = q * t + (-0.142248368f); q = q * t + 0.127414796f; q = q * t;
    const f32x2 s = (v * v) * (-0.72134752044f);
    f32x2 e; e.x = __builtin_amdgcn_exp2f(s.x); e.y = __builtin_amdgcn_exp2f(s.y);
    const f32x2 m = v * (q * e), r = v - m;
    f32x2 o; o.x = v.x < 0.f ? m.x : r.x; o.y = v.y < 0.f ? m.y : r.y; return o;
}

template <int ACT  > struct EpiBf16 {
    static constexpr bool PERM = true, AFTER_DRAIN = false; static_assert(ACT == 0 || ACT == 1, "EpiBf16: ACT is 0 (none) or 1 (gelu_pk)");
    bf16_t* O; int ldc; const float* bias; int split_cols; size_t split_stride; float scale0;
    __device__ __forceinline__ void operator()(const f32x4 (&acc)[2][2][4][2], const Unit& u, int wr, int wc, int fr, int fq) const {
        const int row0 = u.pm * BM + wr * 64 + fr; int colt = u.pn * BM; bf16_t* base = O;
        float sc = 1.f; if (split_cols) { const int t = colt / split_cols; base += (size_t)t * split_stride; colt -= t * split_cols; if (t == 0) sc = scale0; }
        const int col0 = colt + wc * 32 + 8 * fq, bcol0 = u.pn * BM + wc * 32 + 8 * fq;
        f32x4 bv[2][2];
#pragma unroll
        for (int bj = 0; bj < 2; ++bj)
#pragma unroll
            for (int n = 0; n < 2; ++n) bv[bj][n] = bias ? *(const f32x4*)(bias + bcol0 + bj * HALF + 4 * n) : (f32x4){0.f, 0.f, 0.f, 0.f};
#pragma unroll
        for (int ai = 0; ai < 2; ++ai)
#pragma unroll
            for (int m = 0; m < 4; ++m) { bf16_t* rowp = base + (size_t)(row0 + ai * HALF + m * 16) * ldc + col0;
#pragma unroll
                for (int bj = 0; bj < 2; ++bj) { f32x4 v0 = acc[ai][bj][m][0] + bv[bj][0], v1 = acc[ai][bj][m][1] + bv[bj][1];
                    if (ACT == 1) { f32x2 a = gelu_pk((f32x2){v0[0], v0[1]}), b = gelu_pk((f32x2){v0[2], v0[3]}), c = gelu_pk((f32x2){v1[0], v1[1]}), d = gelu_pk((f32x2){v1[2], v1[3]});
                        v0 = (f32x4){a.x, a.y, b.x, b.y}; v1 = (f32x4){c.x, c.y, d.x, d.y}; }
                    v0 = v0 * sc; v1 = v1 * sc; u32x4 w; w.x = cvt_pk_bf16(v0[0], v0[1]); w.y = cvt_pk_bf16(v0[2], v0[3]); w.z = cvt_pk_bf16(v1[0], v1[1]); w.w = cvt_pk_bf16(v1[2], v1[3]);
                    *(u32x4*)(rowp + bj * HALF) = w; } }
    }
};
template <class Epi, class Sched, bool ALIGN_EPI = false, bool SP2 = false>
__device__ __forceinline__ void gemm_phase(PG8_LAS unsigned char* lds, const Gemm g, const Sched& S, const Epi& E) {
    const int tid = threadIdx.x, wid = __builtin_amdgcn_readfirstlane(tid >> 6), lane = tid & 63, wr = wid >> 2, wc = wid & 3, fr = lane & 15, fq = lane >> 4;
    const int K = g.K, nt = K / BK;
    unsigned voffA[2], voffB[2];
#pragma unroll
    for (int i = 0; i < 2; ++i) { int R, C; stage_rc(tid * 16 + i * 8192, R, C); const int Rb = Epi::PERM ? ((R & ~31) + perm32(R & 31)) : R;
        voffA[i] = (unsigned)(R * K + C) * 2u; voffB[i] = (unsigned)(Rb * K + C) * 2u; }
    const size_t kstep = (size_t)(BK * 2);
    const size_t hstep = (size_t)HALF * K * 2;
    const size_t tstep = 2 * hstep;
    const unsigned ldsw = (unsigned)wid * 1024u;
    const int aoff = lds_byte(wr * 64 + fr, fq * 8), boff = lds_byte(wc * 32 + fr, fq * 8);
#define PG8_SA(b, h) (((b) * 2 + (h)) * HTB)
#define PG8_SB(b, h) ((4 + (b) * 2 + (h)) * HTB)
#define PG8_STAGE(bufoff, gbase, voff) do { _Pragma("unroll") for (int _i = 0; _i < 2; ++_i) \
        __builtin_amdgcn_global_load_lds((const unsigned*)((const char*)(gbase) + (voff)[_i]), (PG8_LAS unsigned*)(lds + (bufoff) + ldsw + _i * 8192), 16, 0, 0); } while (0)
#define PG8_LDA(dst, b, h) do { _Pragma("unroll") for (int m = 0; m < 4; ++m) _Pragma("unroll") for (int k = 0; k < 2; ++k) dst[m][k] = *(const PG8_LAS bf16x8*)(lds + PG8_SA(b, h) + aoff + m * 2048 + k * 1024); } while (0)
#define PG8_LDB(dst, b, h) do { _Pragma("unroll") for (int n = 0; n < 2; ++n) _Pragma("unroll") for (int k = 0; k < 2; ++k) dst[n][k] = *(const PG8_LAS bf16x8*)(lds + PG8_SB(b, h) + boff + n * 2048 + k * 1024); } while (0)
#define PG8_MMA(ai, bj, At, Bt) do { __builtin_amdgcn_s_setprio(1); _Pragma("unroll") for (int m = 0; m < 4; ++m) _Pragma("unroll") for (int n = 0; n < 2; ++n) _Pragma("unroll") for (int k = 0; k < 2; ++k) \
        acc[ai][bj][m][n] = __builtin_amdgcn_mfma_f32_16x16x32_bf16(Bt[n][k], At[m][k], acc[ai][bj][m][n], 0, 0, 0); __builtin_amdgcn_s_setprio(0); } while (0)
#define PG8_WAIT_V(n) asm volatile("s_waitcnt vmcnt(" #n ")" ::: "memory")
#define PG8_WAIT_L(n) asm volatile("s_waitcnt lgkmcnt(" #n ")" ::: "memory")
#define PG8_BAR __builtin_amdgcn_s_barrier()
#define PG8_SCHED __builtin_amdgcn_sched_barrier(0)
    Unit cur, nxt; int ui = 0;
    if (!S.next(0, cur)) return;
    f32x4 acc[2][2][4][2];
#pragma unroll
    for (int a = 0; a < 2; ++a)
#pragma unroll
        for (int b = 0; b < 2; ++b)
#pragma unroll
            for (int m = 0; m < 4; ++m)
#pragma unroll
                for (int n = 0; n < 2; ++n) acc[a][b][m][n] = (f32x4){0.f, 0.f, 0.f, 0.f};
    bf16x8 At[4][2], B0[2][2], B1[2][2];
    const char* cA = (const char*)g.A + (size_t)cur.pm * tstep; const char* cB = (const char*)g.Bt + (size_t)cur.pn * tstep;
    S.a_ready(cur);
    if constexpr (SP2) {
        PG8_STAGE(PG8_SB(0, 0), cB, voffB); PG8_STAGE(PG8_SB(0, 1), cB + hstep, voffB); PG8_STAGE(PG8_SA(0, 0), cA, voffA); PG8_STAGE(PG8_SA(0, 1), cA + hstep, voffA);
        if (wr == 1) PG8_BAR;
        PG8_WAIT_V(2); PG8_BAR;
        PG8_STAGE(PG8_SB(1, 0), cB + kstep, voffB); PG8_STAGE(PG8_SA(1, 0), cA + kstep, voffA); PG8_STAGE(PG8_SB(1, 1), cB + hstep + kstep, voffB);
        PG8_WAIT_V(6); PG8_BAR;
    } else {
        PG8_STAGE(PG8_SB(0, 0), cB, voffB); PG8_STAGE(PG8_SA(0, 0), cA, voffA); PG8_STAGE(PG8_SB(0, 1), cB + hstep, voffB); PG8_STAGE(PG8_SA(0, 1), cA + hstep, voffA);
        if (wr == 1) PG8_BAR;
        PG8_WAIT_V(4); PG8_BAR;
        PG8_STAGE(PG8_SB(1, 0), cB + kstep, voffB); PG8_STAGE(PG8_SA(1, 0), cA + kstep, voffA); PG8_STAGE(PG8_SB(1, 1), cB + hstep + kstep, voffB);
        PG8_WAIT_V(6); PG8_BAR;
    }
    for (;;) {
        const bool has_next = S.next(ui + 1, nxt);
        const char* nA = has_next ? (const char*)g.A + (size_t)nxt.pm * tstep : cA; const char* nB = has_next ? (const char*)g.Bt + (size_t)nxt.pn * tstep : cB;
        for (int t = 0; t < nt; t += 2) {
            const bool last = (t == nt - 2);
            const char* a1 = cA + (size_t)(t + 1) * kstep;
            const char* a2 = last ? nA : cA + (size_t)(t + 2) * kstep; const char* b2 = last ? nB : cB + (size_t)(t + 2) * kstep;
            const char* a3 = a2 + kstep; const char* b3 = b2 + kstep;
            if (last && has_next) S.a_ready(nxt);
            if constexpr (SP2) {
            PG8_LDB(B0, 0, 0); PG8_LDB(B1, 0, 1); PG8_SCHED; PG8_LDA(At, 0, 0); PG8_STAGE(PG8_SA(1, 1), a1 + hstep, voffA);
            PG8_WAIT_V(8); PG8_WAIT_L(0); PG8_BAR; PG8_MMA(0, 0, At, B0); PG8_MMA(0, 1, At, B1); PG8_BAR; PG8_SCHED;
            PG8_LDA(At, 0, 1); PG8_STAGE(PG8_SB(0, 0), b2, voffB); PG8_STAGE(PG8_SB(0, 1), b2 + hstep, voffB); PG8_STAGE(PG8_SA(0, 0), a2, voffA);
            PG8_WAIT_V(8); PG8_WAIT_L(0); PG8_BAR; PG8_MMA(1, 0, At, B0); PG8_MMA(1, 1, At, B1); PG8_BAR; PG8_SCHED;
            PG8_LDB(B0, 1, 0); PG8_LDB(B1, 1, 1); PG8_SCHED; PG8_LDA(At, 1, 0); PG8_STAGE(PG8_SA(0, 1), a2 + hstep, voffA);
            PG8_WAIT_V(8); PG8_WAIT_L(0); PG8_BAR; PG8_MMA(0, 0, At, B0); PG8_MMA(0, 1, At, B1); PG8_BAR; PG8_SCHED;
            PG8_LDA(At, 1, 1); PG8_STAGE(PG8_SB(1, 0), b3, voffB); PG8_STAGE(PG8_SB(1, 1), b3 + hstep, voffB); PG8_STAGE(PG8_SA(1, 0), a3, voffA);
            PG8_WAIT_V(8); PG8_WAIT_L(0); PG8_BAR; PG8_MMA(1, 0, At, B0); PG8_MMA(1, 1, At, B1); PG8_BAR; PG8_SCHED;
            } else {
            PG8_LDB(B0, 0, 0); PG8_SCHED; PG8_LDA(At, 0, 0); PG8_STAGE(PG8_SA(1, 1), a1 + hstep, voffA);
            PG8_WAIT_L(8); PG8_BAR; PG8_WAIT_L(0); PG8_MMA(0, 0, At, B0); PG8_BAR; PG8_SCHED;
            PG8_LDB(B1, 0, 1); PG8_STAGE(PG8_SB(0, 0), b2, voffB);
            PG8_BAR; PG8_WAIT_L(0); PG8_MMA(0, 1, At, B1); PG8_BAR;
            PG8_LDA(At, 0, 1); PG8_STAGE(PG8_SA(0, 0), a2, voffA);
            PG8_BAR; PG8_WAIT_L(0); PG8_MMA(1, 0, At, B0); PG8_BAR; PG8_SCHED;
            PG8_STAGE(PG8_SB(0, 1), b2 + hstep, voffB);
            PG8_WAIT_V(6); PG8_BAR; PG8_MMA(1, 1, At, B1); PG8_BAR;
            PG8_LDB(B0, 1, 0); PG8_SCHED; PG8_LDA(At, 1, 0); PG8_STAGE(PG8_SA(0, 1), a2 + hstep, voffA);
            PG8_WAIT_L(8); PG8_BAR; PG8_WAIT_L(0); PG8_MMA(0, 0, At, B0); PG8_BAR; PG8_SCHED;
            PG8_LDB(B1, 1, 1); PG8_STAGE(PG8_SB(1, 0), b3, voffB);
            PG8_BAR; PG8_WAIT_L(0); PG8_MMA(0, 1, At, B1); PG8_BAR;
            PG8_LDA(At, 1, 1); PG8_STAGE(PG8_SA(1, 0), a3, voffA);
            PG8_BAR; PG8_WAIT_L(0); PG8_MMA(1, 0, At, B0); PG8_BAR; PG8_SCHED;
            PG8_STAGE(PG8_SB(1, 1), b3 + hstep, voffB);
            PG8_WAIT_V(6); PG8_BAR; PG8_MMA(1, 1, At, B1); PG8_BAR;
            }
        }
        if constexpr (ALIGN_EPI) { if (wr == 0) PG8_BAR; }
        if constexpr (!Epi::AFTER_DRAIN) { E(acc, cur, wr, wc, fr, fq); S.done(cur); }
        if (!has_next) break;
#pragma unroll
        for (int a = 0; a < 2; ++a)
#pragma unroll
            for (int b = 0; b < 2; ++b)
#pragma unroll
                for (int m = 0; m < 4; ++m)
#pragma unroll
                    for (int n = 0; n < 2; ++n) acc[a][b][m][n] = (f32x4){0.f, 0.f, 0.f, 0.f};
        cur = nxt; cA = nA; cB = nB; ++ui;
        if constexpr (ALIGN_EPI) { if (wr == 1) PG8_BAR; }
    }
    PG8_WAIT_V(0);
    if constexpr (!ALIGN_EPI) { if (wr == 0) PG8_BAR; }
    PG8_BAR;
    if constexpr (Epi::AFTER_DRAIN) { E.fused(acc, cur, wr, wc, fr, fq, lds, wid, lane); S.done(cur); }
#undef PG8_SA
#undef PG8_SB
#undef PG8_STAGE
#undef PG8_LDA
#undef PG8_LDB
#undef PG8_MMA
#undef PG8_WAIT_V
#undef PG8_WAIT_L
#undef PG8_BAR
#undef PG8_SCHED
}
}

#ifndef PG8_SP2
#define PG8_SP2 true
#endif
#ifndef PG8_ALIGN
#define PG8_ALIGN true
#endif
constexpr int NWAVES = 8;
constexpr int BATCH = 4, SEQ = 4096, T = BATCH * SEQ, D = 1024, INW = 6656;
constexpr int C_Q = 0, C_K = 512, C_V = 1024, C_CB = 1536, C_CC = 2048, C_CX = 2560, C_QM = 3072, C_G = 3584;
constexpr int MEMT = 256, MROWS = BATCH * MEMT;
constexpr int NE = 32, FF = 1024, TOPK = 4;
constexpr int MAXTILES = 288, SLOTROWS = MAXTILES * 256;
constexpr float RMS_EPS = 1e-6f;

constexpr size_t MiB = 1u << 20;
constexpr size_t WS_CTL = 0, CTL_ZERO_BYTES = 1 * MiB;
constexpr size_t WS_ROUTE = 1 * MiB;
constexpr size_t WS_WIN = 2 * MiB, WS_WKV = 15 * MiB, WS_WBR = 17 * MiB, WS_WO = 20 * MiB, WS_MEMN = 22 * MiB, WS_KV = 24 * MiB;
constexpr size_t WS_WGU = 26 * MiB, WS_WD = 154 * MiB, WS_XN = 218 * MiB, WS_MERGED = 250 * MiB, WS_Y = 282 * MiB;
constexpr size_t WS_PROJ = 426 * MiB, WS_OBR = 634 * MiB, WS_BO = 682 * MiB, WS_END = 778 * MiB;
constexpr size_t WS_XG = 426 * MiB, WS_ACT = 570 * MiB;
static_assert(WS_XG + (size_t)SLOTROWS * 1024 * 2 <= WS_ACT && WS_ACT + (size_t)SLOTROWS * 1024 * 2 <= WS_END, "overlay map");
static_assert(WS_Y + (size_t)SLOTROWS * 1024 * 2 <= WS_PROJ && WS_PROJ + (size_t)T * INW * 2 <= WS_OBR, "d_ws map");
constexpr int CW_BAR = 4096;
constexpr int CW_CNT = 8192;

constexpr int RING_OFF = 0, RING_BYTES = 131072;
constexpr int LDSCTL_OFF = RING_BYTES, MISC_OFF = LDSCTL_OFF + 320;
constexpr int TAB_OFF = LDSCTL_OFF + 1024;
constexpr int LDS_BYTES = 147456;

#define GAS __attribute__((address_space(1)))
#define LAS __attribute__((address_space(3)))
typedef unsigned short bf16;
typedef unsigned v4u __attribute__((ext_vector_type(4)));
typedef float f32x4 __attribute__((ext_vector_type(4)));
typedef short bf16x8 __attribute__((ext_vector_type(8)));
typedef GAS unsigned gu32;
typedef GAS unsigned long long gu64;
#define RLX_AGENT __ATOMIC_RELAXED, __HIP_MEMORY_SCOPE_AGENT
#define LDS_WAIT() asm volatile("s_waitcnt lgkmcnt(0)" ::: "memory")
#define VM_WAIT() asm volatile("s_waitcnt vmcnt(0)" ::: "memory")
__device__ __forceinline__ unsigned long long rt() { return __builtin_amdgcn_s_memrealtime(); }
__device__ __forceinline__ unsigned f2bf(float f) { unsigned u = __builtin_bit_cast(unsigned, f); return (u + 0x7fffu + ((u >> 16) & 1u)) >> 16; }
__device__ __forceinline__ unsigned pk2(float lo, float hi) { return f2bf(lo) | (f2bf(hi) << 16); }

#define XB_TMO      128
#define XB_XCNT(j)  (256  + 64 * (j))
#define XB_XSUB(j)  (1280 + 64 * (j))
#define XB_XGEN(j)  (2304 + 64 * (j))
#define XB_TOP      3328
#define XB_TOPGEN   3392
#define XCD_BAR_WORDS 3456
#define XB_SPIN_CAP (1u << 18)

__device__ __forceinline__ unsigned xb_ld(unsigned* p)              { return __hip_atomic_load(p, __ATOMIC_RELAXED, __HIP_MEMORY_SCOPE_AGENT); }
__device__ __forceinline__ unsigned xb_add(unsigned* p, unsigned v) { return __hip_atomic_fetch_add(p, v, __ATOMIC_RELAXED, __HIP_MEMORY_SCOPE_AGENT); }
__device__ __forceinline__ unsigned xb_xcc_id() { return (unsigned)__builtin_amdgcn_s_getreg((3 << 11) | 20) & 0xFu; }
#define XB_SPIN(cond, bar) do { unsigned _sp = 0; while (cond) { __builtin_amdgcn_s_sleep(1); \
    if ((++_sp & 255u) == 0u) { if (xb_ld(&(bar)[XB_TMO])) break; if (_sp > XB_SPIN_CAP) { atomicAdd(&(bar)[XB_TMO], 1u); break; } } } } while (0)

struct XcdBarrier {
    unsigned* bar; unsigned x;
    volatile LAS unsigned* st;
};

__device__ __forceinline__ XcdBarrier xcd_barrier_post(unsigned* bar, volatile LAS unsigned* st) {
    XcdBarrier b; b.bar = bar; b.x = xb_xcc_id(); b.st = st;
    if (threadIdx.x == 0) (void)xb_add(&bar[XB_XCNT(b.x)], 1u);
    return b;
}
__device__ __forceinline__ void xcd_barrier_complete(unsigned* bar, unsigned x, unsigned& nloc, unsigned& nx) {
    const unsigned G = gridDim.x * gridDim.y * gridDim.z;
    unsigned sum, cnt, mine, sp = 0u;
    for (;;) {
        sum = 0u; cnt = 0u; mine = 0u;
#pragma unroll
        for (unsigned j = 0; j < 16; ++j) { const unsigned c = xb_ld(&bar[XB_XCNT(j)]); sum += c; cnt += (c > 0u) ? 1u : 0u; mine = (j == x) ? c : mine; }
        if (sum == G) break;
        __builtin_amdgcn_s_sleep(1);
        if ((++sp & 255u) == 0u) { if (xb_ld(&bar[XB_TMO])) break; if (sp > XB_SPIN_CAP) { atomicAdd(&bar[XB_TMO], 1u); break; } }
    }
    nloc = mine > 0u ? mine : 1u; nx = cnt > 0u ? cnt : 1u;
}

__device__ __forceinline__ void xcd_barrier(const XcdBarrier& b) {
    asm volatile("s_waitcnt vmcnt(0)" ::: "memory");
    __syncthreads();
    if (threadIdx.x == 0) {
        unsigned* bar = b.bar;
        __builtin_amdgcn_s_waitcnt(0);
        unsigned nloc = b.st[0], nx = b.st[1];
        if (nloc == 0u) { xcd_barrier_complete(bar, b.x, nloc, nx); b.st[0] = nloc; b.st[1] = nx; }
        const unsigned old = xb_add(&bar[XB_XSUB(b.x)], 1u);
        const unsigned gen = old / nloc;
        if (old + 1u == (gen + 1u) * nloc) {
            __builtin_amdgcn_fence(__ATOMIC_RELEASE, "agent");
            asm volatile("s_waitcnt vmcnt(0)" ::: "memory");
            const unsigned og = xb_add(&bar[XB_TOP], 1u);
            const unsigned tg = og / nx;
            if (og + 1u == (tg + 1u) * nx) xb_add(&bar[XB_TOPGEN], 1u);
            else XB_SPIN(xb_ld(&bar[XB_TOPGEN]) == tg, bar);
            __builtin_amdgcn_fence(__ATOMIC_ACQUIRE, "agent");
            xb_add(&bar[XB_XGEN(b.x)], 1u);
            asm volatile("s_waitcnt vmcnt(0)" ::: "memory");
        } else {
            XB_SPIN(xb_ld(&bar[XB_XGEN(b.x)]) == gen, bar);
            __builtin_amdgcn_fence(__ATOMIC_ACQUIRE, "agent");
            asm volatile("s_waitcnt vmcnt(0)" ::: "memory");
        }
    }
    __syncthreads();
}

struct Frame {
    LAS unsigned char* lds;
    volatile LAS unsigned* MISC;
    gu32* ctl;
    unsigned char* ws; float* out;
    int tid, lane, wave, vcu, G;
};
typedef const __attribute__((address_space(4))) char* kargp_t;
__device__ __forceinline__ const float* in_ptr(int i) {
    kargp_t kp = (kargp_t)__builtin_amdgcn_kernarg_segment_ptr();
    asm volatile("" : "+s"(kp));
    return *(const float* const __attribute__((address_space(4)))*)(kp + 8 * i);
}
enum { I_X = 0, I_MEM, I_MIXG, I_WIN, I_SBQG, I_SBKG, I_CONVW, I_MEMG, I_WKV, I_MEMQG, I_MEMKG, I_WBRSB, I_WBRCONV, I_WBRMEM, I_WO, I_FFNG, I_WROUTER, I_BROUTER, I_WGU, I_BGU, I_WD, I_BD };
#define WSP(TY, off) ((TY*)(F.ws + (off)))

__device__ __forceinline__ float wave_sum(float v) {
#pragma unroll
    for (int o = 1; o < 64; o <<= 1) v += __shfl_xor(v, o);
    return v;
}
__device__ __forceinline__ float bflo(unsigned w) { return __uint_as_float(w << 16); }
__device__ __forceinline__ float bfhi(unsigned w) { return __uint_as_float(w & 0xffff0000u); }

__device__ __forceinline__ void p0_transpose_tile(const float* W, int N, int K, int k0, int n0, bf16* WT, int dst_row0, LAS float* scr, int lane) {
#pragma unroll 8
    for (int i = 0; i < 32; ++i) { const int kk = 2 * i + (lane >> 5); scr[kk * 33 + (lane & 31)] = W[(size_t)(k0 + kk) * N + n0 + (lane & 31)]; }
    LDS_WAIT(); asm volatile("" ::: "memory");
    const int c = lane & 7;
#pragma unroll
    for (int j = 0; j < 4; ++j) { const int n = (lane >> 3) + 8 * j; const LAS float* s = scr + (8 * c) * 33 + n;
        v4u o; o.x = pk2(s[0 * 33], s[1 * 33]); o.y = pk2(s[2 * 33], s[3 * 33]); o.z = pk2(s[4 * 33], s[5 * 33]); o.w = pk2(s[6 * 33], s[7 * 33]);
        *(GAS v4u*)(WT + (size_t)(dst_row0 + n) * K + k0 + 8 * c) = o; }
    LDS_WAIT(); asm volatile("" ::: "memory");
}
__device__ __forceinline__ void rms_row_to_bf16(int lane, const float* xrow, const float* g, bf16* orow) {
    const GAS f32x4* xr = (const GAS f32x4*)xrow + lane; const GAS f32x4* gr = (const GAS f32x4*)g + lane;
    f32x4 v[4]; float s = 0.f;
#pragma unroll
    for (int j = 0; j < 4; ++j) { v[j] = xr[64 * j]; s += (v[j].x * v[j].x + v[j].y * v[j].y) + (v[j].z * v[j].z + v[j].w * v[j].w); }
    const float r = 1.f / sqrtf(wave_sum(s) * (1.f / 1024.f) + RMS_EPS);
    GAS unsigned long long* o8 = (GAS unsigned long long*)orow + lane;
#pragma unroll
    for (int j = 0; j < 4; ++j) { const f32x4 gg = gr[64 * j];
        o8[64 * j] = (unsigned long long)pk2(v[j].x * r * gg.x, v[j].y * r * gg.y) | ((unsigned long long)pk2(v[j].z * r * gg.z, v[j].w * r * gg.w) << 32); }
}
__device__ __forceinline__ void p0_prologue(Frame& F) {
    LAS float* scr = (LAS float*)(F.lds + RING_OFF + F.wave * 16384);
    const int gw = F.vcu * NWAVES + F.wave, NGW = F.G * NWAVES;
    constexpr int I_IN = 16 * 208, I_KV = 16 * 32, I_BR = 8 * 32, I_O = 16 * 32, I_GU = NE * 16 * 64, I_D = NE * 16 * 32;
    constexpr int NITEMS = I_IN + I_KV + 3 * I_BR + I_O + I_GU + I_D;
    for (int it = gw; it < NITEMS; it += NGW) {
        int r = it;
        if (r < I_IN) { const int kb = r / 208, nb = r % 208; p0_transpose_tile(in_ptr(I_WIN), INW, 1024, 64 * kb, 32 * nb, WSP(bf16, WS_WIN), 32 * nb, scr, F.lane); continue; } r -= I_IN;
        if (r < I_KV) { const int kb = r / 32, nb = r % 32; p0_transpose_tile(in_ptr(I_WKV), 1024, 1024, 64 * kb, 32 * nb, WSP(bf16, WS_WKV), 32 * nb, scr, F.lane); continue; } r -= I_KV;
        if (r < 3 * I_BR) { const int br = r / I_BR, rr = r % I_BR, kb = rr / 32, nb = rr % 32; const float* W = in_ptr(I_WBRSB + br);
            p0_transpose_tile(W, 1024, 512, 64 * kb, 32 * nb, WSP(bf16, WS_WBR) + (size_t)br * 1024 * 512, 32 * nb, scr, F.lane); continue; } r -= 3 * I_BR;
        if (r < I_O) { const int kb = r / 32, nb = r % 32; p0_transpose_tile(in_ptr(I_WO), 1024, 1024, 64 * kb, 32 * nb, WSP(bf16, WS_WO), 32 * nb, scr, F.lane); continue; } r -= I_O;
        if (r < I_GU) { const int e = r / 1024, rr = r % 1024, kb = rr / 64, nb = rr % 64, n0 = 32 * nb, f0 = n0 & 1023;
            const int dst = e * 2048 + (f0 >> 7) * 256 + (n0 >= 1024 ? 128 : 0) + (f0 & 127);
            p0_transpose_tile(in_ptr(I_WGU) + (size_t)e * 1024 * 2048, 2048, 1024, 64 * kb, n0, WSP(bf16, WS_WGU), dst, scr, F.lane); continue; } r -= I_GU;
        { const int e = r / 512, rr = r % 512, kb = rr / 32, nb = rr % 32;
            p0_transpose_tile(in_ptr(I_WD) + (size_t)e * 1024 * 1024, 1024, 1024, 64 * kb, 32 * nb, WSP(bf16, WS_WD), e * 1024 + 32 * nb, scr, F.lane); }
    }
    const float *px = in_ptr(I_X), *pmixg = in_ptr(I_MIXG), *pmem = in_ptr(I_MEM), *pmemg = in_ptr(I_MEMG);
    for (int m = gw; m < T + MROWS; m += NGW) {
        if (m < T) rms_row_to_bf16(F.lane, px + (size_t)m * D, pmixg, WSP(bf16, WS_XN) + (size_t)m * D);
        else rms_row_to_bf16(F.lane, pmem + (size_t)(m - T) * D, pmemg, WSP(bf16, WS_MEMN) + (size_t)(m - T) * D);
    }
}

__device__ __forceinline__ void norm8_inplace(GAS v4u* p, float inv_n, const float* g, int nshuf, float post) {
    v4u c = *p; float x[8] = {bflo(c.x), bfhi(c.x), bflo(c.y), bfhi(c.y), bflo(c.z), bfhi(c.z), bflo(c.w), bfhi(c.w)};
    float ss = 0.f;
#pragma unroll
    for (int i = 0; i < 8; ++i) ss += x[i] * x[i];
#pragma unroll
    for (int o = 1; o < 16; o <<= 1) if (o < nshuf) ss += __shfl_xor(ss, o);
    const float r = post / sqrtf(ss * inv_n + RMS_EPS);
    const f32x4 g0 = *(const GAS f32x4*)g, g1 = *(const GAS f32x4*)(g + 4);
    v4u o; o.x = pk2(x[0] * r * g0.x, x[1] * r * g0.y); o.y = pk2(x[2] * r * g0.z, x[3] * r * g0.w); o.z = pk2(x[4] * r * g1.x, x[5] * r * g1.y); o.w = pk2(x[6] * r * g1.z, x[7] * r * g1.w);
    *p = o;
}
__device__ __forceinline__ void p2a_norms(Frame& F) {
    const int gw = F.vcu * NWAVES + F.wave, NGW = F.G * NWAVES, lane = F.lane;
    const float *sbqg = in_ptr(I_SBQG), *sbkg = in_ptr(I_SBKG), *memqg = in_ptr(I_MEMQG), *memkg = in_ptr(I_MEMKG);
    for (int it = gw; it < T + MROWS; it += NGW) {
        if (it < T) {
            bf16* row = WSP(bf16, WS_PROJ) + (size_t)it * INW;
            norm8_inplace((GAS v4u*)(row + lane * 8), 1.f / 64.f, sbqg + (lane & 7) * 8, 8, 0.125f);
            norm8_inplace((GAS v4u*)(row + 512 + lane * 8), 1.f / 64.f, sbkg + (lane & 7) * 8, 8, 1.f);
            norm8_inplace((GAS v4u*)(row + C_QM + lane * 8), 1.f / 128.f, memqg + (lane & 15) * 8, 16, 1.f);
        } else {
            bf16* row = WSP(bf16, WS_KV) + (size_t)(it - T) * 1024;
            norm8_inplace((GAS v4u*)(row + lane * 8), 1.f / 128.f, memkg + (lane & 15) * 8, 16, 1.f);
        }
    }
}

__device__ __forceinline__ void sb_naive_item(Frame& F, int bh, int tile, bf16* OSB) {
    const int lane = F.lane, b = bh >> 3, h = bh & 7, t = tile * 64 + lane;
    LAS unsigned char* kl = F.lds + RING_OFF + F.wave * 16384;
    float q[64], o[64];
    { const GAS v4u* qp = (const GAS v4u*)(WSP(bf16, WS_PROJ) + (size_t)(b * SEQ + t) * INW + C_Q + h * 64);
#pragma unroll
      for (int i = 0; i < 8; ++i) { const v4u c = qp[i]; q[8 * i] = bflo(c.x); q[8 * i + 1] = bfhi(c.x); q[8 * i + 2] = bflo(c.y); q[8 * i + 3] = bfhi(c.y); q[8 * i + 4] = bflo(c.z); q[8 * i + 5] = bfhi(c.z); q[8 * i + 6] = bflo(c.w); q[8 * i + 7] = bfhi(c.w); } }
#pragma unroll
    for (int i = 0; i < 64; ++i) o[i] = 0.f;
    float acc = 0.f;
    for (int c = tile; c >= 0; --c) {
        { const bf16* rowp = WSP(bf16, WS_PROJ) + (size_t)(b * SEQ + c * 64 + lane) * INW + h * 64;
          const GAS v4u* kp = (const GAS v4u*)(rowp + C_K); const GAS v4u* vp = (const GAS v4u*)(rowp + C_V);
#pragma unroll
          for (int i = 0; i < 8; ++i) { *(LAS v4u*)(kl + lane * 128 + i * 16) = kp[i]; *(LAS v4u*)(kl + 8192 + lane * 128 + i * 16) = vp[i]; } }
        LDS_WAIT(); asm volatile("" ::: "memory");
        for (int sl = 63; sl >= 0; --sl) {
            const int s = c * 64 + sl;
            float z = 0.f;
#pragma unroll
            for (int i = 0; i < 8; ++i) { const v4u kk = *(const LAS v4u*)(kl + sl * 128 + i * 16);
                z += q[8 * i] * bflo(kk.x) + q[8 * i + 1] * bfhi(kk.x) + q[8 * i + 2] * bflo(kk.y) + q[8 * i + 3] * bfhi(kk.y) + q[8 * i + 4] * bflo(kk.z) + q[8 * i + 5] * bfhi(kk.z) + q[8 * i + 6] * bflo(kk.w) + q[8 * i + 7] * bfhi(kk.w); }
            const bool valid = s < t;
            const float e = __expf(-fabsf(z));
            const float sp = fmaxf(z, 0.f) + __logf(1.f + e);
            const float sg = (z >= 0.f ? 1.f : e) / (1.f + e);
            const float w = valid ? sg * __expf(acc) : 0.f;
            acc = valid ? acc - sp : acc;
#pragma unroll
            for (int i = 0; i < 8; ++i) { const v4u vv = *(const LAS v4u*)(kl + 8192 + sl * 128 + i * 16);
                o[8 * i] += w * bflo(vv.x); o[8 * i + 1] += w * bfhi(vv.x); o[8 * i + 2] += w * bflo(vv.y); o[8 * i + 3] += w * bfhi(vv.y); o[8 * i + 4] += w * bflo(vv.z); o[8 * i + 5] += w * bfhi(vv.z); o[8 * i + 6] += w * bflo(vv.w); o[8 * i + 7] += w * bfhi(vv.w); }
        }
        LDS_WAIT(); asm volatile("" ::: "memory");
    }
    GAS v4u* op = (GAS v4u*)(OSB + (size_t)(b * SEQ + t) * 512 + h * 64);
#pragma unroll
    for (int i = 0; i < 8; ++i) { v4u w; w.x = pk2(o[8 * i], o[8 * i + 1]); w.y = pk2(o[8 * i + 2], o[8 * i + 3]); w.z = pk2(o[8 * i + 4], o[8 * i + 5]); w.w = pk2(o[8 * i + 6], o[8 * i + 7]); op[i] = w; }
}
__device__ __forceinline__ void mem_naive_item(Frame& F, int t, int h, bf16* OMEM) {
    const int lane = F.lane, b = t >> 12;
    LAS float* qs = (LAS float*)(F.lds + RING_OFF + F.wave * 16384);
    LAS float* ps = qs + 128;
    { const unsigned w = *(const GAS unsigned*)(WSP(bf16, WS_PROJ) + (size_t)t * INW + C_QM + h * 128 + lane * 2); qs[lane * 2] = bflo(w); qs[lane * 2 + 1] = bfhi(w); }
    LDS_WAIT(); asm volatile("" ::: "memory");
    float sc[4];
#pragma unroll
    for (int i = 0; i < 4; ++i) { const GAS v4u* kp = (const GAS v4u*)(WSP(bf16, WS_KV) + (size_t)(b * MEMT + lane + 64 * i) * 1024 + h * 128); float z = 0.f;
#pragma unroll
        for (int j = 0; j < 16; ++j) { const v4u kk = kp[j]; const LAS float* qq = qs + 8 * j;
            z += qq[0] * bflo(kk.x) + qq[1] * bfhi(kk.x) + qq[2] * bflo(kk.y) + qq[3] * bfhi(kk.y) + qq[4] * bflo(kk.z) + qq[5] * bfhi(kk.z) + qq[6] * bflo(kk.w) + qq[7] * bfhi(kk.w); }
        sc[i] = z * 0.08838834764831845f; }
    float mx = fmaxf(fmaxf(sc[0], sc[1]), fmaxf(sc[2], sc[3]));
#pragma unroll
    for (int o = 1; o < 64; o <<= 1) mx = fmaxf(mx, __shfl_xor(mx, o));
    float sum = 0.f;
#pragma unroll
    for (int i = 0; i < 4; ++i) { sc[i] = __expf(sc[i] - mx); sum += sc[i]; }
    sum = wave_sum(sum); const float inv = 1.f / sum;
#pragma unroll
    for (int i = 0; i < 4; ++i) ps[lane + 64 * i] = sc[i] * inv;
    LDS_WAIT(); asm volatile("" ::: "memory");
    float o0 = 0.f, o1 = 0.f;
    const bf16* vb = WSP(bf16, WS_KV) + (size_t)(b * MEMT) * 1024 + 512 + h * 128 + lane * 2;
#pragma unroll 8
    for (int m = 0; m < MEMT; ++m) { const unsigned w = *(const GAS unsigned*)(vb + (size_t)m * 1024); const float p = ps[m]; o0 += p * bflo(w); o1 += p * bfhi(w); }
    *(GAS unsigned*)(OMEM + (size_t)t * 512 + h * 128 + lane * 2) = pk2(o0, o1);
    LDS_WAIT(); asm volatile("" ::: "memory");
}
__device__ __forceinline__ void conv_item(Frame& F, int t, bf16* OCONV, const float* cw) {
    const int lane = F.lane, pos = t & (SEQ - 1), c0 = lane * 8;
    float u[3][8];
#pragma unroll
    for (int j = 0; j < 3; ++j) {
        const int d = 2 - j;
        if (pos >= d) { const bf16* rp = WSP(bf16, WS_PROJ) + (size_t)(t - d) * INW; const v4u a = *(const GAS v4u*)(rp + C_CC + c0), x = *(const GAS v4u*)(rp + C_CX + c0);
            u[j][0] = bflo(a.x) * bflo(x.x); u[j][1] = bfhi(a.x) * bfhi(x.x); u[j][2] = bflo(a.y) * bflo(x.y); u[j][3] = bfhi(a.y) * bfhi(x.y);
            u[j][4] = bflo(a.z) * bflo(x.z); u[j][5] = bfhi(a.z) * bfhi(x.z); u[j][6] = bflo(a.w) * bflo(x.w); u[j][7] = bfhi(a.w) * bfhi(x.w); }
        else {
#pragma unroll
            for (int i = 0; i < 8; ++i) u[j][i] = 0.f; }
    }
    const v4u bq = *(const GAS v4u*)(WSP(bf16, WS_PROJ) + (size_t)t * INW + C_CB + c0);
    const float cb[8] = {bflo(bq.x), bfhi(bq.x), bflo(bq.y), bfhi(bq.y), bflo(bq.z), bfhi(bq.z), bflo(bq.w), bfhi(bq.w)};
    float r[8];
#pragma unroll
    for (int i = 0; i < 8; ++i) r[i] = cb[i] * (cw[c0 + i] * u[0][i] + cw[512 + c0 + i] * u[1][i] + cw[1024 + c0 + i] * u[2][i]);
    v4u w; w.x = pk2(r[0], r[1]); w.y = pk2(r[2], r[3]); w.z = pk2(r[4], r[5]); w.w = pk2(r[6], r[7]);
    *(GAS v4u*)(OCONV + (size_t)t * 512 + c0) = w;
}
__device__ __forceinline__ void p2_mixers(Frame& F) {
    bf16* OSB = WSP(bf16, WS_OBR); bf16* OCONV = WSP(bf16, WS_OBR) + (size_t)T * 512; bf16* OMEM = WSP(bf16, WS_OBR) + (size_t)2 * T * 512;
    const int gw = F.vcu * NWAVES + F.wave, NGW = F.G * NWAVES;
    for (int it = gw; it < 32 * 64; it += NGW) {
        const int bh = it >> 6, jb = (it >> 3) & 7, w = it & 7;
        const int tile = (w < 4) ? (jb * 4 + w) : 63 - (jb * 4 + (w - 4));
        sb_naive_item(F, bh, tile, OSB);
    }
    for (int it = gw; it < T * 4; it += NGW) mem_naive_item(F, it >> 2, it & 3, OMEM);
    const float* cw = in_ptr(I_CONVW);
    for (int t = gw; t < T; t += NGW) conv_item(F, t, OCONV, cw);
}

__device__ __forceinline__ void p3b_merge(Frame& F) {
    const int gw = F.vcu * NWAVES + F.wave, NGW = F.G * NWAVES, lane = F.lane;
    for (int t = gw; t < T; t += NGW) {
#pragma unroll
        for (int hf = 0; hf < 2; ++hf) {
            const int col = hf * 512 + lane * 8; float m[8];
#pragma unroll
            for (int i = 0; i < 8; ++i) m[i] = 0.f;
#pragma unroll
            for (int br = 0; br < 3; ++br) {
                const v4u g = *(const GAS v4u*)(WSP(bf16, WS_PROJ) + (size_t)t * INW + C_G + br * 1024 + col), y = *(const GAS v4u*)(WSP(bf16, WS_BO) + (size_t)br * T * 1024 + (size_t)t * 1024 + col);
                const float gv[8] = {bflo(g.x), bfhi(g.x), bflo(g.y), bfhi(g.y), bflo(g.z), bfhi(g.z), bflo(g.w), bfhi(g.w)};
                const float yv[8] = {bflo(y.x), bfhi(y.x), bflo(y.y), bfhi(y.y), bflo(y.z), bfhi(y.z), bflo(y.w), bfhi(y.w)};
#pragma unroll
                for (int i = 0; i < 8; ++i) m[i] += yv[i] / (1.f + __expf(-gv[i]));
            }
            v4u w; w.x = pk2(m[0], m[1]); w.y = pk2(m[2], m[3]); w.z = pk2(m[4], m[5]); w.w = pk2(m[6], m[7]);
            *(GAS v4u*)(WSP(bf16, WS_MERGED) + (size_t)t * 1024 + col) = w;
        }
    }
}

__device__ __forceinline__ void p5_route(Frame& F) {
    const int gw = F.vcu * NWAVES + F.wave, NGW = F.G * NWAVES, lane = F.lane, e = lane & 31, hw = lane >> 5;
    const float* wrt = in_ptr(I_WROUTER); const float* fg = in_ptr(I_FFNG); const float be = in_ptr(I_BROUTER)[e];
    for (int tp = gw; tp < T / 2; tp += NGW) {
        const int t = tp * 2 + hw;
        const GAS f32x4* xr = (const GAS f32x4*)(F.out + (size_t)t * D); const GAS f32x4* gr = (const GAS f32x4*)fg;
        float lg = 0.f, ss = 0.f;
#pragma unroll 4
        for (int k4 = 0; k4 < 256; ++k4) {
            const f32x4 xv = xr[k4], gv = gr[k4]; const GAS float* wp = (const GAS float*)wrt + (size_t)k4 * 128 + e;
            ss += (xv.x * xv.x + xv.y * xv.y) + (xv.z * xv.z + xv.w * xv.w);
            lg += (xv.x * gv.x) * wp[0]; lg += (xv.y * gv.y) * wp[32]; lg += (xv.z * gv.z) * wp[64]; lg += (xv.w * gv.w) * wp[96];
        }
        const float r = 1.f / sqrtf(ss * (1.f / 1024.f) + RMS_EPS);
        float val = lg * r + be;
        float tv[4]; int ti[4];
#pragma unroll
        for (int rr = 0; rr < 4; ++rr) {
            float bv = val; int bi = e;
#pragma unroll
            for (int o = 16; o >= 1; o >>= 1) { const float ov = __shfl_xor(bv, o); const int oi = __shfl_xor(bi, o); if (ov > bv || (ov == bv && oi < bi)) { bv = ov; bi = oi; } }
            tv[rr] = bv; ti[rr] = bi; if (e == bi) val = -INFINITY;
        }
        const float e1 = __expf(tv[1] - tv[0]), e2 = __expf(tv[2] - tv[0]), e3 = __expf(tv[3] - tv[0]); const float inv = 1.f / (1.f + e1 + e2 + e3);
        if (e < 4) {
            const int my_e = e == 0 ? ti[0] : (e == 1 ? ti[1] : (e == 2 ? ti[2] : ti[3]));
            const float my_g = (e == 0 ? 1.f : (e == 1 ? e1 : (e == 2 ? e2 : e3))) * inv;
            const unsigned pos = __hip_atomic_fetch_add((unsigned*)(F.ctl + CW_CNT + 64 * my_e), 1u, __ATOMIC_RELAXED, __HIP_MEMORY_SCOPE_AGENT);
            WSP(int, WS_ROUTE)[t * 4 + e] = my_e; WSP(float, WS_ROUTE + 256 * 1024)[t * 4 + e] = my_g; WSP(int, WS_ROUTE + 512 * 1024)[t * 4 + e] = (int)pos;
        }
    }
}
__device__ __forceinline__ void moe_table(Frame& F) {
    volatile LAS int* tab = (volatile LAS int*)(F.lds + TAB_OFF);
    if (F.tid == 0) { int acc = 0;
        for (int e = 0; e < NE; ++e) { tab[e] = acc; const unsigned c = __hip_atomic_load((unsigned*)(F.ctl + CW_CNT + 64 * e), __ATOMIC_RELAXED, __HIP_MEMORY_SCOPE_AGENT); acc += (int)((c + 255u) >> 8); }
        tab[NE] = acc; tab[40] = acc; }
    __syncthreads();
}
__device__ __forceinline__ void p5b_gather(Frame& F) {
    moe_table(F);
    const volatile LAS int* tab = (const volatile LAS int*)(F.lds + TAB_OFF);
    const int gw = F.vcu * NWAVES + F.wave, NGW = F.G * NWAVES, lane = F.lane;
    const GAS f32x4* gr = (const GAS f32x4*)in_ptr(I_FFNG) + lane;
    for (int t = gw; t < T; t += NGW) {
        const GAS f32x4* xr = (const GAS f32x4*)(F.out + (size_t)t * D) + lane;
        f32x4 v[4]; float s = 0.f;
#pragma unroll
        for (int j = 0; j < 4; ++j) { v[j] = xr[64 * j]; s += (v[j].x * v[j].x + v[j].y * v[j].y) + (v[j].z * v[j].z + v[j].w * v[j].w); }
        const float r = 1.f / sqrtf(wave_sum(s) * (1.f / 1024.f) + RMS_EPS);
        unsigned long long pk[4];
#pragma unroll
        for (int j = 0; j < 4; ++j) { const f32x4 gg = gr[64 * j];
            pk[j] = (unsigned long long)pk2(v[j].x * r * gg.x, v[j].y * r * gg.y) | ((unsigned long long)pk2(v[j].z * r * gg.z, v[j].w * r * gg.w) << 32); }
#pragma unroll
        for (int k = 0; k < 4; ++k) {
            const int e = WSP(int, WS_ROUTE)[t * 4 + k], pos = WSP(int, WS_ROUTE + 512 * 1024)[t * 4 + k]; const int slot = tab[e] * 256 + pos;
            GAS unsigned long long* o8 = (GAS unsigned long long*)(WSP(bf16, WS_XG) + (size_t)slot * 1024) + lane;
#pragma unroll
            for (int j = 0; j < 4; ++j) o8[64 * j] = pk[j];
            if (lane == 0) WSP(int, WS_ROUTE + 768 * 1024)[t * 4 + k] = slot;
        }
    }
}
__device__ __forceinline__ void p8_combine(Frame& F) {
    const int gw = F.vcu * NWAVES + F.wave, NGW = F.G * NWAVES, lane = F.lane;
    for (int t = gw; t < T; t += NGW) {
        GAS f32x4* xr = (GAS f32x4*)(F.out + (size_t)t * D) + lane;
        f32x4 v[4];
#pragma unroll
        for (int j = 0; j < 4; ++j) v[j] = xr[64 * j];
#pragma unroll
        for (int k = 0; k < 4; ++k) {
            const int slot = WSP(int, WS_ROUTE + 768 * 1024)[t * 4 + k]; const float g = WSP(float, WS_ROUTE + 256 * 1024)[t * 4 + k];
            const GAS unsigned long long* y8 = (const GAS unsigned long long*)(WSP(bf16, WS_Y) + (size_t)slot * 1024) + lane;
#pragma unroll
            for (int j = 0; j < 4; ++j) { const unsigned long long w = y8[64 * j]; const unsigned lo = (unsigned)w, hi = (unsigned)(w >> 32);
                v[j].x += g * bflo(lo); v[j].y += g * bfhi(lo); v[j].z += g * bflo(hi); v[j].w += g * bfhi(hi); }
        }
#pragma unroll
        for (int j = 0; j < 4; ++j) xr[64 * j] = v[j];
    }
}

struct EpiResF32 {
    static constexpr bool PERM = false, AFTER_DRAIN = false;
    const float* base; float* out; int ldc;
    __device__ __forceinline__ void operator()(const pg8::f32x4 (&acc)[2][2][4][2], const pg8::Unit& u, int wr, int wc, int fr, int fq) const {
        const int col0 = u.pn * pg8::BM + wc * 32 + 4 * fq;
#pragma unroll
        for (int ai = 0; ai < 2; ++ai)
#pragma unroll
            for (int m = 0; m < 4; ++m) { const size_t off = (size_t)(u.pm * pg8::BM + ai * pg8::HALF + wr * 64 + m * 16 + fr) * ldc + col0;
#pragma unroll
                for (int bj = 0; bj < 2; ++bj)
#pragma unroll
                    for (int n = 0; n < 2; ++n) { const pg8::f32x4 bs = *(const pg8::f32x4*)(base + off + bj * pg8::HALF + n * 16); *(pg8::f32x4*)(out + off + bj * pg8::HALF + n * 16) = bs + acc[ai][bj][m][n]; }
                asm volatile("" ::: "memory"); }
    }
};
struct EpiSwiglu {
    static constexpr bool PERM = true, AFTER_DRAIN = false;
    pg8::bf16_t* O; const float* bias;
    __device__ __forceinline__ void operator()(const pg8::f32x4 (&acc)[2][2][4][2], const pg8::Unit& u, int wr, int wc, int fr, int fq) const {
        const int e = u.pn >> 3, pl = u.pn & 7, f0 = pl * 128 + wc * 32 + 8 * fq, row0 = u.pm * pg8::BM + wr * 64 + fr;
        const float* bg = bias + e * 2048 + f0;
        pg8::f32x4 bgv[2], blv[2];
#pragma unroll
        for (int n = 0; n < 2; ++n) { bgv[n] = *(const pg8::f32x4*)(bg + 4 * n); blv[n] = *(const pg8::f32x4*)(bg + 1024 + 4 * n); }
#pragma unroll
        for (int ai = 0; ai < 2; ++ai)
#pragma unroll
            for (int m = 0; m < 4; ++m) { pg8::bf16_t* rowp = O + (size_t)(row0 + ai * pg8::HALF + m * 16) * 1024 + f0; float a[8];
#pragma unroll
                for (int n = 0; n < 2; ++n) { const pg8::f32x4 g4 = acc[ai][0][m][n] + bgv[n], l4 = acc[ai][1][m][n] + blv[n];
#pragma unroll
                    for (int j = 0; j < 4; ++j) { const float g = fminf(g4[j], 7.f), l = fminf(fmaxf(l4[j], -7.f), 7.f); a[4 * n + j] = g * (l + 1.f) / (1.f + __expf(-1.702f * g)); } }
                pg8::u32x4 w; w.x = pg8::cvt_pk_bf16(a[0], a[1]); w.y = pg8::cvt_pk_bf16(a[2], a[3]); w.z = pg8::cvt_pk_bf16(a[4], a[5]); w.w = pg8::cvt_pk_bf16(a[6], a[7]);
                *(pg8::u32x4*)rowp = w; }
    }
};
struct MoeOrder {
    const volatile LAS int* tab; int nN, ntiles, G, c;
    __device__ __forceinline__ bool next(int i, pg8::Unit& u) const {
        const long L = (long)i * G + c; if (L >= (long)ntiles * nN) return false;
        const int wgid = (int)L, nig = 8 * nN, gid = wgid / nig, fm = gid * 8, gsz = (ntiles - fm) < 8 ? (ntiles - fm) : 8;
        const int pm = fm + ((wgid % nig) % gsz), pl = (wgid % nig) / gsz;
        int e = 0;
        for (int j = 1; j < NE; ++j) e += (tab[j] <= pm) ? 1 : 0;
        u.pm = __builtin_amdgcn_readfirstlane(pm); u.pn = __builtin_amdgcn_readfirstlane(e * nN + pl); return true;
    }
    __device__ __forceinline__ void a_ready(const pg8::Unit&) const {}
    __device__ __forceinline__ void done(const pg8::Unit&) const {}
};

struct Args { const float* in[22]; float* out; unsigned char* ws; int ph_lo, ph_hi; };
__global__ void __launch_bounds__(NWAVES * 64, 2) fwd_kernel(Args args) {
    extern __shared__ __attribute__((aligned(16))) unsigned char lds[];
    Frame F;
    F.lds = (LAS unsigned char*)lds;
    F.MISC = (volatile LAS unsigned*)(F.lds + MISC_OFF);
    F.tid = threadIdx.x; F.lane = F.tid & 63; F.wave = __builtin_amdgcn_readfirstlane(F.tid >> 6);
    F.G = gridDim.x; { const int bx = blockIdx.x; F.vcu = (F.G % 8 == 0) ? (bx % 8) * (F.G / 8) + bx / 8 : bx; }
    F.ws = args.ws; F.out = args.out; F.ctl = (gu32*)(F.ws + WS_CTL);
    for (int u = F.tid; u < (LDS_BYTES - LDSCTL_OFF) / 4; u += NWAVES * 64) ((LAS unsigned*)(F.lds + LDSCTL_OFF))[u] = 0u;
    __syncthreads();
    XcdBarrier bar = xcd_barrier_post((unsigned*)(F.ctl + CW_BAR), F.MISC + 8);
    const int lo = args.ph_lo, hi = args.ph_hi;
#define IN(k) (lo <= (k) && (k) < hi)
#define GRID_BAR() xcd_barrier(bar)

    if (IN(0)) { p0_prologue(F); GRID_BAR(); }
    if (IN(1)) {
        { pg8::Gemm g{WSP(bf16, WS_XN), WSP(bf16, WS_WIN), T, INW, D}; pg8::StaticOrder S; S.init(T, INW, F.G, (int)blockIdx.x);
          pg8::EpiBf16<0> E{WSP(bf16, WS_PROJ), INW, nullptr, 0, 0, 1.f};
          pg8::gemm_phase<pg8::EpiBf16<0>, pg8::StaticOrder, true, true>(F.lds + RING_OFF, g, S, E); }
        { pg8::Gemm g{WSP(bf16, WS_MEMN), WSP(bf16, WS_WKV), MROWS, 1024, D}; pg8::StaticOrder S; S.init(MROWS, 1024, F.G, (int)blockIdx.x);
          pg8::EpiBf16<0> E{WSP(bf16, WS_KV), 1024, nullptr, 0, 0, 1.f};
          pg8::gemm_phase<pg8::EpiBf16<0>, pg8::StaticOrder, true, true>(F.lds + RING_OFF, g, S, E); }
        GRID_BAR();
    }
    if (IN(2)) { p2a_norms(F); GRID_BAR(); }
    if (IN(3)) { p2_mixers(F); GRID_BAR(); }
    if (IN(4)) {
#pragma unroll 1
        for (int br = 0; br < 3; ++br) {
            pg8::Gemm g{WSP(bf16, WS_OBR) + (size_t)br * T * 512, WSP(bf16, WS_WBR) + (size_t)br * 1024 * 512, T, D, 512}; pg8::StaticOrder S; S.init(T, D, F.G, (int)blockIdx.x);
            pg8::EpiBf16<0> E{WSP(bf16, WS_BO) + (size_t)br * T * 1024, D, nullptr, 0, 0, 1.f};
            pg8::gemm_phase<pg8::EpiBf16<0>, pg8::StaticOrder, true, true>(F.lds + RING_OFF, g, S, E);
        }
        GRID_BAR();
    }
    if (IN(5)) { p3b_merge(F); GRID_BAR(); }
    if (IN(6)) {
        pg8::Gemm g{WSP(bf16, WS_MERGED), WSP(bf16, WS_WO), T, D, D}; pg8::StaticOrder S; S.init(T, D, F.G, (int)blockIdx.x);
        EpiResF32 E{in_ptr(I_X), F.out, D};
        pg8::gemm_phase<EpiResF32, pg8::StaticOrder, true, true>(F.lds + RING_OFF, g, S, E);
        GRID_BAR();
    }
    if (IN(7)) { p5_route(F); GRID_BAR(); }
    if (IN(8)) { p5b_gather(F); GRID_BAR(); }
    if (IN(9)) {
        if (!IN(8)) moe_table(F);
        const volatile LAS int* tab = (const volatile LAS int*)(F.lds + TAB_OFF);
        pg8::Gemm g{WSP(bf16, WS_XG), WSP(bf16, WS_WGU), SLOTROWS, NE * 2048, D}; MoeOrder S{tab, 8, __builtin_amdgcn_readfirstlane(tab[40]), F.G, (int)blockIdx.x};
        EpiSwiglu E{WSP(bf16, WS_ACT), in_ptr(I_BGU)};
        pg8::gemm_phase<EpiSwiglu, MoeOrder, true, true>(F.lds + RING_OFF, g, S, E);
        GRID_BAR();
    }
    if (IN(10)) {
        if (!IN(8)) moe_table(F);
        const volatile LAS int* tab = (const volatile LAS int*)(F.lds + TAB_OFF);
        pg8::Gemm g{WSP(bf16, WS_ACT), WSP(bf16, WS_WD), SLOTROWS, NE * 1024, FF}; MoeOrder S{tab, 4, __builtin_amdgcn_readfirstlane(tab[40]), F.G, (int)blockIdx.x};
        pg8::EpiBf16<0> E{WSP(bf16, WS_Y), D, in_ptr(I_BD), 1024, 0, 1.f};
        pg8::gemm_phase<pg8::EpiBf16<0>, MoeOrder, true, true>(F.lds + RING_OFF, g, S, E);
        GRID_BAR();
    }
    if (IN(11)) { p8_combine(F); }
#undef IN
#undef GRID_BAR
}

extern "C" void kernel_launch(void* const* d_in, const int* in_sizes, int n_in, void* d_out, int out_size, void* d_ws, size_t ws_size, hipStream_t stream) {
    static int grid = 0;
    if (grid == 0) {
        if (n_in != 22 || out_size != T * D || ws_size < WS_END) { fprintf(stderr, "kernel_launch: unexpected problem (n_in %d, out %d, ws %zu)\n", n_in, out_size, ws_size); grid = -1; return; }
        int dev = 0, cus = 0, per_cu = 0;
        if (hipGetDevice(&dev) != hipSuccess || hipDeviceGetAttribute(&cus, hipDeviceAttributeMultiprocessorCount, dev) != hipSuccess) { grid = -1; return; }
        if (hipFuncSetAttribute((const void*)fwd_kernel, hipFuncAttributeMaxDynamicSharedMemorySize, LDS_BYTES) != hipSuccess) { fprintf(stderr, "kernel_launch: hipFuncSetAttribute failed\n"); grid = -1; return; }
        if (hipOccupancyMaxActiveBlocksPerMultiprocessor(&per_cu, (const void*)fwd_kernel, NWAVES * 64, LDS_BYTES) != hipSuccess || per_cu < 1) { fprintf(stderr, "kernel_launch: occupancy query says %d\n", per_cu); (void)hipGetLastError(); grid = -1; return; }
        grid = cus;
    }
    if (grid < 0) return;
    if (hipMemsetAsync((char*)d_ws + WS_CTL, 0, CTL_ZERO_BYTES, stream) != hipSuccess) { fprintf(stderr, "kernel_launch: memset failed\n"); return; }
    Args a{};
    for (int i = 0; i < 22; ++i) a.in[i] = (const float*)d_in[i];
    a.out = (float*)d_out; a.ws = (unsigned char*)d_ws; a.ph_lo = 0; a.ph_hi = 12;
    void* kargs[] = {&a};
    const hipError_t le = hipLaunchCooperativeKernel((const void*)fwd_kernel, dim3(grid), dim3(NWAVES * 64), kargs, LDS_BYTES, stream);
    if (le != hipSuccess) fprintf(stderr, "kernel_launch: launch failed: %s (grid %d)\n", hipGetErrorName(le), grid);
}
```

```cpp
#include <hip/hip_runtime.h>
#include <cstdio>
#include <cstdint>
namespace pg8 {
#define PG8_LAS __attribute__((address_space(3)))
typedef unsigned short bf16_t;
typedef short bf16x8 __attribute__((ext_vector_type(8)));
typedef float f32x4 __attribute__((ext_vector_type(4)));
typedef unsigned u32x4 __attribute__((ext_vector_type(4)));
constexpr int BM = 256, BK = 64, HALF = 128, HTB = HALF * BK * 2  , STAGE_BYTES = 8 * HTB, NXCD = 8, WGM = 8;

__host__ __device__ __forceinline__ int lds_byte(int r, int c) { const int st = (r >> 4) * 2 + (c >> 5), rr = r & 15, cc = c & 31, ob = rr * 64 + cc * 2; return st * 1024 + (ob ^ (((ob >> 9) & 1) << 5)); }
__host__ __device__ __forceinline__ void stage_rc(int b, int& R, int& C) { const int st = b / 1024, sb = b % 1024, swz = sb ^ (((sb >> 9) & 1) << 5); R = (st >> 1) * 16 + swz / 64; C = (st & 1) * 32 + (swz % 64) / 2; }
__host__ __device__ __forceinline__ int perm32(int rho) { const int n = rho >> 4, i = rho & 15; return 8 * (i >> 2) + 4 * n + (i & 3); }

struct Unit { int pm, pn; };
struct Gemm { const bf16_t* A; const bf16_t* Bt; int M, N, K; };

struct StaticOrder {
    int nM, nN, nwg, G, c;
    __host__ __device__ void init(int M, int N, int G_, int c_) { nM = M / BM; nN = N / BM; nwg = nM * nN; G = G_; c = c_; }
    __host__ __device__ bool next(int i, Unit& u) const {
        const long L = (long)i * G + c; if (L >= nwg) return false;
        int wgid = (int)L; { const int q = nwg / NXCD, r = nwg % NXCD, xcd = wgid % NXCD, off = wgid / NXCD; wgid = (xcd < r ? xcd * (q + 1) : r * (q + 1) + (xcd - r) * q) + off; }
        const int nig = WGM * nN, gid = wgid / nig, fm = gid * WGM, gsz = (nM - fm) < WGM ? (nM - fm) : WGM;
        u.pm = fm + ((wgid % nig) % gsz); u.pn = (wgid % nig) / gsz; return true;
    }
    __device__ __forceinline__ void a_ready(const Unit&) const {}
    __device__ __forceinline__ void done(const Unit&) const {}
};

__device__ __forceinline__ unsigned cvt_pk_bf16(float lo, float hi) { unsigned r; asm volatile("v_cvt_pk_bf16_f32 %0, %1, %2" : "=v"(r) : "v"(lo), "v"(hi)); return r; }
typedef float f32x2 __attribute__((ext_vector_type(2)));
__device__ __forceinline__ f32x2 gelu_pk(f32x2 v) {
    const f32x2 av = __builtin_elementwise_abs(v), d = av * 0.2316418882f + 1.0f;
    f32x2 t; t.x = __builtin_amdgcn_rcpf(d.x); t.y = __builtin_amdgcn_rcpf(d.y);
    f32x2 q = t * 0.5307027145f + (-0.7265760135f); q = q * t + 0.7107068705f; q = q * t + (-0.142248368f); q = q * t + 0.127414796f; q = q * t;
    const f32x2 s = (v * v) * (-0.72134752044f);
    f32x2 e; e.x = __builtin_amdgcn_exp2f(s.x); e.y = __builtin_amdgcn_exp2f(s.y);
    const f32x2 m = v * (q * e), r = v - m;
    f32x2 o; o.x = v.x < 0.f ? m.x : r.x; o.y = v.y < 0.f ? m.y : r.y; return o;
}

template <int ACT  > struct EpiBf16 {
    static constexpr int NST = 16;
    static constexpr bool PERM = true, AFTER_DRAIN = false; static_assert(ACT == 0 || ACT == 1, "EpiBf16: ACT is 0 (none) or 1 (gelu_pk)");
    bf16_t* O; int ldc; const float* bias; int split_cols; size_t split_stride; float scale0;
    __device__ __forceinline__ void operator()(const f32x4 (&acc)[2][2][4][2], const Unit& u, int wr, int wc, int fr, int fq) const {
        const int row0 = u.pm * BM + wr * 64 + fr; int colt = u.pn * BM; bf16_t* base = O;
        float sc = 1.f; if (split_cols) { const int t = colt / split_cols; base += (size_t)t * split_stride; colt -= t * split_cols; if (t == 0) sc = scale0; }
        const int col0 = colt + wc * 32 + 8 * fq, bcol0 = u.pn * BM + wc * 32 + 8 * fq;
        f32x4 bv[2][2];
#pragma unroll
        for (int bj = 0; bj < 2; ++bj)
#pragma unroll
            for (int n = 0; n < 2; ++n) bv[bj][n] = bias ? *(const f32x4*)(bias + bcol0 + bj * HALF + 4 * n) : (f32x4){0.f, 0.f, 0.f, 0.f};
#pragma unroll
        for (int ai = 0; ai < 2; ++ai)
#pragma unroll
            for (int m = 0; m < 4; ++m) { bf16_t* rowp = base + (size_t)(row0 + ai * HALF + m * 16) * ldc + col0;
#pragma unroll
                for (int bj = 0; bj < 2; ++bj) { f32x4 v0 = acc[ai][bj][m][0] + bv[bj][0], v1 = acc[ai][bj][m][1] + bv[bj][1];
                    if (ACT == 1) { f32x2 a = gelu_pk((f32x2){v0[0], v0[1]}), b = gelu_pk((f32x2){v0[2], v0[3]}), c = gelu_pk((f32x2){v1[0], v1[1]}), d = gelu_pk((f32x2){v1[2], v1[3]});
                        v0 = (f32x4){a.x, a.y, b.x, b.y}; v1 = (f32x4){c.x, c.y, d.x, d.y}; }
                    v0 = v0 * sc; v1 = v1 * sc; u32x4 w; w.x = cvt_pk_bf16(v0[0], v0[1]); w.y = cvt_pk_bf16(v0[2], v0[3]); w.z = cvt_pk_bf16(v1[0], v1[1]); w.w = cvt_pk_bf16(v1[2], v1[3]);
                    *(u32x4*)(rowp + bj * HALF) = w; } }
    }
};
template <class Epi, class Sched, bool ALIGN_EPI = false, bool SP2 = false>
__device__ __forceinline__ void gemm_phase(PG8_LAS unsigned char* lds, const Gemm g, const Sched& S, const Epi& E) {
    const int tid = threadIdx.x, wid = __builtin_amdgcn_readfirstlane(tid >> 6), lane = tid & 63, wr = wid >> 2, wc = wid & 3, fr = lane & 15, fq = lane >> 4;
    const int K = g.K, nt = K / BK;
    unsigned voffA[2], voffB[2];
#pragma unroll
    for (int i = 0; i < 2; ++i) { int R, C; stage_rc(tid * 16 + i * 8192, R, C); const int Rb = Epi::PERM ? ((R & ~31) + perm32(R & 31)) : R;
        voffA[i] = (unsigned)(R * K + C) * 2u; voffB[i] = (unsigned)(Rb * K + C) * 2u; }
    const size_t kstep = (size_t)(BK * 2);
    const size_t hstep = (size_t)HALF * K * 2;
    const size_t tstep = 2 * hstep;
    const unsigned ldsw = (unsigned)wid * 1024u;
    const int aoff = lds_byte(wr * 64 + fr, fq * 8), boff = lds_byte(wc * 32 + fr, fq * 8);
#define PG8_SA(b, h) (((b) * 2 + (h)) * HTB)
#define PG8_SB(b, h) ((4 + (b) * 2 + (h)) * HTB)
#define PG8_STAGE(bufoff, gbase, voff) do { _Pragma("unroll") for (int _i = 0; _i < 2; ++_i) \
        __builtin_amdgcn_global_load_lds((const unsigned*)((const char*)(gbase) + (voff)[_i]), (PG8_LAS unsigned*)(lds + (bufoff) + ldsw + _i * 8192), 16, 0, 0); } while (0)
#define PG8_LDA(dst, b, h) do { _Pragma("unroll") for (int m = 0; m < 4; ++m) _Pragma("unroll") for (int k = 0; k < 2; ++k) dst[m][k] = *(const PG8_LAS bf16x8*)(lds + PG8_SA(b, h) + aoff + m * 2048 + k * 1024); } while (0)
#define PG8_LDB(dst, b, h) do { _Pragma("unroll") for (int n = 0; n < 2; ++n) _Pragma("unroll") for (int k = 0; k < 2; ++k) dst[n][k] = *(const PG8_LAS bf16x8*)(lds + PG8_SB(b, h) + boff + n * 2048 + k * 1024); } while (0)
#define PG8_MMA(ai, bj, At, Bt) do { __builtin_amdgcn_s_setprio(1); _Pragma("unroll") for (int m = 0; m < 4; ++m) _Pragma("unroll") for (int n = 0; n < 2; ++n) _Pragma("unroll") for (int k = 0; k < 2; ++k) \
        acc[ai][bj][m][n] = __builtin_amdgcn_mfma_f32_16x16x32_bf16(Bt[n][k], At[m][k], acc[ai][bj][m][n], 0, 0, 0); __builtin_amdgcn_s_setprio(0); } while (0)
#define PG8_WAIT_V(n) asm volatile("s_waitcnt vmcnt(" #n ")" ::: "memory")
#define PG8_WAIT_VE(nweak, nstrong, flag) asm volatile("s_waitcnt vmcnt(%0)\n\tv_cmp_ne_u32_e32 vcc, 0, %2\n\ts_nop 3\n\ts_cbranch_vccnz 1f\n\ts_waitcnt vmcnt(%1)\n1:" :: "n"(nweak), "n"(nstrong), "v"(flag) : "memory", "vcc")
#define PG8_WAIT_L(n) asm volatile("s_waitcnt lgkmcnt(" #n ")" ::: "memory")
#define PG8_BAR __builtin_amdgcn_s_barrier()
#define PG8_SCHED __builtin_amdgcn_sched_barrier(0)
    Unit cur, nxt; int ui = 0;
    if (!S.next(0, cur)) return;
    f32x4 acc[2][2][4][2];
#pragma unroll
    for (int a = 0; a < 2; ++a)
#pragma unroll
        for (int b = 0; b < 2; ++b)
#pragma unroll
            for (int m = 0; m < 4; ++m)
#pragma unroll
                for (int n = 0; n < 2; ++n) acc[a][b][m][n] = (f32x4){0.f, 0.f, 0.f, 0.f};
    bf16x8 At[4][2], B0[2][2], B1[2][2];
    const char* cA = (const char*)g.A + (size_t)cur.pm * tstep; const char* cB = (const char*)g.Bt + (size_t)cur.pn * tstep;
    S.a_ready(cur);
    if constexpr (SP2) {
        PG8_STAGE(PG8_SB(0, 0), cB, voffB); PG8_STAGE(PG8_SB(0, 1), cB + hstep, voffB); PG8_STAGE(PG8_SA(0, 0), cA, voffA); PG8_STAGE(PG8_SA(0, 1), cA + hstep, voffA);
        if (wr == 1) PG8_BAR;
        PG8_WAIT_V(2); PG8_BAR;
        PG8_STAGE(PG8_SB(1, 0), cB + kstep, voffB); PG8_STAGE(PG8_SA(1, 0), cA + kstep, voffA); PG8_STAGE(PG8_SB(1, 1), cB + hstep + kstep, voffB);
        PG8_WAIT_V(6); PG8_BAR;
    } else {
        PG8_STAGE(PG8_SB(0, 0), cB, voffB); PG8_STAGE(PG8_SA(0, 0), cA, voffA); PG8_STAGE(PG8_SB(0, 1), cB + hstep, voffB); PG8_STAGE(PG8_SA(0, 1), cA + hstep, voffA);
        if (wr == 1) PG8_BAR;
        PG8_WAIT_V(4); PG8_BAR;
        PG8_STAGE(PG8_SB(1, 0), cB + kstep, voffB); PG8_STAGE(PG8_SA(1, 0), cA + kstep, voffA); PG8_STAGE(PG8_SB(1, 1), cB + hstep + kstep, voffB);
        PG8_WAIT_V(6); PG8_BAR;
    }
    for (;;) {
        const bool has_next = S.next(ui + 1, nxt);
        const char* nA = has_next ? (const char*)g.A + (size_t)nxt.pm * tstep : cA; const char* nB = has_next ? (const char*)g.Bt + (size_t)nxt.pn * tstep : cB;
        for (int t = 0; t < nt; t += 2) {
            const bool last = (t == nt - 2);
            const int fe = ((t == 0) && (ui > 0)) ? 1 : 0;
            const char* a1 = cA + (size_t)(t + 1) * kstep;
            const char* a2 = last ? nA : cA + (size_t)(t + 2) * kstep; const char* b2 = last ? nB : cB + (size_t)(t + 2) * kstep;
            const char* a3 = a2 + kstep; const char* b3 = b2 + kstep;
            if (last && has_next) S.a_ready(nxt);
            if constexpr (SP2) {
            PG8_LDB(B0, 0, 0); PG8_LDB(B1, 0, 1); PG8_SCHED; PG8_LDA(At, 0, 0); PG8_STAGE(PG8_SA(1, 1), a1 + hstep, voffA);
            PG8_WAIT_VE(8 + Epi::NST, 8, fe); PG8_WAIT_L(0); PG8_BAR; PG8_MMA(0, 0, At, B0); PG8_MMA(0, 1, At, B1); PG8_BAR; PG8_SCHED;
            PG8_LDA(At, 0, 1); PG8_STAGE(PG8_SB(0, 0), b2, voffB); PG8_STAGE(PG8_SB(0, 1), b2 + hstep, voffB); PG8_STAGE(PG8_SA(0, 0), a2, voffA);
            PG8_WAIT_VE(8 + Epi::NST, 8, fe); PG8_WAIT_L(0); PG8_BAR; PG8_MMA(1, 0, At, B0); PG8_MMA(1, 1, At, B1); PG8_BAR; PG8_SCHED;
            PG8_LDB(B0, 1, 0); PG8_LDB(B1, 1, 1); PG8_SCHED; PG8_LDA(At, 1, 0); PG8_STAGE(PG8_SA(0, 1), a2 + hstep, voffA);
            PG8_WAIT_V(8); PG8_WAIT_L(0); PG8_BAR; PG8_MMA(0, 0, At, B0); PG8_MMA(0, 1, At, B1); PG8_BAR; PG8_SCHED;
            PG8_LDA(At, 1, 1); PG8_STAGE(PG8_SB(1, 0), b3, voffB); PG8_STAGE(PG8_SB(1, 1), b3 + hstep, voffB); PG8_STAGE(PG8_SA(1, 0), a3, voffA);
            PG8_WAIT_V(8); PG8_WAIT_L(0); PG8_BAR; PG8_MMA(1, 0, At, B0); PG8_MMA(1, 1, At, B1); PG8_BAR; PG8_SCHED;
            } else {
            PG8_LDB(B0, 0, 0); PG8_SCHED; PG8_LDA(At, 0, 0); PG8_STAGE(PG8_SA(1, 1), a1 + hstep, voffA);
            PG8_WAIT_L(8); PG8_BAR; PG8_WAIT_L(0); PG8_MMA(0, 0, At, B0); PG8_BAR; PG8_SCHED;
            PG8_LDB(B1, 0, 1); PG8_STAGE(PG8_SB(0, 0), b2, voffB);
            PG8_BAR; PG8_WAIT_L(0); PG8_MMA(0, 1, At, B1); PG8_BAR;
            PG8_LDA(At, 0, 1); PG8_STAGE(PG8_SA(0, 0), a2, voffA);
            PG8_BAR; PG8_WAIT_L(0); PG8_MMA(1, 0, At, B0); PG8_BAR; PG8_SCHED;
            PG8_STAGE(PG8_SB(0, 1), b2 + hstep, voffB);
            PG8_WAIT_V(6); PG8_BAR; PG8_MMA(1, 1, At, B1); PG8_BAR;
            PG8_LDB(B0, 1, 0); PG8_SCHED; PG8_LDA(At, 1, 0); PG8_STAGE(PG8_SA(0, 1), a2 + hstep, voffA);
            PG8_WAIT_L(8); PG8_BAR; PG8_WAIT_L(0); PG8_MMA(0, 0, At, B0); PG8_BAR; PG8_SCHED;
            PG8_LDB(B1, 1, 1); PG8_STAGE(PG8_SB(1, 0), b3, voffB);
            PG8_BAR; PG8_WAIT_L(0); PG8_MMA(0, 1, At, B1); PG8_BAR;
            PG8_LDA(At, 1, 1); PG8_STAGE(PG8_SA(1, 0), a3, voffA);
            PG8_BAR; PG8_WAIT_L(0); PG8_MMA(1, 0, At, B0); PG8_BAR; PG8_SCHED;
            PG8_STAGE(PG8_SB(1, 1), b3 + hstep, voffB);
            PG8_WAIT_V(6); PG8_BAR; PG8_MMA(1, 1, At, B1); PG8_BAR;
            }
        }
        if constexpr (ALIGN_EPI) { if (wr == 0) PG8_BAR; }
        if constexpr (!Epi::AFTER_DRAIN) { E(acc, cur, wr, wc, fr, fq); S.done(cur); }
        if (!has_next) break;
#pragma unroll
        for (int a = 0; a < 2; ++a)
#pragma unroll
            for (int b = 0; b < 2; ++b)
#pragma unroll
                for (int m = 0; m < 4; ++m)
#pragma unroll
                    for (int n = 0; n < 2; ++n) acc[a][b][m][n] = (f32x4){0.f, 0.f, 0.f, 0.f};
        cur = nxt; cA = nA; cB = nB; ++ui;
        if constexpr (ALIGN_EPI) { if (wr == 1) PG8_BAR; }
    }
    PG8_WAIT_V(0);
    if constexpr (!ALIGN_EPI) { if (wr == 0) PG8_BAR; }
    PG8_BAR;
    if constexpr (Epi::AFTER_DRAIN) { E.fused(acc, cur, wr, wc, fr, fq, lds, wid, lane); S.done(cur); }
#undef PG8_SA
#undef PG8_SB
#undef PG8_STAGE
#undef PG8_LDA
#undef PG8_LDB
#undef PG8_MMA
#undef PG8_WAIT_V
#undef PG8_WAIT_VE
#undef PG8_WAIT_L
#undef PG8_BAR
#undef PG8_SCHED
}
}

#ifndef PG8_SP2
#define PG8_SP2 true
#endif
#ifndef PG8_ALIGN
#define PG8_ALIGN true
#endif
namespace pg8 {
typedef int i32x4 __attribute__((ext_vector_type(4)));
typedef int i32x8 __attribute__((ext_vector_type(8)));
struct Gemm8 { const unsigned char* A; const unsigned char* Bt; int M, N, K; };
template <class Epi, class Sched, bool ALIGN_EPI = false, bool SP2 = false>
__device__ __forceinline__ void gemm_phase_f8(PG8_LAS unsigned char* lds, const Gemm8 g, const Sched& S, const Epi& E) {
    const int tid = threadIdx.x, wid = __builtin_amdgcn_readfirstlane(tid >> 6), lane = tid & 63, wr = wid >> 2, wc = wid & 3, fr = lane & 15, fq = lane >> 4;
    const int K = g.K, nt = K / 128;
    unsigned voffA[2], voffB[2];
#pragma unroll
    for (int i = 0; i < 2; ++i) { int R, C; stage_rc(tid * 16 + i * 8192, R, C); const int Rb = Epi::PERM ? ((R & ~31) + perm32(R & 31)) : R;
        voffA[i] = (unsigned)(R * K + C * 2); voffB[i] = (unsigned)(Rb * K + C * 2); }
    const size_t kstep = (size_t)(BK * 2);
    const size_t hstep = (size_t)HALF * K;
    const size_t tstep = 2 * hstep;
    const unsigned ldsw = (unsigned)wid * 1024u;
    const int aoff = lds_byte(wr * 64 + fr, fq * 8), boff = lds_byte(wc * 32 + fr, fq * 8);
#define PG8_SA(b, h) (((b) * 2 + (h)) * HTB)
#define PG8_SB(b, h) ((4 + (b) * 2 + (h)) * HTB)
#define PG8_STAGE(bufoff, gbase, voff) do { _Pragma("unroll") for (int _i = 0; _i < 2; ++_i) \
        __builtin_amdgcn_global_load_lds((const unsigned*)((const char*)(gbase) + (voff)[_i]), (PG8_LAS unsigned*)(lds + (bufoff) + ldsw + _i * 8192), 16, 0, 0); } while (0)
#define PG8_LD32(p) __builtin_shufflevector(*(const PG8_LAS i32x4*)(p), *(const PG8_LAS i32x4*)((p) + 1024), 0, 1, 2, 3, 4, 5, 6, 7)
#define PG8_LDA(dst, b, h) do { _Pragma("unroll") for (int m = 0; m < 4; ++m) dst[m] = PG8_LD32(lds + PG8_SA(b, h) + aoff + m * 2048); } while (0)
#define PG8_LDB(dst, b, h) do { _Pragma("unroll") for (int n = 0; n < 2; ++n) dst[n] = PG8_LD32(lds + PG8_SB(b, h) + boff + n * 2048); } while (0)
#define PG8_MMA(ai, bj, At, Bt) do { __builtin_amdgcn_s_setprio(1); _Pragma("unroll") for (int m = 0; m < 4; ++m) _Pragma("unroll") for (int n = 0; n < 2; ++n) \
        asm volatile("v_mfma_scale_f32_16x16x128_f8f6f4 %0, %1, %2, %0, %3, %3 op_sel_hi:[0,0,0]" : "+v"(acc[ai][bj][m][n]) : "v"(Bt[n]), "v"(At[m]), "v"(one_scale)); __builtin_amdgcn_s_setprio(0); } while (0)
#define PG8_WAIT_V(n) asm volatile("s_waitcnt vmcnt(" #n ")" ::: "memory")
#define PG8_WAIT_VE(nweak, nstrong, flag) asm volatile("s_waitcnt vmcnt(%0)\n\tv_cmp_ne_u32_e32 vcc, 0, %2\n\ts_nop 3\n\ts_cbranch_vccnz 1f\n\ts_waitcnt vmcnt(%1)\n1:" :: "n"(nweak), "n"(nstrong), "v"(flag) : "memory", "vcc")
#define PG8_WAIT_L(n) asm volatile("s_waitcnt lgkmcnt(" #n ")" ::: "memory")
#define PG8_BAR __builtin_amdgcn_s_barrier()
#define PG8_SCHED __builtin_amdgcn_sched_barrier(0)
    Unit cur, nxt; int ui = 0;
    if (!S.next(0, cur)) return;
    f32x4 acc[2][2][4][2];
#pragma unroll
    for (int a = 0; a < 2; ++a)
#pragma unroll
        for (int b = 0; b < 2; ++b)
#pragma unroll
            for (int m = 0; m < 4; ++m)
#pragma unroll
                for (int n = 0; n < 2; ++n) acc[a][b][m][n] = (f32x4){0.f, 0.f, 0.f, 0.f};
    i32x8 At[4], B0[2], B1[2];
    int one_scale = 0x7f7f7f7f; asm volatile("" : "+v"(one_scale));
    const char* cA = (const char*)g.A + (size_t)cur.pm * tstep; const char* cB = (const char*)g.Bt + (size_t)cur.pn * tstep;
    S.a_ready(cur);
    if constexpr (SP2) {
        PG8_STAGE(PG8_SB(0, 0), cB, voffB); PG8_STAGE(PG8_SB(0, 1), cB + hstep, voffB); PG8_STAGE(PG8_SA(0, 0), cA, voffA); PG8_STAGE(PG8_SA(0, 1), cA + hstep, voffA);
        if (wr == 1) PG8_BAR;
        PG8_WAIT_V(2); PG8_BAR;
        PG8_STAGE(PG8_SB(1, 0), cB + kstep, voffB); PG8_STAGE(PG8_SA(1, 0), cA + kstep, voffA); PG8_STAGE(PG8_SB(1, 1), cB + hstep + kstep, voffB);
        PG8_WAIT_V(6); PG8_BAR;
    } else {
        PG8_STAGE(PG8_SB(0, 0), cB, voffB); PG8_STAGE(PG8_SA(0, 0), cA, voffA); PG8_STAGE(PG8_SB(0, 1), cB + hstep, voffB); PG8_STAGE(PG8_SA(0, 1), cA + hstep, voffA);
        if (wr == 1) PG8_BAR;
        PG8_WAIT_V(4); PG8_BAR;
        PG8_STAGE(PG8_SB(1, 0), cB + kstep, voffB); PG8_STAGE(PG8_SA(1, 0), cA + kstep, voffA); PG8_STAGE(PG8_SB(1, 1), cB + hstep + kstep, voffB);
        PG8_WAIT_V(6); PG8_BAR;
    }
    for (;;) {
        const bool has_next = S.next(ui + 1, nxt);
        const char* nA = has_next ? (const char*)g.A + (size_t)nxt.pm * tstep : cA; const char* nB = has_next ? (const char*)g.Bt + (size_t)nxt.pn * tstep : cB;
_Pragma("unroll 1")
        for (int t = 0; t < nt; t += 2) {
            const bool last = (t == nt - 2);
            const int fe = ((t == 0) && (ui > 0)) ? 1 : 0;
            const char* a1 = cA + (size_t)(t + 1) * kstep;
            const char* a2 = last ? nA : cA + (size_t)(t + 2) * kstep; const char* b2 = last ? nB : cB + (size_t)(t + 2) * kstep;
            const char* a3 = a2 + kstep; const char* b3 = b2 + kstep;
            if (last && has_next) S.a_ready(nxt);
            if constexpr (SP2) {
            PG8_LDB(B0, 0, 0); PG8_LDB(B1, 0, 1); PG8_SCHED; PG8_LDA(At, 0, 0); PG8_STAGE(PG8_SA(1, 1), a1 + hstep, voffA);
            PG8_WAIT_VE(8 + Epi::NST, 8, fe); PG8_WAIT_L(0); PG8_BAR; PG8_MMA(0, 0, At, B0); PG8_MMA(0, 1, At, B1); PG8_BAR; PG8_SCHED;
            PG8_LDA(At, 0, 1); PG8_STAGE(PG8_SB(0, 0), b2, voffB); PG8_STAGE(PG8_SB(0, 1), b2 + hstep, voffB); PG8_STAGE(PG8_SA(0, 0), a2, voffA);
            PG8_WAIT_VE(8 + Epi::NST, 8, fe); PG8_WAIT_L(0); PG8_BAR; PG8_MMA(1, 0, At, B0); PG8_MMA(1, 1, At, B1); PG8_BAR; PG8_SCHED;
            PG8_LDB(B0, 1, 0); PG8_LDB(B1, 1, 1); PG8_SCHED; PG8_LDA(At, 1, 0); PG8_STAGE(PG8_SA(0, 1), a2 + hstep, voffA);
            PG8_WAIT_V(8); PG8_WAIT_L(0); PG8_BAR; PG8_MMA(0, 0, At, B0); PG8_MMA(0, 1, At, B1); PG8_BAR; PG8_SCHED;
            PG8_LDA(At, 1, 1); PG8_STAGE(PG8_SB(1, 0), b3, voffB); PG8_STAGE(PG8_SB(1, 1), b3 + hstep, voffB); PG8_STAGE(PG8_SA(1, 0), a3, voffA);
            PG8_WAIT_V(8); PG8_WAIT_L(0); PG8_BAR; PG8_MMA(1, 0, At, B0); PG8_MMA(1, 1, At, B1); PG8_BAR; PG8_SCHED;
            } else {
            PG8_LDB(B0, 0, 0); PG8_SCHED; PG8_LDA(At, 0, 0); PG8_STAGE(PG8_SA(1, 1), a1 + hstep, voffA);
            PG8_WAIT_L(8); PG8_BAR; PG8_WAIT_L(0); PG8_MMA(0, 0, At, B0); PG8_BAR; PG8_SCHED;
            PG8_LDB(B1, 0, 1); PG8_STAGE(PG8_SB(0, 0), b2, voffB);
            PG8_BAR; PG8_WAIT_L(0); PG8_MMA(0, 1, At, B1); PG8_BAR;
            PG8_LDA(At, 0, 1); PG8_STAGE(PG8_SA(0, 0), a2, voffA);
            PG8_BAR; PG8_WAIT_L(0); PG8_MMA(1, 0, At, B0); PG8_BAR; PG8_SCHED;
            PG8_STAGE(PG8_SB(0, 1), b2 + hstep, voffB);
            PG8_WAIT_V(6); PG8_BAR; PG8_MMA(1, 1, At, B1); PG8_BAR;
            PG8_LDB(B0, 1, 0); PG8_SCHED; PG8_LDA(At, 1, 0); PG8_STAGE(PG8_SA(0, 1), a2 + hstep, voffA);
            PG8_WAIT_L(8); PG8_BAR; PG8_WAIT_L(0); PG8_MMA(0, 0, At, B0); PG8_BAR; PG8_SCHED;
            PG8_LDB(B1, 1, 1); PG8_STAGE(PG8_SB(1, 0), b3, voffB);
            PG8_BAR; PG8_WAIT_L(0); PG8_MMA(0, 1, At, B1); PG8_BAR;
            PG8_LDA(At, 1, 1); PG8_STAGE(PG8_SA(1, 0), a3, voffA);
            PG8_BAR; PG8_WAIT_L(0); PG8_MMA(1, 0, At, B0); PG8_BAR; PG8_SCHED;
            PG8_STAGE(PG8_SB(1, 1), b3 + hstep, voffB);
            PG8_WAIT_V(6); PG8_BAR; PG8_MMA(1, 1, At, B1); PG8_BAR;
            }
        }
        asm volatile("s_nop 15\n\ts_nop 15" ::: "memory");
        if constexpr (ALIGN_EPI) { if (wr == 0) PG8_BAR; }
        if constexpr (!Epi::AFTER_DRAIN) { E(acc, cur, wr, wc, fr, fq); S.done(cur); }
        if (!has_next) break;
#pragma unroll
        for (int a = 0; a < 2; ++a)
#pragma unroll
            for (int b = 0; b < 2; ++b)
#pragma unroll
                for (int m = 0; m < 4; ++m)
#pragma unroll
                    for (int n = 0; n < 2; ++n) acc[a][b][m][n] = (f32x4){0.f, 0.f, 0.f, 0.f};
        cur = nxt; cA = nA; cB = nB; ++ui;
        if constexpr (ALIGN_EPI) { if (wr == 1) PG8_BAR; }
    }
    PG8_WAIT_V(0);
    if constexpr (!ALIGN_EPI) { if (wr == 0) PG8_BAR; }
    PG8_BAR;
    if constexpr (Epi::AFTER_DRAIN) { E.fused(acc, cur, wr, wc, fr, fq, lds, wid, lane); S.done(cur); }
#undef PG8_SA
#undef PG8_SB
#undef PG8_STAGE
#undef PG8_LD32
#undef PG8_LDA
#undef PG8_LDB
#undef PG8_MMA
#undef PG8_WAIT_V
#undef PG8_WAIT_VE
#undef PG8_WAIT_L
#undef PG8_BAR
#undef PG8_SCHED
}
}
namespace pg8 {
template <class Epi, class Sched, bool ALIGN_EPI = false, bool SP2 = true>
__device__ __forceinline__ void gemm_phase_f8g(PG8_LAS unsigned char* lds, PG8_LAS int* itab, const Gemm8 g, const Sched& S, const Epi& E) {
    static_assert(SP2, "gather variant: SP2 schedule only");
    const int tid = threadIdx.x, wid = __builtin_amdgcn_readfirstlane(tid >> 6), lane = tid & 63, wr = wid >> 2, wc = wid & 3, fr = lane & 15, fq = lane >> 4;
    const int K = g.K, nt = K / 128;
    unsigned voffB[2], colA[2]; int rowA[2];
#pragma unroll
    for (int i = 0; i < 2; ++i) { int R, C; stage_rc(tid * 16 + i * 8192, R, C); const int Rb = Epi::PERM ? ((R & ~31) + perm32(R & 31)) : R;
        rowA[i] = R; colA[i] = (unsigned)(C * 2); voffB[i] = (unsigned)(Rb * K + C * 2); }
    unsigned vc[2][2], vn[2][2];
#define PG8_IDX_DMA(u_, buf_) do { if (wid < 4) { const int* lp_ = S.rows_list(u_); \
        __builtin_amdgcn_global_load_lds((const unsigned*)(lp_ + 64 * wid + lane), (PG8_LAS unsigned*)(itab + (buf_) * 256 + 64 * wid), 4, 0, 0); } } while (0)
#define PG8_IDX_READ(dst_, u_, buf_) do { const int nr_ = S.nrows(u_); _Pragma("unroll") for (int h_ = 0; h_ < 2; ++h_) _Pragma("unroll") for (int i_ = 0; i_ < 2; ++i_) { \
        const int r_ = h_ * HALF + rowA[i_]; const int t_ = itab[(buf_) * 256 + r_]; dst_[h_][i_] = (unsigned)((r_ < nr_ ? t_ : 0) * K) + colA[i_]; } } while (0)
    const size_t kstep = (size_t)(BK * 2);
    const size_t hstep = (size_t)HALF * K;
    const size_t tstep = 2 * hstep;
    const unsigned ldsw = (unsigned)wid * 1024u;
    const int aoff = lds_byte(wr * 64 + fr, fq * 8), boff = lds_byte(wc * 32 + fr, fq * 8);
#define PG8_SA(b, h) (((b) * 2 + (h)) * HTB)
#define PG8_SB(b, h) ((4 + (b) * 2 + (h)) * HTB)
#define PG8_STAGE(bufoff, gbase, voff) do { _Pragma("unroll") for (int _i = 0; _i < 2; ++_i) \
        __builtin_amdgcn_global_load_lds((const unsigned*)((const char*)(gbase) + (voff)[_i]), (PG8_LAS unsigned*)(lds + (bufoff) + ldsw + _i * 8192), 16, 0, 0); } while (0)
#define PG8_LD32(p) __builtin_shufflevector(*(const PG8_LAS i32x4*)(p), *(const PG8_LAS i32x4*)((p) + 1024), 0, 1, 2, 3, 4, 5, 6, 7)
#define PG8_LDA(dst, b, h) do { _Pragma("unroll") for (int m = 0; m < 4; ++m) dst[m] = PG8_LD32(lds + PG8_SA(b, h) + aoff + m * 2048); } while (0)
#define PG8_LDB(dst, b, h) do { _Pragma("unroll") for (int n = 0; n < 2; ++n) dst[n] = PG8_LD32(lds + PG8_SB(b, h) + boff + n * 2048); } while (0)
#define PG8_MMA(ai, bj, At, Bt) do { __builtin_amdgcn_s_setprio(1); _Pragma("unroll") for (int m = 0; m < 4; ++m) _Pragma("unroll") for (int n = 0; n < 2; ++n) \
        asm volatile("v_mfma_scale_f32_16x16x128_f8f6f4 %0, %1, %2, %0, %3, %3 op_sel_hi:[0,0,0]" : "+v"(acc[ai][bj][m][n]) : "v"(Bt[n]), "v"(At[m]), "v"(one_scale)); __builtin_amdgcn_s_setprio(0); } while (0)
#define PG8_WAIT_V(n) asm volatile("s_waitcnt vmcnt(" #n ")" ::: "memory")
#define PG8_WAIT_VE(nweak, nstrong, flag) asm volatile("s_waitcnt vmcnt(%0)\n\tv_cmp_ne_u32_e32 vcc, 0, %2\n\ts_nop 3\n\ts_cbranch_vccnz 1f\n\ts_waitcnt vmcnt(%1)\n1:" :: "n"(nweak), "n"(nstrong), "v"(flag) : "memory", "vcc")
#define PG8_WAIT_L(n) asm volatile("s_waitcnt lgkmcnt(" #n ")" ::: "memory")
#define PG8_BAR __builtin_amdgcn_s_barrier()
#define PG8_SCHED __builtin_amdgcn_sched_barrier(0)
    Unit cur, nxt; int ui = 0;
    if (!S.next(0, cur)) return;
    f32x4 acc[2][2][4][2];
#pragma unroll
    for (int a = 0; a < 2; ++a)
#pragma unroll
        for (int b = 0; b < 2; ++b)
#pragma unroll
            for (int m = 0; m < 4; ++m)
#pragma unroll
                for (int n = 0; n < 2; ++n) acc[a][b][m][n] = (f32x4){0.f, 0.f, 0.f, 0.f};
    i32x8 At[4], B0[2], B1[2];
    int one_scale = 0x7f7f7f7f; asm volatile("" : "+v"(one_scale));
    const char* gA = (const char*)g.A; const char* cB = (const char*)g.Bt + (size_t)cur.pn * tstep;
    S.a_ready(cur);
    PG8_IDX_DMA(cur, 0); PG8_WAIT_V(0); PG8_BAR; PG8_IDX_READ(vc, cur, 0);
    if constexpr (SP2) {
        PG8_STAGE(PG8_SB(0, 0), cB, voffB); PG8_STAGE(PG8_SB(0, 1), cB + hstep, voffB); PG8_STAGE(PG8_SA(0, 0), gA, vc[0]); PG8_STAGE(PG8_SA(0, 1), gA, vc[1]);
        if (wr == 1) PG8_BAR;
        PG8_WAIT_V(2); PG8_BAR;
        PG8_STAGE(PG8_SB(1, 0), cB + kstep, voffB); PG8_STAGE(PG8_SA(1, 0), gA + kstep, vc[0]); PG8_STAGE(PG8_SB(1, 1), cB + hstep + kstep, voffB);
        PG8_WAIT_V(6); PG8_BAR;
    }
    for (;;) {
        const bool has_next = S.next(ui + 1, nxt);
        const char* nB = has_next ? (const char*)g.Bt + (size_t)nxt.pn * tstep : cB;
        if (has_next) PG8_IDX_DMA(nxt, (ui + 1) & 1);
_Pragma("unroll 1")
        for (int t = 0; t < nt; t += 2) {
            const bool last = (t == nt - 2);
            const int fe = ((t == 0) && (ui > 0)) ? 1 : 0;
            const char* a1 = gA + (size_t)(t + 1) * kstep;
            const char* a2 = gA + (last ? (size_t)0 : (size_t)(t + 2) * kstep); const char* b2 = last ? nB : cB + (size_t)(t + 2) * kstep;
            const char* a3 = a2 + kstep; const char* b3 = b2 + kstep;
            if (last) { if (has_next) { S.a_ready(nxt); PG8_IDX_READ(vn, nxt, (ui + 1) & 1); } else { _Pragma("unroll") for (int h_ = 0; h_ < 2; ++h_) _Pragma("unroll") for (int i_ = 0; i_ < 2; ++i_) vn[h_][i_] = vc[h_][i_]; } }
            unsigned s0[2], s1[2];
            _Pragma("unroll") for (int i_ = 0; i_ < 2; ++i_) { s0[i_] = last ? vn[0][i_] : vc[0][i_]; s1[i_] = last ? vn[1][i_] : vc[1][i_]; }
            if constexpr (SP2) {
            PG8_LDB(B0, 0, 0); PG8_LDB(B1, 0, 1); PG8_SCHED; PG8_LDA(At, 0, 0); PG8_STAGE(PG8_SA(1, 1), a1, vc[1]);
            PG8_WAIT_VE(8 + Epi::NST, 8, fe); PG8_WAIT_L(0); PG8_BAR; PG8_MMA(0, 0, At, B0); PG8_MMA(0, 1, At, B1); PG8_BAR; PG8_SCHED;
            PG8_LDA(At, 0, 1); PG8_STAGE(PG8_SB(0, 0), b2, voffB); PG8_STAGE(PG8_SB(0, 1), b2 + hstep, voffB); PG8_STAGE(PG8_SA(0, 0), a2, s0);
            PG8_WAIT_VE(8 + Epi::NST, 8, fe); PG8_WAIT_L(0); PG8_BAR; PG8_MMA(1, 0, At, B0); PG8_MMA(1, 1, At, B1); PG8_BAR; PG8_SCHED;
            PG8_LDB(B0, 1, 0); PG8_LDB(B1, 1, 1); PG8_SCHED; PG8_LDA(At, 1, 0); PG8_STAGE(PG8_SA(0, 1), a2, s1);
            PG8_WAIT_V(8); PG8_WAIT_L(0); PG8_BAR; PG8_MMA(0, 0, At, B0); PG8_MMA(0, 1, At, B1); PG8_BAR; PG8_SCHED;
            PG8_LDA(At, 1, 1); PG8_STAGE(PG8_SB(1, 0), b3, voffB); PG8_STAGE(PG8_SB(1, 1), b3 + hstep, voffB); PG8_STAGE(PG8_SA(1, 0), a3, s0);
            PG8_WAIT_V(8); PG8_WAIT_L(0); PG8_BAR; PG8_MMA(1, 0, At, B0); PG8_MMA(1, 1, At, B1); PG8_BAR; PG8_SCHED;
            }
        }
        asm volatile("s_nop 15\n\ts_nop 15" ::: "memory");
        if constexpr (ALIGN_EPI) { if (wr == 0) PG8_BAR; }
        if constexpr (!Epi::AFTER_DRAIN) { E(acc, cur, wr, wc, fr, fq); S.done(cur); }
        if (!has_next) break;
#pragma unroll
        for (int a = 0; a < 2; ++a)
#pragma unroll
            for (int b = 0; b < 2; ++b)
#pragma unroll
                for (int m = 0; m < 4; ++m)
#pragma unroll
                    for (int n = 0; n < 2; ++n) acc[a][b][m][n] = (f32x4){0.f, 0.f, 0.f, 0.f};
        cur = nxt; cB = nB; ++ui;
        _Pragma("unroll") for (int h_ = 0; h_ < 2; ++h_) _Pragma("unroll") for (int i_ = 0; i_ < 2; ++i_) vc[h_][i_] = vn[h_][i_];
        if constexpr (ALIGN_EPI) { if (wr == 1) PG8_BAR; }
    }
    PG8_WAIT_V(0);
    if constexpr (!ALIGN_EPI) { if (wr == 0) PG8_BAR; }
    PG8_BAR;
    if constexpr (Epi::AFTER_DRAIN) { E.fused(acc, cur, wr, wc, fr, fq, lds, wid, lane); S.done(cur); }
#undef PG8_SA
#undef PG8_SB
#undef PG8_STAGE
#undef PG8_IDX_DMA
#undef PG8_IDX_READ
#undef PG8_LD32
#undef PG8_LDA
#undef PG8_LDB
#undef PG8_MMA
#undef PG8_WAIT_V
#undef PG8_WAIT_VE
#undef PG8_WAIT_L
#undef PG8_BAR
#undef PG8_SCHED
}
}
constexpr int NWAVES = 8;
constexpr int BATCH = 4, SEQ = 4096, T = BATCH * SEQ, D = 1024, INW = 6656;
constexpr int C_Q = 0, C_K = 512, C_V = 1024, C_CB = 1536, C_CC = 2048, C_CX = 2560, C_QM = 3072, C_G = 3584;
constexpr int MEMT = 256, MROWS = BATCH * MEMT;
constexpr int NE = 32, FF = 1024, TOPK = 4;
constexpr int MAXTILES = 288, SLOTROWS = MAXTILES * 256;
constexpr float RMS_EPS = 1e-6f;

constexpr size_t MiB = 1u << 20;
constexpr size_t WS_CTL = 0, CTL_ZERO_BYTES = 1 * MiB;
constexpr size_t WS_ROUTE = 1 * MiB;
constexpr size_t WS_WIN = 2 * MiB, WS_WKV = 15 * MiB, WS_WBR = 17 * MiB, WS_WO = 20 * MiB, WS_MEMN = 22 * MiB, WS_KV = 24 * MiB;
constexpr size_t WS_WGU = 26 * MiB, WS_WD = 154 * MiB, WS_XN = 218 * MiB, WS_MERGED = 250 * MiB, WS_Y = 282 * MiB;
constexpr size_t WS_PROJ = 426 * MiB, WS_OBR = 634 * MiB, WS_BO = 682 * MiB, WS_END = 778 * MiB;
constexpr size_t WS_WIN8 = 90 * MiB, WS_XN8 = 100 * MiB;
constexpr size_t WS_HF8 = 426 * MiB, WS_LIST = 458 * MiB;
constexpr size_t WS_SSQ = 460 * MiB;
constexpr size_t WS_XG = 426 * MiB, WS_ACT = 570 * MiB;
static_assert(WS_XG + (size_t)SLOTROWS * 1024 * 2 <= WS_ACT && WS_ACT + (size_t)SLOTROWS * 1024 * 2 <= WS_END, "overlay map");
static_assert(WS_Y + (size_t)SLOTROWS * 1024 * 2 <= WS_PROJ && WS_PROJ + (size_t)T * INW * 2 <= WS_OBR, "d_ws map");
constexpr int CW_BAR = 4096;
constexpr int CW_CNT = 8192;

constexpr int RING_OFF = 0, RING_BYTES = 131072;
constexpr int LDSCTL_OFF = 139264, MISC_OFF = LDSCTL_OFF + 320;
constexpr int TAB_OFF = LDSCTL_OFF + 1024;
constexpr int LDS_BYTES = 147456;

#define GAS __attribute__((address_space(1)))
#define LAS __attribute__((address_space(3)))
typedef unsigned short bf16;
typedef unsigned v4u __attribute__((ext_vector_type(4)));
typedef float f32x4 __attribute__((ext_vector_type(4)));
typedef short bf16x8 __attribute__((ext_vector_type(8)));
typedef GAS unsigned gu32;
typedef GAS unsigned long long gu64;
#define RLX_AGENT __ATOMIC_RELAXED, __HIP_MEMORY_SCOPE_AGENT
#define LDS_WAIT() asm volatile("s_waitcnt lgkmcnt(0)" ::: "memory")
#define VM_WAIT() asm volatile("s_waitcnt vmcnt(0)" ::: "memory")
__device__ __forceinline__ unsigned long long rt() { return __builtin_amdgcn_s_memrealtime(); }
__device__ __forceinline__ unsigned f2bf(float f) { unsigned u = __builtin_bit_cast(unsigned, f); return (u + 0x7fffu + ((u >> 16) & 1u)) >> 16; }
__device__ __forceinline__ unsigned pk2(float lo, float hi) { return f2bf(lo) | (f2bf(hi) << 16); }

#define XB_TMO      128
#define XB_XCNT(j)  (256  + 64 * (j))
#define XB_XSUB(j)  (1280 + 64 * (j))
#define XB_XGEN(j)  (2304 + 64 * (j))
#define XB_TOP      3328
#define XB_TOPGEN   3392
#define XCD_BAR_WORDS 3456
#define XB_SPIN_CAP (1u << 18)

__device__ __forceinline__ unsigned xb_ld(unsigned* p)              { return __hip_atomic_load(p, __ATOMIC_RELAXED, __HIP_MEMORY_SCOPE_AGENT); }
__device__ __forceinline__ unsigned xb_add(unsigned* p, unsigned v) { return __hip_atomic_fetch_add(p, v, __ATOMIC_RELAXED, __HIP_MEMORY_SCOPE_AGENT); }
__device__ __forceinline__ unsigned xb_xcc_id() { return (unsigned)__builtin_amdgcn_s_getreg((3 << 11) | 20) & 0xFu; }
#define XB_SPIN(cond, bar) do { unsigned _sp = 0; while (cond) { __builtin_amdgcn_s_sleep(1); \
    if ((++_sp & 255u) == 0u) { if (xb_ld(&(bar)[XB_TMO])) break; if (_sp > XB_SPIN_CAP) { atomicAdd(&(bar)[XB_TMO], 1u); break; } } } } while (0)

struct XcdBarrier {
    unsigned* bar; unsigned x;
    volatile LAS unsigned* st;
};

__device__ __forceinline__ XcdBarrier xcd_barrier_post(unsigned* bar, volatile LAS unsigned* st) {
    XcdBarrier b; b.bar = bar; b.x = xb_xcc_id(); b.st = st;
    if (threadIdx.x == 0) (void)xb_add(&bar[XB_XCNT(b.x)], 1u);
    return b;
}
__device__ __forceinline__ void xcd_barrier_complete(unsigned* bar, unsigned x, unsigned& nloc, unsigned& nx) {
    const unsigned G = gridDim.x * gridDim.y * gridDim.z;
    unsigned sum, cnt, mine, sp = 0u;
    for (;;) {
        sum = 0u; cnt = 0u; mine = 0u;
#pragma unroll
        for (unsigned j = 0; j < 16; ++j) { const unsigned c = xb_ld(&bar[XB_XCNT(j)]); sum += c; cnt += (c > 0u) ? 1u : 0u; mine = (j == x) ? c : mine; }
        if (sum == G) break;
        __builtin_amdgcn_s_sleep(1);
        if ((++sp & 255u) == 0u) { if (xb_ld(&bar[XB_TMO])) break; if (sp > XB_SPIN_CAP) { atomicAdd(&bar[XB_TMO], 1u); break; } }
    }
    nloc = mine > 0u ? mine : 1u; nx = cnt > 0u ? cnt : 1u;
}

__device__ __forceinline__ void xcd_barrier(const XcdBarrier& b) {
    asm volatile("s_waitcnt vmcnt(0)" ::: "memory");
    __syncthreads();
    if (threadIdx.x == 0) {
        unsigned* bar = b.bar;
        __builtin_amdgcn_s_waitcnt(0);
        unsigned nloc = b.st[0], nx = b.st[1];
        if (nloc == 0u) { xcd_barrier_complete(bar, b.x, nloc, nx); b.st[0] = nloc; b.st[1] = nx; }
        const unsigned old = xb_add(&bar[XB_XSUB(b.x)], 1u);
        const unsigned gen = old / nloc;
        if (old + 1u == (gen + 1u) * nloc) {
            __builtin_amdgcn_fence(__ATOMIC_RELEASE, "agent");
            asm volatile("s_waitcnt vmcnt(0)" ::: "memory");
            const unsigned og = xb_add(&bar[XB_TOP], 1u);
            const unsigned tg = og / nx;
            if (og + 1u == (tg + 1u) * nx) xb_add(&bar[XB_TOPGEN], 1u);
            else XB_SPIN(xb_ld(&bar[XB_TOPGEN]) == tg, bar);
            __builtin_amdgcn_fence(__ATOMIC_ACQUIRE, "agent");
            xb_add(&bar[XB_XGEN(b.x)], 1u);
            asm volatile("s_waitcnt vmcnt(0)" ::: "memory");
        } else {
            XB_SPIN(xb_ld(&bar[XB_XGEN(b.x)]) == gen, bar);
            __builtin_amdgcn_fence(__ATOMIC_ACQUIRE, "agent");
            asm volatile("s_waitcnt vmcnt(0)" ::: "memory");
        }
    }
    __syncthreads();
}

struct Frame {
    LAS unsigned char* lds;
    volatile LAS unsigned* MISC;
    gu32* ctl;
    unsigned char* ws; float* out;
    int tid, lane, wave, vcu, G;
};
typedef const __attribute__((address_space(4))) char* kargp_t;
__device__ __forceinline__ const float* in_ptr(int i) {
    kargp_t kp = (kargp_t)__builtin_amdgcn_kernarg_segment_ptr();
    asm volatile("" : "+s"(kp));
    return *(const float* const __attribute__((address_space(4)))*)(kp + 8 * i);
}
enum { I_X = 0, I_MEM, I_MIXG, I_WIN, I_SBQG, I_SBKG, I_CONVW, I_MEMG, I_WKV, I_MEMQG, I_MEMKG, I_WBRSB, I_WBRCONV, I_WBRMEM, I_WO, I_FFNG, I_WROUTER, I_BROUTER, I_WGU, I_BGU, I_WD, I_BD };
#define WSP(TY, off) ((TY*)(F.ws + (off)))

__device__ __forceinline__ float wave_sum(float v) {
#pragma unroll
    for (int o = 1; o < 64; o <<= 1) v += __shfl_xor(v, o);
    return v;
}
typedef unsigned u32x4s __attribute__((ext_vector_type(4)));
typedef unsigned u32x2s __attribute__((ext_vector_type(2)));
typedef float f32x2s __attribute__((ext_vector_type(2)));
__device__ __forceinline__ float bflo(unsigned w) { return __uint_as_float(w << 16); }
__device__ __forceinline__ float bfhi(unsigned w) { return __uint_as_float(w & 0xffff0000u); }
__device__ __forceinline__ unsigned pk4_fp8(float a, float b, float c, float d) {
    a = fminf(fmaxf(a, -448.f), 448.f); b = fminf(fmaxf(b, -448.f), 448.f); c = fminf(fmaxf(c, -448.f), 448.f); d = fminf(fmaxf(d, -448.f), 448.f);
    int w = __builtin_amdgcn_cvt_pk_fp8_f32(a, b, 0, false);
    w = __builtin_amdgcn_cvt_pk_fp8_f32(c, d, w, true);
    return (unsigned)w;
}

constexpr int CI_IN = 16 * 208, CI_KV = 16 * 32, CI_BR = 8 * 32, CI_O = 16 * 32, CI_SMALL = CI_IN + CI_KV + 3 * CI_BR + CI_O, CI_D = NE * 16 * 32, CI_GU = NE * 16 * 64, CI_ALL = CI_SMALL + CI_D + CI_GU;
__host__ __device__ __forceinline__ bool proj_tile_f8(int pn) { return pn >= 14; }
struct ConvItem { const float* W; bf16* WT; int N, K, k0, n0, dst, f8; };
__device__ __forceinline__ ConvItem conv_decode(Frame& F, int it) {
    ConvItem d; int r = it;
    if (r < CI_IN) { const int kb = r / 208, nb = r % 208, pn = nb >> 3; d.f8 = proj_tile_f8(pn) ? 1 : 0; d.W = in_ptr(I_WIN); d.WT = d.f8 ? (bf16*)WSP(unsigned char, WS_WIN8) : WSP(bf16, WS_WIN); d.N = INW; d.K = 1024; d.k0 = 64 * kb; d.n0 = 32 * nb; d.dst = 32 * nb; return d; } r -= CI_IN;
    if (r < CI_KV) { const int kb = r / 32, nb = r % 32; d.W = in_ptr(I_WKV); d.WT = WSP(bf16, WS_WKV); d.N = 1024; d.K = 1024; d.k0 = 64 * kb; d.n0 = 32 * nb; d.dst = 32 * nb; d.f8 = 0; return d; } r -= CI_KV;
    if (r < 3 * CI_BR) { const int br = r / CI_BR, rr = r % CI_BR, kb = rr / 32, nb = rr % 32; d.W = in_ptr(I_WBRSB + br); d.WT = WSP(bf16, WS_WBR) + (size_t)br * 1024 * 512; d.N = 1024; d.K = 512; d.k0 = 64 * kb; d.n0 = 32 * nb; d.dst = 32 * nb; d.f8 = 0; return d; } r -= 3 * CI_BR;
    if (r < CI_O) { const int kb = r / 32, nb = r % 32; d.W = in_ptr(I_WO); d.WT = WSP(bf16, WS_WO); d.N = 1024; d.K = 1024; d.k0 = 64 * kb; d.n0 = 32 * nb; d.dst = 32 * nb; d.f8 = 0; return d; } r -= CI_O;
    if (r < CI_D) { const int e = r / 512, rr = r % 512, kb = rr / 32, nb = rr % 32; d.W = in_ptr(I_WD) + (size_t)e * 1024 * 1024; d.WT = WSP(bf16, WS_WD); d.N = 1024; d.K = 1024; d.k0 = 64 * kb; d.n0 = 32 * nb; d.dst = e * 1024 + 32 * nb; d.f8 = 1; return d; } r -= CI_D;
    { const int e = r / 1024, rr = r % 1024, kb = rr / 64, nb = rr % 64, n0 = 32 * nb, f0 = n0 & 1023;
      d.W = in_ptr(I_WGU) + (size_t)e * 1024 * 2048; d.WT = WSP(bf16, WS_WGU); d.N = 2048; d.K = 1024; d.k0 = 64 * kb; d.n0 = n0;
      d.dst = e * 2048 + (f0 >> 7) * 256 + (n0 >= 1024 ? 128 : 0) + (f0 & 127); d.f8 = 1; return d; }
}
__device__ __forceinline__ void conv_load(const ConvItem& d, f32x4 (&r)[8], int lane) {
    const GAS f32x4* p = (const GAS f32x4*)((const GAS float*)d.W + (size_t)(d.k0 + 8 * (lane >> 3)) * d.N + d.n0 + 4 * (lane & 7));
    const size_t rstep = (size_t)(d.N >> 2);
#pragma unroll
    for (int i = 0; i < 8; ++i) r[i] = p[i * rstep];
}
__device__ __forceinline__ void conv_finish(const ConvItem& d, const f32x4 (&r)[8], LAS float* scr, int lane) {
    const size_t o0 = (size_t)(d.dst + 4 * (lane & 7)) * d.K + d.k0 + 8 * (lane >> 3);
    if (d.f8) {
        GAS unsigned char* o = (GAS unsigned char*)d.WT + o0;
#pragma unroll
        for (int j = 0; j < 4; ++j) { u32x2s w; w.x = pk4_fp8(r[0][j], r[1][j], r[2][j], r[3][j]); w.y = pk4_fp8(r[4][j], r[5][j], r[6][j], r[7][j]); *(GAS u32x2s*)(o + (size_t)j * d.K) = w; }
    } else {
        GAS bf16* o = (GAS bf16*)d.WT + o0;
#pragma unroll
        for (int j = 0; j < 4; ++j) { v4u w; w.x = pk2(r[0][j], r[1][j]); w.y = pk2(r[2][j], r[3][j]); w.z = pk2(r[4][j], r[5][j]); w.w = pk2(r[6][j], r[7][j]); *(GAS v4u*)(o + (size_t)j * d.K) = w; }
    }
}
constexpr int CONV_DEPTH = 6;
constexpr int G_PROJ = 192;
constexpr int CI_D_P0 = 20 * 512;
__device__ __forceinline__ void conv_items(Frame& F, int first, int last, int gw, int ngw, LAS float* scr) {
    if (first + gw >= last) return;
    const int n = (last - first - gw + ngw - 1) / ngw, base = first + gw;
    f32x4 r[CONV_DEPTH][8];
#pragma unroll
    for (int q = 0; q < CONV_DEPTH; ++q) { const int j = q < n ? q : n - 1; const ConvItem d = conv_decode(F, base + j * ngw); conv_load(d, r[q], F.lane); }
    int j0 = 0;
#pragma unroll 1
    for (; j0 + CONV_DEPTH < n; j0 += CONV_DEPTH) {
#pragma unroll
        for (int q = 0; q < CONV_DEPTH; ++q) {
            { const ConvItem d = conv_decode(F, base + (j0 + q) * ngw); conv_finish(d, r[q], scr, F.lane); }
            { const int jn = j0 + q + CONV_DEPTH, j = jn < n ? jn : n - 1; const ConvItem d = conv_decode(F, base + j * ngw); conv_load(d, r[q], F.lane); }
        }
    }
#pragma unroll
    for (int q = 0; q < CONV_DEPTH; ++q) { const int jq = j0 + q, j = jq < n ? jq : n - 1; const ConvItem d = conv_decode(F, base + j * ngw); conv_finish(d, r[q], scr, F.lane); }
}
__device__ __forceinline__ void rms_rows(Frame& F, int gw, int NGW) {
    const int lane = F.lane;
    const float *px = in_ptr(I_X), *pmixg = in_ptr(I_MIXG), *pmem = in_ptr(I_MEM), *pmemg = in_ptr(I_MEMG);
    int m = gw; if (m >= T + MROWS) return;
    f32x4 v[4];
    { const GAS f32x4* xr = (const GAS f32x4*)(m < T ? px + (size_t)m * D : pmem + (size_t)(m - T) * D) + lane;
#pragma unroll
      for (int j = 0; j < 4; ++j) v[j] = xr[64 * j]; }
#pragma unroll 1
    for (;;) {
        const int mn = m + NGW; const bool has = mn < T + MROWS;
        f32x4 vn[4];
        if (has) { const GAS f32x4* xr = (const GAS f32x4*)(mn < T ? px + (size_t)mn * D : pmem + (size_t)(mn - T) * D) + lane;
#pragma unroll
            for (int j = 0; j < 4; ++j) vn[j] = xr[64 * j]; }
        const GAS f32x4* gr = (const GAS f32x4*)(m < T ? pmixg : pmemg) + lane;
        float s = 0.f;
#pragma unroll
        for (int j = 0; j < 4; ++j) s += (v[j].x * v[j].x + v[j].y * v[j].y) + (v[j].z * v[j].z + v[j].w * v[j].w);
        const float r = 1.f / sqrtf(wave_sum(s) * (1.f / 1024.f) + RMS_EPS);
        bf16* orow = m < T ? WSP(bf16, WS_XN) + (size_t)m * D : WSP(bf16, WS_MEMN) + (size_t)(m - T) * D;
        GAS unsigned long long* o8 = (GAS unsigned long long*)orow + lane;
#pragma unroll
        for (int j = 0; j < 4; ++j) { const f32x4 gg = gr[64 * j]; v[j].x *= r * gg.x; v[j].y *= r * gg.y; v[j].z *= r * gg.z; v[j].w *= r * gg.w;
            o8[64 * j] = (unsigned long long)pk2(v[j].x, v[j].y) | ((unsigned long long)pk2(v[j].z, v[j].w) << 32); }
        if (m < T) { GAS unsigned* o4 = (GAS unsigned*)(WSP(unsigned char, WS_XN8) + (size_t)m * D) + lane;
#pragma unroll
            for (int j = 0; j < 4; ++j) o4[64 * j] = pk4_fp8(v[j].x, v[j].y, v[j].z, v[j].w); }
        if (!has) break;
        m = mn;
#pragma unroll
        for (int j = 0; j < 4; ++j) v[j] = vn[j];
    }
}
__device__ __forceinline__ void p0_prologue(Frame& F, int nconv) {
    LAS float* scr = (LAS float*)(F.lds + RING_OFF + F.wave * 16384);
    const int gw = F.vcu * NWAVES + F.wave, NGW = F.G * NWAVES;
    rms_rows(F, gw, NGW);
    conv_items(F, 0, nconv, gw, NGW, scr);
}

typedef float f32x16 __attribute__((ext_vector_type(16)));
__device__ __forceinline__ float swap_max(float v) { auto rr = __builtin_amdgcn_permlane32_swap(__float_as_uint(v), __float_as_uint(v), false, false); return fmaxf(__uint_as_float(rr[0]), __uint_as_float(rr[1])); }
__device__ __forceinline__ float swap_sum(float v) { auto rr = __builtin_amdgcn_permlane32_swap(__float_as_uint(v), __float_as_uint(v), false, false); return __uint_as_float(rr[0]) + __uint_as_float(rr[1]); }
__device__ __forceinline__ float swap_other(float v) { auto rr = __builtin_amdgcn_permlane32_swap(__float_as_uint(v), __float_as_uint(v), false, false); const float a = __uint_as_float(rr[0]), b = __uint_as_float(rr[1]); return (a + b) - v; }
template <int NS> __device__ __forceinline__ void norm_frags(const v4u (&raw)[NS], bf16x8 (&out)[NS], const float* g, int hi, float inv_n, float post) {
    float ss = 0.f;
#pragma unroll
    for (int s = 0; s < NS; ++s) { const v4u c = raw[s]; const float x0 = bflo(c.x), x1 = bfhi(c.x), x2 = bflo(c.y), x3 = bfhi(c.y), x4 = bflo(c.z), x5 = bfhi(c.z), x6 = bflo(c.w), x7 = bfhi(c.w);
        ss += (x0 * x0 + x1 * x1) + (x2 * x2 + x3 * x3) + (x4 * x4 + x5 * x5) + (x6 * x6 + x7 * x7); }
    ss = swap_sum(ss);
    const float r = post * __builtin_amdgcn_rsqf(ss * inv_n + RMS_EPS);
#pragma unroll
    for (int s = 0; s < NS; ++s) { const v4u c = raw[s]; const f32x4 g0 = *(const GAS f32x4*)(g + 16 * s + 8 * hi), g1 = *(const GAS f32x4*)(g + 16 * s + 8 * hi + 4);
        u32x4s w; w.x = pg8::cvt_pk_bf16(bflo(c.x) * r * g0.x, bfhi(c.x) * r * g0.y); w.y = pg8::cvt_pk_bf16(bflo(c.y) * r * g0.z, bfhi(c.y) * r * g0.w);
        w.z = pg8::cvt_pk_bf16(bflo(c.z) * r * g1.x, bfhi(c.z) * r * g1.y); w.w = pg8::cvt_pk_bf16(bflo(c.w) * r * g1.z, bfhi(c.w) * r * g1.w); out[s] = __builtin_bit_cast(bf16x8, w); }
}
constexpr float SB_EXIT_LOG2 = -32.0f;
constexpr int SB_VROW = 72;
__device__ __forceinline__ void sb_tile(Frame& F, int bh, int qt, bf16* OSB, const float* qg, const float* kg) {
    const int lane = F.lane, r32 = lane & 31, hi = lane >> 5, b = bh >> 3, h = bh & 7;
    LAS unsigned char* vt = F.lds + RING_OFF + F.wave * 16384;
    const bf16* base = WSP(bf16, WS_PROJ) + (size_t)(b * SEQ) * INW + h * 64;
    const int t = qt * 32 + r32;
    bf16x8 qf[4];
    { v4u raw[4]; const bf16* qp = base + (size_t)t * INW + C_Q + 8 * hi;
#pragma unroll
      for (int s = 0; s < 4; ++s) raw[s] = *(const GAS v4u*)(qp + 16 * s);
      norm_frags<4>(raw, qf, qg, hi, 1.f / 64.f, 0.125f * 1.4426950408889634f); }
    f32x16 O[2];
#pragma unroll
    for (int d = 0; d < 2; ++d) O[d] = (f32x16){0.f, 0.f, 0.f, 0.f, 0.f, 0.f, 0.f, 0.f, 0.f, 0.f, 0.f, 0.f, 0.f, 0.f, 0.f, 0.f};
    float carry = 0.f;
    v4u kraw[4], vraw[4], knx[4], vnx[4];
    { const bf16* krow = base + (size_t)(qt * 32 + r32) * INW;
#pragma unroll
      for (int s = 0; s < 4; ++s) { kraw[s] = *(const GAS v4u*)(krow + C_K + 16 * s + 8 * hi); vraw[s] = *(const GAS v4u*)(krow + C_V + 32 * hi + 8 * s); } }
#pragma unroll 1
    for (int kt = qt; kt >= 0; --kt) {
        { const bf16* krow = base + (size_t)((kt > 0 ? kt - 1 : 0) * 32 + r32) * INW;
#pragma unroll
          for (int s = 0; s < 4; ++s) { knx[s] = *(const GAS v4u*)(krow + C_K + 16 * s + 8 * hi); vnx[s] = *(const GAS v4u*)(krow + C_V + 32 * hi + 8 * s); } }
        bf16x8 kf[4];
        norm_frags<4>(kraw, kf, kg, hi, 1.f / 64.f, 1.f);
#pragma unroll
        for (int s = 0; s < 4; ++s) { LAS unsigned short* p = (LAS unsigned short*)(vt + (32 * hi + 8 * s) * SB_VROW + r32 * 2); const v4u v = vraw[s];
            p[0 * (SB_VROW / 2)] = (unsigned short)v.x; p[1 * (SB_VROW / 2)] = (unsigned short)(v.x >> 16); p[2 * (SB_VROW / 2)] = (unsigned short)v.y; p[3 * (SB_VROW / 2)] = (unsigned short)(v.y >> 16);
            p[4 * (SB_VROW / 2)] = (unsigned short)v.z; p[5 * (SB_VROW / 2)] = (unsigned short)(v.z >> 16); p[6 * (SB_VROW / 2)] = (unsigned short)v.w; p[7 * (SB_VROW / 2)] = (unsigned short)(v.w >> 16); }
        f32x16 S = {0.f, 0.f, 0.f, 0.f, 0.f, 0.f, 0.f, 0.f, 0.f, 0.f, 0.f, 0.f, 0.f, 0.f, 0.f, 0.f};
#pragma unroll
        for (int s = 0; s < 4; ++s) S = __builtin_amdgcn_mfma_f32_32x32x16_bf16(kf[s], qf[s], S, 0, 0, 0);
        const bool diag = (kt == qt);
        float ls[16], la[16];
#pragma unroll
        for (int r = 0; r < 16; ++r) {
            const int kr = (r & 3) + 8 * (r >> 2) + 4 * hi;
            const bool valid = !diag || kr < r32;
            const float z = S[r], e = __builtin_amdgcn_exp2f(-fabsf(z)), L = __builtin_amdgcn_logf(1.f + e);
            ls[r] = valid ? -(fmaxf(z, 0.f) + L) : 0.f;
            la[r] = valid ? fminf(z, 0.f) - L : -INFINITY;
        }
        float go[4], gp[4];
#pragma unroll
        for (int g = 0; g < 4; ++g) { go[g] = (ls[4 * g] + ls[4 * g + 1]) + (ls[4 * g + 2] + ls[4 * g + 3]); gp[g] = swap_other(go[g]); }
        float after[4];
        after[3] = (hi == 0) ? gp[3] : 0.f;
#pragma unroll
        for (int g = 2; g >= 0; --g) after[g] = after[g + 1] + go[g + 1] + ((hi == 0) ? gp[g] : gp[g + 1]);
        float w[16];
#pragma unroll
        for (int g = 0; g < 4; ++g) {
            const float b3 = carry + after[g], b2 = b3 + ls[4 * g + 3], b1 = b2 + ls[4 * g + 2], b0 = b1 + ls[4 * g + 1];
            w[4 * g + 3] = __builtin_amdgcn_exp2f(la[4 * g + 3] + b3); w[4 * g + 2] = __builtin_amdgcn_exp2f(la[4 * g + 2] + b2);
            w[4 * g + 1] = __builtin_amdgcn_exp2f(la[4 * g + 1] + b1); w[4 * g] = __builtin_amdgcn_exp2f(la[4 * g] + b0);
        }
        carry += ((go[0] + go[1]) + (go[2] + go[3])) + ((gp[0] + gp[1]) + (gp[2] + gp[3]));
        bf16x8 pb[2];
#pragma unroll
        for (int s2 = 0; s2 < 2; ++s2) { u32x4s u; u.x = pg8::cvt_pk_bf16(w[8 * s2], w[8 * s2 + 1]); u.y = pg8::cvt_pk_bf16(w[8 * s2 + 2], w[8 * s2 + 3]); u.z = pg8::cvt_pk_bf16(w[8 * s2 + 4], w[8 * s2 + 5]); u.w = pg8::cvt_pk_bf16(w[8 * s2 + 6], w[8 * s2 + 7]); pb[s2] = __builtin_bit_cast(bf16x8, u); }
        LDS_WAIT(); asm volatile("" ::: "memory");
#pragma unroll
        for (int d = 0; d < 2; ++d)
#pragma unroll
            for (int s2 = 0; s2 < 2; ++s2) {
                const LAS unsigned char* vp = vt + (32 * d + r32) * SB_VROW + (16 * s2 + 4 * hi) * 2;
                const u32x2s lo = *(const LAS u32x2s*)vp, hh = *(const LAS u32x2s*)(vp + 16);
                u32x4s a; a.x = lo.x; a.y = lo.y; a.z = hh.x; a.w = hh.y;
                O[d] = __builtin_amdgcn_mfma_f32_32x32x16_bf16(__builtin_bit_cast(bf16x8, a), pb[s2], O[d], 0, 0, 0);
            }
        LDS_WAIT(); asm volatile("" ::: "memory");
        if (__all(carry < SB_EXIT_LOG2)) break;
#pragma unroll
        for (int s = 0; s < 4; ++s) { kraw[s] = knx[s]; vraw[s] = vnx[s]; }
    }
    bf16* op = OSB + (size_t)(b * SEQ + t) * 512 + h * 64 + 4 * hi;
#pragma unroll
    for (int d = 0; d < 2; ++d)
#pragma unroll
        for (int g = 0; g < 4; ++g) { u32x2s u; u.x = pk2(O[d][4 * g], O[d][4 * g + 1]); u.y = pk2(O[d][4 * g + 2], O[d][4 * g + 3]); *(GAS u32x2s*)(op + 32 * d + 8 * g) = u; }
}
constexpr int MA_KROW = 272, MA_VROW = 520, MA_VOFF = 256 * MA_KROW;
__device__ __forceinline__ void mem_attn_item(Frame& F, int item, bf16* OMEM, const float* mqg, const float* mkg) {
    const int b = item >> 6, h = (item >> 4) & 3, qblk = item & 15, tid = F.tid, lane = F.lane, r32 = lane & 31, hi = lane >> 5;
    LAS unsigned char* kl = F.lds + RING_OFF; LAS unsigned char* vl = kl + MA_VOFF;
    const bf16* kvb = WSP(bf16, WS_KV) + (size_t)(b * MEMT) * 1024 + h * 128;
    __syncthreads();
#pragma unroll
    for (int i = 0; i < 8; ++i) { const int id = tid + 512 * i, row = id >> 4, c = id & 15;
        const v4u cr = *(const GAS v4u*)(kvb + (size_t)row * 1024 + c * 8);
        const float x0 = bflo(cr.x), x1 = bfhi(cr.x), x2 = bflo(cr.y), x3 = bfhi(cr.y), x4 = bflo(cr.z), x5 = bfhi(cr.z), x6 = bflo(cr.w), x7 = bfhi(cr.w);
        float ss = (x0 * x0 + x1 * x1) + (x2 * x2 + x3 * x3) + (x4 * x4 + x5 * x5) + (x6 * x6 + x7 * x7);
        ss += __shfl_xor(ss, 1); ss += __shfl_xor(ss, 2); ss += __shfl_xor(ss, 4); ss += __shfl_xor(ss, 8);
        const float r = __builtin_amdgcn_rsqf(ss * (1.f / 128.f) + RMS_EPS); const f32x4 g0 = *(const GAS f32x4*)(mkg + 8 * c), g1 = *(const GAS f32x4*)(mkg + 8 * c + 4);
        v4u o; o.x = pk2(x0 * r * g0.x, x1 * r * g0.y); o.y = pk2(x2 * r * g0.z, x3 * r * g0.w); o.z = pk2(x4 * r * g1.x, x5 * r * g1.y); o.w = pk2(x6 * r * g1.z, x7 * r * g1.w);
        *(LAS v4u*)(kl + row * MA_KROW + c * 16) = o; }
#pragma unroll
    for (int i = 0; i < 8; ++i) { const int id = tid + 512 * i, key = id & 255, c = id >> 8;
        const v4u v = *(const GAS v4u*)(kvb + (size_t)key * 1024 + 512 + c * 8); LAS unsigned short* vt = (LAS unsigned short*)(vl + (8 * c) * MA_VROW + key * 2);
        vt[0 * (MA_VROW / 2)] = (unsigned short)v.x; vt[1 * (MA_VROW / 2)] = (unsigned short)(v.x >> 16); vt[2 * (MA_VROW / 2)] = (unsigned short)v.y; vt[3 * (MA_VROW / 2)] = (unsigned short)(v.y >> 16);
        vt[4 * (MA_VROW / 2)] = (unsigned short)v.z; vt[5 * (MA_VROW / 2)] = (unsigned short)(v.z >> 16); vt[6 * (MA_VROW / 2)] = (unsigned short)v.w; vt[7 * (MA_VROW / 2)] = (unsigned short)(v.w >> 16); }
    __syncthreads();
    const int t = b * SEQ + qblk * 256 + F.wave * 32 + r32;
    bf16x8 qf[8];
    { v4u raw[8]; const bf16* qp = WSP(bf16, WS_PROJ) + (size_t)t * INW + C_QM + h * 128 + 8 * hi;
#pragma unroll
      for (int s = 0; s < 8; ++s) raw[s] = *(const GAS v4u*)(qp + 16 * s);
      norm_frags<8>(raw, qf, mqg, hi, 1.f / 128.f, 1.f); }
    const LAS unsigned char* kbase = kl + r32 * MA_KROW + hi * 16;
    float m = -INFINITY;
#pragma unroll 1
    for (int kt = 0; kt < 8; ++kt) {
        f32x16 S = {0.f, 0.f, 0.f, 0.f, 0.f, 0.f, 0.f, 0.f, 0.f, 0.f, 0.f, 0.f, 0.f, 0.f, 0.f, 0.f};
#pragma unroll
        for (int s = 0; s < 8; ++s) S = __builtin_amdgcn_mfma_f32_32x32x16_bf16(*(const LAS bf16x8*)(kbase + kt * 32 * MA_KROW + s * 32), qf[s], S, 0, 0, 0);
#pragma unroll
        for (int r = 0; r < 16; ++r) m = fmaxf(m, S[r]);
    }
    m = swap_max(m);
    const float sc2 = 0.08838834764831845f * 1.4426950408889634f;
    const float msc = m * sc2;
    float l = 0.f; f32x16 O[4];
#pragma unroll
    for (int d = 0; d < 4; ++d) O[d] = (f32x16){0.f, 0.f, 0.f, 0.f, 0.f, 0.f, 0.f, 0.f, 0.f, 0.f, 0.f, 0.f, 0.f, 0.f, 0.f, 0.f};
    const LAS unsigned char* vbase = vl + r32 * MA_VROW + hi * 8;
#pragma unroll 1
    for (int kt = 0; kt < 8; ++kt) {
        f32x16 S = {0.f, 0.f, 0.f, 0.f, 0.f, 0.f, 0.f, 0.f, 0.f, 0.f, 0.f, 0.f, 0.f, 0.f, 0.f, 0.f};
#pragma unroll
        for (int s = 0; s < 8; ++s) S = __builtin_amdgcn_mfma_f32_32x32x16_bf16(*(const LAS bf16x8*)(kbase + kt * 32 * MA_KROW + s * 32), qf[s], S, 0, 0, 0);
        float p[16];
#pragma unroll
        for (int r = 0; r < 16; ++r) { p[r] = __builtin_amdgcn_exp2f(S[r] * sc2 - msc); l += p[r]; }
        bf16x8 pb[2];
#pragma unroll
        for (int s2 = 0; s2 < 2; ++s2) { u32x4s w; w.x = pg8::cvt_pk_bf16(p[8 * s2], p[8 * s2 + 1]); w.y = pg8::cvt_pk_bf16(p[8 * s2 + 2], p[8 * s2 + 3]); w.z = pg8::cvt_pk_bf16(p[8 * s2 + 4], p[8 * s2 + 5]); w.w = pg8::cvt_pk_bf16(p[8 * s2 + 6], p[8 * s2 + 7]); pb[s2] = __builtin_bit_cast(bf16x8, w); }
#pragma unroll
        for (int d = 0; d < 4; ++d)
#pragma unroll
            for (int s2 = 0; s2 < 2; ++s2) {
                const LAS unsigned char* vp = vbase + d * 32 * MA_VROW + (kt * 32 + s2 * 16) * 2;
                const u32x2s lo = *(const LAS u32x2s*)vp, hh = *(const LAS u32x2s*)(vp + 16);
                u32x4s a; a.x = lo.x; a.y = lo.y; a.z = hh.x; a.w = hh.y;
                O[d] = __builtin_amdgcn_mfma_f32_32x32x16_bf16(__builtin_bit_cast(bf16x8, a), pb[s2], O[d], 0, 0, 0);
            }
    }
    l = swap_sum(l); const float inv = 1.f / l;
    bf16* op = OMEM + (size_t)t * 512 + h * 128 + 4 * hi;
#pragma unroll
    for (int d = 0; d < 4; ++d)
#pragma unroll
        for (int g = 0; g < 4; ++g) { u32x2s w; w.x = pk2(O[d][4 * g] * inv, O[d][4 * g + 1] * inv); w.y = pk2(O[d][4 * g + 2] * inv, O[d][4 * g + 3] * inv);
            *(GAS u32x2s*)(op + 32 * d + 8 * g) = w; }
    __syncthreads();
}
__device__ __forceinline__ void conv_item4(Frame& F, int t0, bf16* OCONV, const float* cw) {
    const int lane = F.lane, pos0 = t0 & (SEQ - 1), c0 = lane * 8;
    const bf16* pr = WSP(bf16, WS_PROJ) + (size_t)t0 * INW + c0;
    v4u a[6], x[6], bq[4];
#pragma unroll
    for (int j = 0; j < 6; ++j) { const int d = j - 2;
        if (pos0 + d >= 0) { a[j] = *(const GAS v4u*)(pr + (long)d * INW + C_CC); x[j] = *(const GAS v4u*)(pr + (long)d * INW + C_CX); }
        else { a[j] = (v4u){0u, 0u, 0u, 0u}; x[j] = (v4u){0u, 0u, 0u, 0u}; } }
#pragma unroll
    for (int j = 0; j < 4; ++j) bq[j] = *(const GAS v4u*)(pr + (long)j * INW + C_CB);
    float w0[8], w1[8], w2[8];
#pragma unroll
    for (int i = 0; i < 8; ++i) { w0[i] = cw[c0 + i]; w1[i] = cw[512 + c0 + i]; w2[i] = cw[1024 + c0 + i]; }
    float u[6][8];
#pragma unroll
    for (int j = 0; j < 6; ++j) { u[j][0] = bflo(a[j].x) * bflo(x[j].x); u[j][1] = bfhi(a[j].x) * bfhi(x[j].x); u[j][2] = bflo(a[j].y) * bflo(x[j].y); u[j][3] = bfhi(a[j].y) * bfhi(x[j].y);
        u[j][4] = bflo(a[j].z) * bflo(x[j].z); u[j][5] = bfhi(a[j].z) * bfhi(x[j].z); u[j][6] = bflo(a[j].w) * bflo(x[j].w); u[j][7] = bfhi(a[j].w) * bfhi(x[j].w); }
#pragma unroll
    for (int j = 0; j < 4; ++j) {
        const float cb[8] = {bflo(bq[j].x), bfhi(bq[j].x), bflo(bq[j].y), bfhi(bq[j].y), bflo(bq[j].z), bfhi(bq[j].z), bflo(bq[j].w), bfhi(bq[j].w)};
        float r[8];
#pragma unroll
        for (int i = 0; i < 8; ++i) r[i] = cb[i] * (w0[i] * u[j][i] + w1[i] * u[j + 1][i] + w2[i] * u[j + 2][i]);
        v4u o; o.x = pk2(r[0], r[1]); o.y = pk2(r[2], r[3]); o.z = pk2(r[4], r[5]); o.w = pk2(r[6], r[7]);
        *(GAS v4u*)(OCONV + (size_t)(t0 + j) * 512 + c0) = o;
    }
}
#ifndef MIXREP
#define MIXREP 0
#endif
__device__ __forceinline__ void p2_mixers(Frame& F) {
    bf16* OSB = WSP(bf16, WS_OBR); bf16* OCONV = WSP(bf16, WS_OBR) + (size_t)T * 512; bf16* OMEM = WSP(bf16, WS_OBR) + (size_t)2 * T * 512;
    const int gw = F.vcu * NWAVES + F.wave, NGW = F.G * NWAVES;
    { const float* mqg = in_ptr(I_MEMQG); const float* mkg = in_ptr(I_MEMKG);
      for (int item = F.vcu; item < 256; item += F.G) mem_attn_item(F, item, OMEM, mqg, mkg); }
    { const float* qg = in_ptr(I_SBQG); const float* kg = in_ptr(I_SBKG);
      for (int it = F.vcu; it < BATCH * 128; it += F.G) sb_tile(F, (it >> 7) * 8 + F.wave, it & 127, OSB, qg, kg); }
    { const float* cw = in_ptr(I_CONVW);
      for (int t4 = gw; t4 < T / 4; t4 += NGW) conv_item4(F, t4 * 4, OCONV, cw); }
}

__device__ __forceinline__ void p5_route(Frame& F) {
    const int lane = F.lane, w = F.wave, r32 = lane & 31, hi = lane >> 5, tid = F.tid;
    constexpr int TROW = 516;
    LAS float* tile = (LAS float*)(F.lds + RING_OFF);
    LAS float* part = tile + 32 * TROW;
    LAS int* lcnt = (LAS int*)(part + 8 * 32 * 33);
    LAS int* lbase = lcnt + 32;
    LAS float* r2s = (LAS float*)(lbase + 32);
    const float* wrt = in_ptr(I_WROUTER); const float* fg = in_ptr(I_FFNG); const float be = in_ptr(I_BROUTER)[r32];
    const float* ssqp = WSP(float, WS_SSQ);
    f32x4 gq[4];
#pragma unroll
    for (int j = 0; j < 4; ++j) gq[j] = ((const GAS f32x4*)fg)[lane + 64 * j];
    for (int task = F.vcu; task < T / 32; task += F.G) {
        const int tb = task * 32;
        f32x4 xs[4][4]; float rinv4[4];
#pragma unroll
        for (int rr = 0; rr < 4; ++rr) { const int row = tb + 4 * w + rr; const GAS f32x4* xr = (const GAS f32x4*)(F.out + (size_t)row * D) + lane;
#pragma unroll
            for (int j = 0; j < 4; ++j) xs[rr][j] = xr[64 * j];
            const GAS f32x4* sp = (const GAS f32x4*)(ssqp + (size_t)row * 16); const f32x4 s0 = sp[0], s1 = sp[1], s2 = sp[2], s3 = sp[3];
            const float ss = ((s0.x + s0.y) + (s0.z + s0.w)) + ((s1.x + s1.y) + (s1.z + s1.w)) + ((s2.x + s2.y) + (s2.z + s2.w)) + ((s3.x + s3.y) + (s3.z + s3.w));
            rinv4[rr] = 1.f / sqrtf(ss * (1.f / 1024.f) + RMS_EPS); }
#pragma unroll
        for (int rr = 0; rr < 4; ++rr) { const int row = tb + 4 * w + rr; GAS unsigned* o4 = (GAS unsigned*)(WSP(unsigned char, WS_HF8) + (size_t)row * 1024) + lane; const float ri = rinv4[rr];
#pragma unroll
            for (int j = 0; j < 4; ++j) { xs[rr][j] = xs[rr][j] * gq[j]; o4[64 * j] = pk4_fp8(xs[rr][j].x * ri, xs[rr][j].y * ri, xs[rr][j].z * ri, xs[rr][j].w * ri); }
            if (lane == 0) r2s[4 * w + rr] = ri; }
        f32x16 C = {0.f, 0.f, 0.f, 0.f, 0.f, 0.f, 0.f, 0.f, 0.f, 0.f, 0.f, 0.f, 0.f, 0.f, 0.f, 0.f};
#pragma unroll
        for (int hk = 0; hk < 2; ++hk) {
            if (hk) __syncthreads();
#pragma unroll
            for (int rr = 0; rr < 4; ++rr)
#pragma unroll
                for (int jj = 0; jj < 2; ++jj) *(LAS f32x4*)(tile + (4 * w + rr) * TROW + 4 * (lane + 64 * jj)) = xs[rr][2 * hk + jj];
            __syncthreads();
            const int lc = w * 64 + 32 * hi;
            f32x4 xv[8];
#pragma unroll
            for (int i = 0; i < 8; ++i) xv[i] = *(const LAS f32x4*)(tile + r32 * TROW + lc + 4 * i);
            const GAS float* wp = (const GAS float*)wrt + (size_t)(hk * 512 + lc) * 32 + r32;
#pragma unroll
            for (int st = 0; st < 32; ++st) C = __builtin_amdgcn_mfma_f32_32x32x2f32(wp[st * 32], xv[st >> 2][st & 3], C, 0, 0, 0);
        }
#pragma unroll
        for (int r = 0; r < 16; ++r) part[(w * 32 + (r & 3) + 8 * (r >> 2) + 4 * hi) * 33 + r32] = C[r];
        if (tid < 32) lcnt[tid] = 0;
        __syncthreads();
        int my_e[2], loc[2]; float my_g[2];
#pragma unroll
        for (int u = 0; u < 2; ++u) {
            const int j = 4 * w + 2 * hi + u;
            float lg = 0.f;
#pragma unroll
            for (int ww = 0; ww < 8; ++ww) lg += part[(ww * 32 + r32) * 33 + j];
            float val = lg * r2s[j] + be;
            float tv[4]; int ti[4];
#pragma unroll
            for (int rr = 0; rr < 4; ++rr) {
                float bv = val; int bi = r32;
#define TOPK_DPP(ctrl) do { const float ov = __builtin_bit_cast(float, __builtin_amdgcn_update_dpp(0, __builtin_bit_cast(int, bv), ctrl, 0xf, 0xf, false)); const int oi = __builtin_amdgcn_update_dpp(0, bi, ctrl, 0xf, 0xf, false); \
                    if (ov > bv || (ov == bv && oi < bi)) { bv = ov; bi = oi; } } while (0)
                TOPK_DPP(0xB1); TOPK_DPP(0x4E); TOPK_DPP(0x141); TOPK_DPP(0x140);
#undef TOPK_DPP
                { const float ov = __shfl_xor(bv, 16); const int oi = __shfl_xor(bi, 16); if (ov > bv || (ov == bv && oi < bi)) { bv = ov; bi = oi; } }
                tv[rr] = bv; ti[rr] = bi; if (r32 == bi) val = -INFINITY;
            }
            const float e1 = __expf(tv[1] - tv[0]), e2 = __expf(tv[2] - tv[0]), e3 = __expf(tv[3] - tv[0]); const float inv = 1.f / (1.f + e1 + e2 + e3);
            my_e[u] = r32 == 0 ? ti[0] : (r32 == 1 ? ti[1] : (r32 == 2 ? ti[2] : ti[3]));
            my_g[u] = (r32 == 0 ? 1.f : (r32 == 1 ? e1 : (r32 == 2 ? e2 : e3))) * inv;
            loc[u] = 0;
            if (r32 < 4) loc[u] = __hip_atomic_fetch_add((LAS int*)lcnt + my_e[u], 1, __ATOMIC_RELAXED, __HIP_MEMORY_SCOPE_WORKGROUP);
        }
        __syncthreads();
        if (tid < 32) { const int c = lcnt[tid]; int base = 0;
            if (c > 0) base = (int)__hip_atomic_fetch_add((unsigned*)(F.ctl + CW_CNT + 64 * tid), (unsigned)c, __ATOMIC_RELAXED, __HIP_MEMORY_SCOPE_AGENT);
            lbase[tid] = base; }
        __syncthreads();
        if (r32 < 4) {
#pragma unroll
            for (int u = 0; u < 2; ++u) { const int t = tb + 4 * w + 2 * hi + u; const int pos = lbase[my_e[u]] + loc[u];
                WSP(int, WS_ROUTE)[t * 4 + r32] = my_e[u]; WSP(float, WS_ROUTE + 256 * 1024)[t * 4 + r32] = my_g[u]; WSP(int, WS_ROUTE + 512 * 1024)[t * 4 + r32] = pos;
                WSP(int, WS_LIST)[my_e[u] * 16384 + pos] = t; }
        }
        __syncthreads();
    }
}
__device__ __forceinline__ void moe_table(Frame& F) {
    volatile LAS int* tab = (volatile LAS int*)(F.lds + TAB_OFF);
    if (F.tid < 64) {
        const int e = F.tid & 31;
        const unsigned c = __hip_atomic_load((unsigned*)(F.ctl + CW_CNT + 64 * e), __ATOMIC_RELAXED, __HIP_MEMORY_SCOPE_AGENT);
        const int tiles = (int)((c + 255u) >> 8); int inc = tiles;
#pragma unroll
        for (int o = 1; o < 32; o <<= 1) { const int up = __shfl_up(inc, o, 32); if (e >= o) inc += up; }
        if (F.tid < 32) { tab[e] = inc - tiles; tab[48 + e] = (int)c; if (e == 31) { tab[NE] = inc; tab[40] = inc; } }
    }
    __syncthreads();
}
__device__ __forceinline__ void p8_combine(Frame& F) {
    const int gw = F.vcu * NWAVES + F.wave, NGW = F.G * NWAVES, lane = F.lane;
    typedef int i32x4c __attribute__((ext_vector_type(4)));
    const GAS i32x4c* ridx = (const GAS i32x4c*)WSP(int, WS_ROUTE); const GAS i32x4c* rpos = (const GAS i32x4c*)WSP(int, WS_ROUTE + 512 * 1024); const GAS f32x4* rgate = (const GAS f32x4*)WSP(float, WS_ROUTE + 256 * 1024);
    const volatile LAS int* tab = (const volatile LAS int*)(F.lds + TAB_OFF);
    constexpr int TB = 4;
    for (int t0 = gw * TB; t0 < T; t0 += NGW * TB) {
        i32x4c sl[TB]; f32x4 gt[TB];
#pragma unroll
        for (int i = 0; i < TB; ++i) { const i32x4c e4 = ridx[t0 + i], p4 = rpos[t0 + i]; gt[i] = rgate[t0 + i];
#pragma unroll
            for (int k = 0; k < 4; ++k) sl[i][k] = tab[e4[k]] * 256 + p4[k]; }
        f32x4 v[TB][4]; unsigned y[TB][4][4];
#pragma unroll
        for (int i = 0; i < TB; ++i) { const GAS f32x4* xr = (const GAS f32x4*)(F.out + (size_t)(t0 + i) * D) + lane;
#pragma unroll
            for (int j = 0; j < 4; ++j) v[i][j] = xr[64 * j];
#pragma unroll
            for (int k = 0; k < 4; ++k) { const GAS unsigned* y4 = (const GAS unsigned*)(WSP(unsigned char, WS_Y) + (size_t)sl[i][k] * 1024) + lane;
#pragma unroll
                for (int j = 0; j < 4; ++j) y[i][k][j] = y4[64 * j]; } }
#pragma unroll
        for (int i = 0; i < TB; ++i) { GAS f32x4* xw = (GAS f32x4*)(F.out + (size_t)(t0 + i) * D) + lane;
#pragma unroll
            for (int k = 0; k < 4; ++k) { const float g = gt[i][k];
#pragma unroll
                for (int j = 0; j < 4; ++j) { const unsigned w = y[i][k][j]; const f32x2s lo = __builtin_amdgcn_cvt_pk_f32_fp8(w, false), hi = __builtin_amdgcn_cvt_pk_f32_fp8(w, true);
                    v[i][j].x += g * lo.x; v[i][j].y += g * lo.y; v[i][j].z += g * hi.x; v[i][j].w += g * hi.y; } }
#pragma unroll
            for (int j = 0; j < 4; ++j) xw[64 * j] = v[i][j]; }
    }
}

struct EpiGate {
    static constexpr bool PERM = true, AFTER_DRAIN = false; static constexpr int NST = 16;
    const pg8::bf16_t* gates; pg8::bf16_t* sum;
    __device__ __forceinline__ void operator()(const pg8::f32x4 (&acc)[2][2][4][2], const pg8::Unit& u, int wr, int wc, int fr, int fq) const {
        const int br = u.pn >> 2, col0 = (u.pn & 3) * pg8::BM + wc * 32 + 8 * fq, row0 = (u.pm & 63) * pg8::BM + wr * 64 + fr;
        const pg8::bf16_t* gp = gates + br * 1024 + (size_t)row0 * INW + col0; pg8::bf16_t* sp = sum + (size_t)row0 * 1024 + col0;
        const unsigned keep = br != 0 ? 0xffffffffu : 0u;
        pg8::u32x4 G[2][4], P[2][4];
#define EG_LOAD(b, buf) do { _Pragma("unroll") for (int mm = 0; mm < 2; ++mm) _Pragma("unroll") for (int bj = 0; bj < 2; ++bj) { const size_t r = (size_t)(((b) >> 1) * pg8::HALF + (((b) & 1) * 2 + mm) * 16); \
            G[buf][mm * 2 + bj] = *(const pg8::u32x4*)(gp + r * INW + bj * pg8::HALF); P[buf][mm * 2 + bj] = *(const pg8::u32x4*)(sp + r * 1024 + bj * pg8::HALF); } } while (0)
        EG_LOAD(0, 0); asm volatile("" ::: "memory");
#pragma unroll
        for (int b = 0; b < 4; ++b) {
            if (b == 0) EG_LOAD(1, 1); else if (b == 1) EG_LOAD(2, 0); else if (b == 2) EG_LOAD(3, 1);
            asm volatile("" ::: "memory");
#pragma unroll
            for (int mm = 0; mm < 2; ++mm)
#pragma unroll
                for (int bj = 0; bj < 2; ++bj) { const int ai = b >> 1, m = (b & 1) * 2 + mm; const size_t r = (size_t)(ai * pg8::HALF + m * 16);
                    const pg8::u32x4 g = G[b & 1][mm * 2 + bj]; pg8::u32x4 p = P[b & 1][mm * 2 + bj]; p.x &= keep; p.y &= keep; p.z &= keep; p.w &= keep;
                    const pg8::f32x4 v0 = acc[ai][bj][m][0], v1 = acc[ai][bj][m][1];
                    const float gv[8] = {bflo(g.x), bfhi(g.x), bflo(g.y), bfhi(g.y), bflo(g.z), bfhi(g.z), bflo(g.w), bfhi(g.w)};
                    const float pv[8] = {bflo(p.x), bfhi(p.x), bflo(p.y), bfhi(p.y), bflo(p.z), bfhi(p.z), bflo(p.w), bfhi(p.w)};
                    const float av[8] = {v0[0], v0[1], v0[2], v0[3], v1[0], v1[1], v1[2], v1[3]};
                    float o[8];
#pragma unroll
                    for (int i = 0; i < 8; ++i) o[i] = pv[i] + av[i] * __builtin_amdgcn_rcpf(1.f + __builtin_amdgcn_exp2f(-1.4426950408889634f * gv[i]));
                    pg8::u32x4 w; w.x = pg8::cvt_pk_bf16(o[0], o[1]); w.y = pg8::cvt_pk_bf16(o[2], o[3]); w.z = pg8::cvt_pk_bf16(o[4], o[5]); w.w = pg8::cvt_pk_bf16(o[6], o[7]);
                    *(pg8::u32x4*)(sp + r * 1024 + bj * pg8::HALF) = w; }
            asm volatile("" ::: "memory");
        }
#undef EG_LOAD
    }
};
struct BranchOrder {
    pg8::StaticOrder so;
    __device__ __forceinline__ bool next(int i, pg8::Unit& u) const {
        pg8::Unit tu; const int tile = i / 3, br = i - 3 * tile; if (!so.next(tile, tu)) return false;
        u.pm = br * (T / 256) + tu.pm; u.pn = br * 4 + tu.pn; return true;
    }
    __device__ __forceinline__ void a_ready(const pg8::Unit&) const {}
    __device__ __forceinline__ void done(const pg8::Unit&) const {}
};
struct EpiResF32 {
    static constexpr bool PERM = false, AFTER_DRAIN = false; static constexpr int NST = 32;
    const float* base; float* out; int ldc; float* ssq;
    __device__ __forceinline__ void operator()(const pg8::f32x4 (&acc)[2][2][4][2], const pg8::Unit& u, int wr, int wc, int fr, int fq) const {
        const int col0 = u.pn * pg8::BM + wc * 32 + 4 * fq, rowb = u.pm * pg8::BM + wr * 64 + fr;
        const float* bp = base + (size_t)rowb * ldc + col0; float* op = out + (size_t)rowb * ldc + col0;
        pg8::f32x4 X[2][8];
#define ER_LOAD(b, buf) do { _Pragma("unroll") for (int mm = 0; mm < 2; ++mm) _Pragma("unroll") for (int bj = 0; bj < 2; ++bj) _Pragma("unroll") for (int n = 0; n < 2; ++n) \
            X[buf][mm * 4 + bj * 2 + n] = *(const pg8::f32x4*)(bp + (size_t)(((b) >> 1) * pg8::HALF + (((b) & 1) * 2 + mm) * 16) * ldc + bj * pg8::HALF + n * 16); } while (0)
        ER_LOAD(0, 0); asm volatile("" ::: "memory");
#pragma unroll
        for (int b = 0; b < 4; ++b) {
            if (b == 0) ER_LOAD(1, 1); else if (b == 1) ER_LOAD(2, 0); else if (b == 2) ER_LOAD(3, 1);
            asm volatile("" ::: "memory");
#pragma unroll
            for (int mm = 0; mm < 2; ++mm) { const int ai = b >> 1, m = (b & 1) * 2 + mm; const int rloc = ai * pg8::HALF + m * 16; float sq = 0.f;
#pragma unroll
                for (int bj = 0; bj < 2; ++bj)
#pragma unroll
                    for (int n = 0; n < 2; ++n) { const pg8::f32x4 o = X[b & 1][mm * 4 + bj * 2 + n] + acc[ai][bj][m][n];
                        *(pg8::f32x4*)(op + (size_t)rloc * ldc + bj * pg8::HALF + n * 16) = o; sq += (o[0] * o[0] + o[1] * o[1]) + (o[2] * o[2] + o[3] * o[3]); }
                sq += __shfl_xor(sq, 16); sq += __shfl_xor(sq, 32);
                if (fq == 0) ssq[(rowb + rloc) * 16 + u.pn * 4 + wc] = sq; }
            asm volatile("" ::: "memory");
        }
#undef ER_LOAD
    }
};
struct EpiSwiglu {
    static constexpr bool PERM = true, AFTER_DRAIN = false; static constexpr int NST = 8;
    unsigned char* O; const float* bias;
    __device__ __forceinline__ void operator()(const pg8::f32x4 (&acc)[2][2][4][2], const pg8::Unit& u, int wr, int wc, int fr, int fq) const {
        const int e = u.pn >> 3, pl = u.pn & 7, f0 = pl * 128 + wc * 32 + 8 * fq, row0 = u.pm * pg8::BM + wr * 64 + fr;
        const float* bg = bias + e * 2048 + f0;
        pg8::f32x4 bgv[2], blv[2];
#pragma unroll
        for (int n = 0; n < 2; ++n) { bgv[n] = *(const pg8::f32x4*)(bg + 4 * n); blv[n] = *(const pg8::f32x4*)(bg + 1024 + 4 * n); }
#pragma unroll
        for (int ai = 0; ai < 2; ++ai)
#pragma unroll
            for (int m = 0; m < 4; ++m) { unsigned char* rowp = O + (size_t)(row0 + ai * pg8::HALF + m * 16) * 1024 + f0; float a[8];
#pragma unroll
                for (int n = 0; n < 2; ++n) { const pg8::f32x4 g4 = acc[ai][0][m][n] + bgv[n], l4 = acc[ai][1][m][n] + blv[n];
#pragma unroll
                    for (int j = 0; j < 4; ++j) { const float g = fminf(g4[j], 7.f), l = fminf(fmaxf(l4[j], -7.f), 7.f); a[4 * n + j] = g * (l + 1.f) * __builtin_amdgcn_rcpf(1.f + __builtin_amdgcn_exp2f(-1.702f * 1.4426950408889634f * g)); } }
                u32x2s w; w.x = pk4_fp8(a[0], a[1], a[2], a[3]); w.y = pk4_fp8(a[4], a[5], a[6], a[7]);
                *(u32x2s*)rowp = w; }
    }
};
struct EpiF8Bias {
    static constexpr bool PERM = true, AFTER_DRAIN = false; static constexpr int NST = 16;
    unsigned char* O; int ldc; const float* bias; int split_cols;
    __device__ __forceinline__ void operator()(const pg8::f32x4 (&acc)[2][2][4][2], const pg8::Unit& u, int wr, int wc, int fr, int fq) const {
        const int row0 = u.pm * pg8::BM + wr * 64 + fr; int colt = u.pn * pg8::BM; colt -= (colt / split_cols) * split_cols;
        const int col0 = colt + wc * 32 + 8 * fq, bcol0 = u.pn * pg8::BM + wc * 32 + 8 * fq;
        pg8::f32x4 bv[2][2];
#pragma unroll
        for (int bj = 0; bj < 2; ++bj)
#pragma unroll
            for (int n = 0; n < 2; ++n) bv[bj][n] = *(const pg8::f32x4*)(bias + bcol0 + bj * pg8::HALF + 4 * n);
#pragma unroll
        for (int ai = 0; ai < 2; ++ai)
#pragma unroll
            for (int m = 0; m < 4; ++m) { unsigned char* rowp = O + (size_t)(row0 + ai * pg8::HALF + m * 16) * ldc + col0;
#pragma unroll
                for (int bj = 0; bj < 2; ++bj) { const pg8::f32x4 v0 = acc[ai][bj][m][0] + bv[bj][0], v1 = acc[ai][bj][m][1] + bv[bj][1];
                    u32x2s w; w.x = pk4_fp8(v0[0], v0[1], v0[2], v0[3]); w.y = pk4_fp8(v1[0], v1[1], v1[2], v1[3]); *(u32x2s*)(rowp + bj * pg8::HALF) = w; } }
    }
};
struct PartOrder {
    pg8::StaticOrder so; int f8;
    __device__ __forceinline__ bool next(int i, pg8::Unit& u) const {
        pg8::Unit tu; if (!so.next(i, tu)) return false;
        u.pm = tu.pm; u.pn = f8 ? tu.pn + 14 : tu.pn; return true;
    }
    __device__ __forceinline__ void a_ready(const pg8::Unit&) const {}
    __device__ __forceinline__ void done(const pg8::Unit&) const {}
};
struct MoeOrder {
    const volatile LAS int* tab; int nN, ntiles, G, c; const int* list;
    __device__ __forceinline__ bool next(int i, pg8::Unit& u) const {
        const long L = (long)i * G + c; const int nwg = ntiles * nN; if (L >= (long)nwg) return false;
        int wgid = (int)L; { const int q = nwg / 8, r = nwg % 8, xcd = wgid % 8, off = wgid / 8; wgid = (xcd < r ? xcd * (q + 1) : r * (q + 1) + (xcd - r) * q) + off; }
        const int nig = 8 * nN, gid = wgid / nig, fm = gid * 8, gsz = (ntiles - fm) < 8 ? (ntiles - fm) : 8;
        const int pm = fm + ((wgid % nig) % gsz), pl = (wgid % nig) / gsz;
        const int lj = (int)(threadIdx.x & 63); const int tv = tab[lj & 31];
        const int e = (int)__popcll(__ballot(lj >= 1 && lj < NE && tv <= pm));
        u.pm = __builtin_amdgcn_readfirstlane(pm); u.pn = __builtin_amdgcn_readfirstlane(e * nN + pl); return true;
    }
    __device__ __forceinline__ const int* rows_list(const pg8::Unit& u) const { const int e = u.pn / nN; return list + __builtin_amdgcn_readfirstlane(e * 16384 + (u.pm - tab[e]) * 256); }
    __device__ __forceinline__ int nrows(const pg8::Unit& u) const { const int e = u.pn / nN; return __builtin_amdgcn_readfirstlane(tab[48 + e] - (u.pm - tab[e]) * 256); }
    __device__ __forceinline__ void a_ready(const pg8::Unit&) const {}
    __device__ __forceinline__ void done(const pg8::Unit&) const {}
};

struct Args { const float* in[22]; float* out; unsigned char* ws; int ph_lo, ph_hi; };
__global__ void __launch_bounds__(NWAVES * 64, 2) fwd_kernel(Args args) {
    extern __shared__ __attribute__((aligned(16))) unsigned char lds[];
    Frame F;
    F.lds = (LAS unsigned char*)lds;
    F.MISC = (volatile LAS unsigned*)(F.lds + MISC_OFF);
    F.tid = threadIdx.x; F.lane = F.tid & 63; F.wave = __builtin_amdgcn_readfirstlane(F.tid >> 6);
    F.G = gridDim.x; { const int bx = blockIdx.x; F.vcu = (F.G % 8 == 0) ? (bx % 8) * (F.G / 8) + bx / 8 : bx; }
    F.ws = args.ws; F.out = args.out; F.ctl = (gu32*)(F.ws + WS_CTL);
    for (int u = F.tid; u < (LDS_BYTES - LDSCTL_OFF) / 4; u += NWAVES * 64) ((LAS unsigned*)(F.lds + LDSCTL_OFF))[u] = 0u;
    __syncthreads();
    XcdBarrier bar = xcd_barrier_post((unsigned*)(F.ctl + CW_BAR), F.MISC + 8);
    const int lo = args.ph_lo, hi = args.ph_hi;
#ifndef REPMASK
#define REPMASK 0
#endif
#define IN(k) (lo <= (k) && (k) < hi)
#define NREP(k) (((REPMASK >> (k)) & 1) ? 2 : 1)
#define GRID_BAR() xcd_barrier(bar)

    const bool split = (F.G == 256);
    const int g1 = split ? G_PROJ : F.G;
    if (IN(0)) { p0_prologue(F, split ? CI_SMALL + CI_D_P0 : CI_ALL); GRID_BAR(); }
    if (IN(1)) {
        const bool gemm_role = (int)blockIdx.x < g1;
        if (gemm_role) {
            { pg8::Gemm g{WSP(bf16, WS_XN), WSP(bf16, WS_WIN), T, INW, D}; PartOrder S; S.so.init(T, 14 * 256, g1, (int)blockIdx.x); S.f8 = 0;
              pg8::EpiBf16<0> E{WSP(bf16, WS_PROJ), INW, nullptr, 0, 0, 1.f};
              pg8::gemm_phase<pg8::EpiBf16<0>, PartOrder, true, true>(F.lds + RING_OFF, g, S, E); }
            { pg8::Gemm8 g{WSP(unsigned char, WS_XN8), WSP(unsigned char, WS_WIN8), T, INW, D}; PartOrder S; S.so.init(T, 12 * 256, g1, (int)blockIdx.x); S.f8 = 1;
              pg8::EpiBf16<0> E{WSP(bf16, WS_PROJ), INW, nullptr, 0, 0, 1.f};
              pg8::gemm_phase_f8<pg8::EpiBf16<0>, PartOrder, true, true>(F.lds + RING_OFF, g, S, E); } }
        if (!gemm_role || !split) {
            pg8::Gemm g{WSP(bf16, WS_MEMN), WSP(bf16, WS_WKV), MROWS, 1024, D}; pg8::StaticOrder S; S.init(MROWS, 1024, split ? F.G - g1 : F.G, split ? (int)blockIdx.x - g1 : (int)blockIdx.x);
            pg8::EpiBf16<0> E{WSP(bf16, WS_KV), 1024, nullptr, 0, 0, 1.f};
            pg8::gemm_phase<pg8::EpiBf16<0>, pg8::StaticOrder, true, true>(F.lds + RING_OFF, g, S, E); }
        if (!gemm_role) conv_items(F, CI_SMALL + CI_D_P0, CI_ALL, ((int)blockIdx.x - g1) * NWAVES + F.wave, (F.G - g1) * NWAVES, (LAS float*)(F.lds + RING_OFF + F.wave * 16384));
        GRID_BAR();
    }
    if (IN(3)) { _Pragma("unroll 1") for (int rep = 0; rep < NREP(3); ++rep) { p2_mixers(F); GRID_BAR(); } }
    if (IN(4)) _Pragma("unroll 1") for (int rep = 0; rep < NREP(4); ++rep) {
        pg8::Gemm g{WSP(bf16, WS_OBR), WSP(bf16, WS_WBR), 3 * T, 3 * 1024, 512}; BranchOrder S; S.so.init(T, D, F.G, (int)blockIdx.x);
        EpiGate E{WSP(bf16, WS_PROJ) + C_G, WSP(bf16, WS_MERGED)};
        pg8::gemm_phase<EpiGate, BranchOrder, true, true>(F.lds + RING_OFF, g, S, E);
        GRID_BAR();
    }
    if (IN(6)) _Pragma("unroll 1") for (int rep = 0; rep < NREP(6); ++rep) {
        pg8::Gemm g{WSP(bf16, WS_MERGED), WSP(bf16, WS_WO), T, D, D}; pg8::StaticOrder S; S.init(T, D, F.G, (int)blockIdx.x);
        EpiResF32 E{in_ptr(I_X), F.out, D, WSP(float, WS_SSQ)};
        pg8::gemm_phase<EpiResF32, pg8::StaticOrder, true, true>(F.lds + RING_OFF, g, S, E);
        GRID_BAR();
    }
    if (IN(7)) { p5_route(F); GRID_BAR(); }
    if (IN(9)) _Pragma("unroll 1") for (int rep = 0; rep < NREP(9); ++rep) {
        moe_table(F);
        const volatile LAS int* tab = (const volatile LAS int*)(F.lds + TAB_OFF);
        pg8::Gemm8 g{WSP(unsigned char, WS_HF8), WSP(unsigned char, WS_WGU), T, NE * 2048, D}; MoeOrder S{tab, 8, __builtin_amdgcn_readfirstlane(tab[40]), F.G, (int)blockIdx.x, WSP(int, WS_LIST)};
        EpiSwiglu E{WSP(unsigned char, WS_ACT), in_ptr(I_BGU)};
        pg8::gemm_phase_f8g<EpiSwiglu, MoeOrder, true, true>(F.lds + RING_OFF, (LAS int*)(F.lds + TAB_OFF + 2048), g, S, E);
        GRID_BAR();
    }
    if (IN(10)) _Pragma("unroll 1") for (int rep = 0; rep < NREP(10); ++rep) {
        if (!IN(9)) moe_table(F);
        const volatile LAS int* tab = (const volatile LAS int*)(F.lds + TAB_OFF);
        pg8::Gemm8 g{WSP(unsigned char, WS_ACT), WSP(unsigned char, WS_WD), SLOTROWS, NE * 1024, FF}; MoeOrder S{tab, 4, __builtin_amdgcn_readfirstlane(tab[40]), F.G, (int)blockIdx.x, nullptr};
        EpiF8Bias E{WSP(unsigned char, WS_Y), D, in_ptr(I_BD), 1024};
        pg8::gemm_phase_f8<EpiF8Bias, MoeOrder, true, true>(F.lds + RING_OFF, g, S, E);
        GRID_BAR();
    }
    if (IN(11)) { p8_combine(F); }
#undef IN
#undef GRID_BAR
}

extern "C" void kernel_launch(void* const* d_in, const int* in_sizes, int n_in, void* d_out, int out_size, void* d_ws, size_t ws_size, hipStream_t stream) {
    static int grid = 0;
    if (grid == 0) {
        if (n_in != 22 || out_size != T * D || ws_size < WS_END) { fprintf(stderr, "kernel_launch: unexpected problem (n_in %d, out %d, ws %zu)\n", n_in, out_size, ws_size); grid = -1; return; }
        int dev = 0, cus = 0, per_cu = 0;
        if (hipGetDevice(&dev) != hipSuccess || hipDeviceGetAttribute(&cus, hipDeviceAttributeMultiprocessorCount, dev) != hipSuccess) { grid = -1; return; }
        if (hipFuncSetAttribute((const void*)fwd_kernel, hipFuncAttributeMaxDynamicSharedMemorySize, LDS_BYTES) != hipSuccess) { fprintf(stderr, "kernel_launch: hipFuncSetAttribute failed\n"); grid = -1; return; }
        if (hipOccupancyMaxActiveBlocksPerMultiprocessor(&per_cu, (const void*)fwd_kernel, NWAVES * 64, LDS_BYTES) != hipSuccess || per_cu < 1) { fprintf(stderr, "kernel_launch: occupancy query says %d\n", per_cu); (void)hipGetLastError(); grid = -1; return; }
        grid = cus;
    }
    if (grid < 0) return;
    if (hipMemsetAsync((char*)d_ws + WS_CTL, 0, CTL_ZERO_BYTES, stream) != hipSuccess) { fprintf(stderr, "kernel_launch: memset failed\n"); return; }
    Args a{};
    for (int i = 0; i < 22; ++i) a.in[i] = (const float*)d_in[i];
    a.out = (float*)d_out; a.ws = (unsigned char*)d_ws; a.ph_lo = 0; a.ph_hi = 12;
    void* kargs[] = {&a};
    const hipError_t le = hipLaunchCooperativeKernel((const void*)fwd_kernel, dim3(grid), dim3(NWAVES * 64), kargs, LDS_BYTES, stream);
    if (le != hipSuccess) fprintf(stderr, "kernel_launch: launch failed: %s (grid %d)\n", hipGetErrorName(le), grid);
}
```

```cpp
#include <hip/hip_runtime.h>
#include <cstdio>
#include <cstdint>
namespace pg8 {
#define PG8_LAS __attribute__((address_space(3)))
typedef unsigned short bf16_t;
typedef short bf16x8 __attribute__((ext_vector_type(8)));
typedef float f32x4 __attribute__((ext_vector_type(4)));
typedef unsigned u32x4 __attribute__((ext_vector_type(4)));
constexpr int BM = 256, BK = 64, HALF = 128, HTB = HALF * BK * 2  , STAGE_BYTES = 8 * HTB, NXCD = 8, WGM = 8;

__host__ __device__ __forceinline__ int lds_byte(int r, int c) { const int st = (r >> 4) * 2 + (c >> 5), rr = r & 15, cc = c & 31, ob = rr * 64 + cc * 2; return st * 1024 + (ob ^ (((ob >> 9) & 1) << 5)); }
__host__ __device__ __forceinline__ void stage_rc(int b, int& R, int& C) { const int st = b / 1024, sb = b % 1024, swz = sb ^ (((sb >> 9) & 1) << 5); R = (st >> 1) * 16 + swz / 64; C = (st & 1) * 32 + (swz % 64) / 2; }
__host__ __device__ __forceinline__ int perm32(int rho) { const int n = rho >> 4, i = rho & 15; return 8 * (i >> 2) + 4 * n + (i & 3); }

struct Unit { int pm, pn; };
struct Gemm { const bf16_t* A; const bf16_t* Bt; int M, N, K; };

struct StaticOrder {
    int nM, nN, nwg, G, c;
    __host__ __device__ void init(int M, int N, int G_, int c_) { nM = M / BM; nN = N / BM; nwg = nM * nN; G = G_; c = c_; }
    __host__ __device__ bool next(int i, Unit& u) const {
        const long L = (long)i * G + c; if (L >= nwg) return false;
        int wgid = (int)L; { const int q = nwg / NXCD, r = nwg % NXCD, xcd = wgid % NXCD, off = wgid / NXCD; wgid = (xcd < r ? xcd * (q + 1) : r * (q + 1) + (xcd - r) * q) + off; }
        const int nig = WGM * nN, gid = wgid / nig, fm = gid * WGM, gsz = (nM - fm) < WGM ? (nM - fm) : WGM;
        u.pm = fm + ((wgid % nig) % gsz); u.pn = (wgid % nig) / gsz; return true;
    }
    __device__ __forceinline__ void a_ready(const Unit&) const {}
    __device__ __forceinline__ void done(const Unit&) const {}
};

__device__ __forceinline__ unsigned cvt_pk_bf16(float lo, float hi) { unsigned r; asm volatile("v_cvt_pk_bf16_f32 %0, %1, %2" : "=v"(r) : "v"(lo), "v"(hi)); return r; }
typedef float f32x2 __attribute__((ext_vector_type(2)));
__device__ __forceinline__ f32x2 gelu_pk(f32x2 v) {
    const f32x2 av = __builtin_elementwise_abs(v), d = av * 0.2316418882f + 1.0f;
    f32x2 t; t.x = __builtin_amdgcn_rcpf(d.x); t.y = __builtin_amdgcn_rcpf(d.y);
    f32x2 q = t * 0.5307027145f + (-0.7265760135f); q = q * t + 0.7107068705f; q = q * t + (-0.142248368f); q = q * t + 0.127414796f; q = q * t;
    const f32x2 s = (v * v) * (-0.72134752044f);
    f32x2 e; e.x = __builtin_amdgcn_exp2f(s.x); e.y = __builtin_amdgcn_exp2f(s.y);
    const f32x2 m = v * (q * e), r = v - m;
    f32x2 o; o.x = v.x < 0.f ? m.x : r.x; o.y = v.y < 0.f ? m.y : r.y; return o;
}

template <int ACT  > struct EpiBf16 {
    static constexpr int NST = 16;
    static constexpr bool PERM = true, AFTER_DRAIN = false; static_assert(ACT == 0 || ACT == 1, "EpiBf16: ACT is 0 (none) or 1 (gelu_pk)");
    bf16_t* O; int ldc; const float* bias; int split_cols; size_t split_stride; float scale0;
    __device__ __forceinline__ void operator()(const f32x4 (&acc)[2][2][4][2], const Unit& u, int wr, int wc, int fr, int fq) const {
        const int row0 = u.pm * BM + wr * 64 + fr; int colt = u.pn * BM; bf16_t* base = O;
        float sc = 1.f; if (split_cols) { const int t = colt / split_cols; base += (size_t)t * split_stride; colt -= t * split_cols; if (t == 0) sc = scale0; }
        const int col0 = colt + wc * 32 + 8 * fq, bcol0 = u.pn * BM + wc * 32 + 8 * fq;
        f32x4 bv[2][2];
#pragma unroll
        for (int bj = 0; bj < 2; ++bj)
#pragma unroll
            for (int n = 0; n < 2; ++n) bv[bj][n] = bias ? *(const f32x4*)(bias + bcol0 + bj * HALF + 4 * n) : (f32x4){0.f, 0.f, 0.f, 0.f};
#pragma unroll
        for (int ai = 0; ai < 2; ++ai)
#pragma unroll
            for (int m = 0; m < 4; ++m) { bf16_t* rowp = base + (size_t)(row0 + ai * HALF + m * 16) * ldc + col0;
#pragma unroll
                for (int bj = 0; bj < 2; ++bj) { f32x4 v0 = acc[ai][bj][m][0] + bv[bj][0], v1 = acc[ai][bj][m][1] + bv[bj][1];
                    if (ACT == 1) { f32x2 a = gelu_pk((f32x2){v0[0], v0[1]}), b = gelu_pk((f32x2){v0[2], v0[3]}), c = gelu_pk((f32x2){v1[0], v1[1]}), d = gelu_pk((f32x2){v1[2], v1[3]});
                        v0 = (f32x4){a.x, a.y, b.x, b.y}; v1 = (f32x4){c.x, c.y, d.x, d.y}; }
                    v0 = v0 * sc; v1 = v1 * sc; u32x4 w; w.x = cvt_pk_bf16(v0[0], v0[1]); w.y = cvt_pk_bf16(v0[2], v0[3]); w.z = cvt_pk_bf16(v1[0], v1[1]); w.w = cvt_pk_bf16(v1[2], v1[3]);
                    *(u32x4*)(rowp + bj * HALF) = w; } }
    }
};
template <class Epi, class Sched, bool ALIGN_EPI = false, bool SP2 = false>
__device__ __forceinline__ void gemm_phase(PG8_LAS unsigned char* lds, const Gemm g, const Sched& S, const Epi& E) {
    const int tid = threadIdx.x, wid = __builtin_amdgcn_readfirstlane(tid >> 6), lane = tid & 63, wr = wid >> 2, wc = wid & 3, fr = lane & 15, fq = lane >> 4;
    const int K = g.K, nt = K / BK;
    unsigned voffA[2], voffB[2];
#pragma unroll
    for (int i = 0; i < 2; ++i) { int R, C; stage_rc(tid * 16 + i * 8192, R, C); const int Rb = Epi::PERM ? ((R & ~31) + perm32(R & 31)) : R;
        voffA[i] = (unsigned)(R * K + C) * 2u; voffB[i] = (unsigned)(Rb * K + C) * 2u; }
    const size_t kstep = (size_t)(BK * 2);
    const size_t hstep = (size_t)HALF * K * 2;
    const size_t tstep = 2 * hstep;
    const unsigned ldsw = (unsigned)wid * 1024u;
    const int aoff = lds_byte(wr * 64 + fr, fq * 8), boff = lds_byte(wc * 32 + fr, fq * 8);
#define PG8_SA(b, h) (((b) * 2 + (h)) * HTB)
#define PG8_SB(b, h) ((4 + (b) * 2 + (h)) * HTB)
#define PG8_STAGE(bufoff, gbase, voff) do { _Pragma("unroll") for (int _i = 0; _i < 2; ++_i) \
        __builtin_amdgcn_global_load_lds((const unsigned*)((const char*)(gbase) + (voff)[_i]), (PG8_LAS unsigned*)(lds + (bufoff) + ldsw + _i * 8192), 16, 0, 0); } while (0)
#define PG8_LDA(dst, b, h) do { _Pragma("unroll") for (int m = 0; m < 4; ++m) _Pragma("unroll") for (int k = 0; k < 2; ++k) dst[m][k] = *(const PG8_LAS bf16x8*)(lds + PG8_SA(b, h) + aoff + m * 2048 + k * 1024); } while (0)
#define PG8_LDB(dst, b, h) do { _Pragma("unroll") for (int n = 0; n < 2; ++n) _Pragma("unroll") for (int k = 0; k < 2; ++k) dst[n][k] = *(const PG8_LAS bf16x8*)(lds + PG8_SB(b, h) + boff + n * 2048 + k * 1024); } while (0)
#define PG8_MMA(ai, bj, At, Bt) do { __builtin_amdgcn_s_setprio(1); _Pragma("unroll") for (int m = 0; m < 4; ++m) _Pragma("unroll") for (int n = 0; n < 2; ++n) _Pragma("unroll") for (int k = 0; k < 2; ++k) \
        acc[ai][bj][m][n] = __builtin_amdgcn_mfma_f32_16x16x32_bf16(Bt[n][k], At[m][k], acc[ai][bj][m][n], 0, 0, 0); __builtin_amdgcn_s_setprio(0); } while (0)
#define PG8_WAIT_V(n) asm volatile("s_waitcnt vmcnt(" #n ")" ::: "memory")
#define PG8_WAIT_VE(nweak, nstrong, flag) asm volatile("s_waitcnt vmcnt(%0)\n\tv_cmp_ne_u32_e32 vcc, 0, %2\n\ts_nop 3\n\ts_cbranch_vccnz 1f\n\ts_waitcnt vmcnt(%1)\n1:" :: "n"(nweak), "n"(nstrong), "v"(flag) : "memory", "vcc")
#define PG8_WAIT_L(n) asm volatile("s_waitcnt lgkmcnt(" #n ")" ::: "memory")
#define PG8_BAR __builtin_amdgcn_s_barrier()
#define PG8_SCHED __builtin_amdgcn_sched_barrier(0)
    Unit cur, nxt; int ui = 0;
    if (!S.next(0, cur)) return;
    f32x4 acc[2][2][4][2];
#pragma unroll
    for (int a = 0; a < 2; ++a)
#pragma unroll
        for (int b = 0; b < 2; ++b)
#pragma unroll
            for (int m = 0; m < 4; ++m)
#pragma unroll
                for (int n = 0; n < 2; ++n) acc[a][b][m][n] = (f32x4){0.f, 0.f, 0.f, 0.f};
    bf16x8 At[4][2], B0[2][2], B1[2][2];
    const char* cA = (const char*)g.A + (size_t)cur.pm * tstep; const char* cB = (const char*)g.Bt + (size_t)cur.pn * tstep;
    S.a_ready(cur);
    if constexpr (SP2) {
        PG8_STAGE(PG8_SB(0, 0), cB, voffB); PG8_STAGE(PG8_SB(0, 1), cB + hstep, voffB); PG8_STAGE(PG8_SA(0, 0), cA, voffA); PG8_STAGE(PG8_SA(0, 1), cA + hstep, voffA);
        if (wr == 1) PG8_BAR;
        PG8_WAIT_V(2); PG8_BAR;
        PG8_STAGE(PG8_SB(1, 0), cB + kstep, voffB); PG8_STAGE(PG8_SA(1, 0), cA + kstep, voffA); PG8_STAGE(PG8_SB(1, 1), cB + hstep + kstep, voffB);
        PG8_WAIT_V(6); PG8_BAR;
    } else {
        PG8_STAGE(PG8_SB(0, 0), cB, voffB); PG8_STAGE(PG8_SA(0, 0), cA, voffA); PG8_STAGE(PG8_SB(0, 1), cB + hstep, voffB); PG8_STAGE(PG8_SA(0, 1), cA + hstep, voffA);
        if (wr == 1) PG8_BAR;
        PG8_WAIT_V(4); PG8_BAR;
        PG8_STAGE(PG8_SB(1, 0), cB + kstep, voffB); PG8_STAGE(PG8_SA(1, 0), cA + kstep, voffA); PG8_STAGE(PG8_SB(1, 1), cB + hstep + kstep, voffB);
        PG8_WAIT_V(6); PG8_BAR;
    }
    for (;;) {
        const bool has_next = S.next(ui + 1, nxt);
        const char* nA = has_next ? (const char*)g.A + (size_t)nxt.pm * tstep : cA; const char* nB = has_next ? (const char*)g.Bt + (size_t)nxt.pn * tstep : cB;
        for (int t = 0; t < nt; t += 2) {
            const bool last = (t == nt - 2);
            const int fe = ((t == 0) && (ui > 0)) ? 1 : 0;
            const char* a1 = cA + (size_t)(t + 1) * kstep;
            const char* a2 = last ? nA : cA + (size_t)(t + 2) * kstep; const char* b2 = last ? nB : cB + (size_t)(t + 2) * kstep;
            const char* a3 = a2 + kstep; const char* b3 = b2 + kstep;
            if (last && has_next) S.a_ready(nxt);
            if constexpr (SP2) {
            PG8_LDB(B0, 0, 0); PG8_LDB(B1, 0, 1); PG8_SCHED; PG8_LDA(At, 0, 0); PG8_STAGE(PG8_SA(1, 1), a1 + hstep, voffA);
            PG8_WAIT_VE(8 + Epi::NST, 8, fe); PG8_WAIT_L(0); PG8_BAR; PG8_MMA(0, 0, At, B0); PG8_MMA(0, 1, At, B1); PG8_BAR; PG8_SCHED;
            PG8_LDA(At, 0, 1); PG8_STAGE(PG8_SB(0, 0), b2, voffB); PG8_STAGE(PG8_SB(0, 1), b2 + hstep, voffB); PG8_STAGE(PG8_SA(0, 0), a2, voffA);
            PG8_WAIT_VE(8 + Epi::NST, 8, fe); PG8_WAIT_L(0); PG8_BAR; PG8_MMA(1, 0, At, B0); PG8_MMA(1, 1, At, B1); PG8_BAR; PG8_SCHED;
            PG8_LDB(B0, 1, 0); PG8_LDB(B1, 1, 1); PG8_SCHED; PG8_LDA(At, 1, 0); PG8_STAGE(PG8_SA(0, 1), a2 + hstep, voffA);
            PG8_WAIT_V(8); PG8_WAIT_L(0); PG8_BAR; PG8_MMA(0, 0, At, B0); PG8_MMA(0, 1, At, B1); PG8_BAR; PG8_SCHED;
            PG8_LDA(At, 1, 1); PG8_STAGE(PG8_SB(1, 0), b3, voffB); PG8_STAGE(PG8_SB(1, 1), b3 + hstep, voffB); PG8_STAGE(PG8_SA(1, 0), a3, voffA);
            PG8_WAIT_V(8); PG8_WAIT_L(0); PG8_BAR; PG8_MMA(1, 0, At, B0); PG8_MMA(1, 1, At, B1); PG8_BAR; PG8_SCHED;
            } else {
            PG8_LDB(B0, 0, 0); PG8_SCHED; PG8_LDA(At, 0, 0); PG8_STAGE(PG8_SA(1, 1), a1 + hstep, voffA);
            PG8_WAIT_L(8); PG8_BAR; PG8_WAIT_L(0); PG8_MMA(0, 0, At, B0); PG8_BAR; PG8_SCHED;
            PG8_LDB(B1, 0, 1); PG8_STAGE(PG8_SB(0, 0), b2, voffB);
            PG8_BAR; PG8_WAIT_L(0); PG8_MMA(0, 1, At, B1); PG8_BAR;
            PG8_LDA(At, 0, 1); PG8_STAGE(PG8_SA(0, 0), a2, voffA);
            PG8_BAR; PG8_WAIT_L(0); PG8_MMA(1, 0, At, B0); PG8_BAR; PG8_SCHED;
            PG8_STAGE(PG8_SB(0, 1), b2 + hstep, voffB);
            PG8_WAIT_V(6); PG8_BAR; PG8_MMA(1, 1, At, B1); PG8_BAR;
            PG8_LDB(B0, 1, 0); PG8_SCHED; PG8_LDA(At, 1, 0); PG8_STAGE(PG8_SA(0, 1), a2 + hstep, voffA);
            PG8_WAIT_L(8); PG8_BAR; PG8_WAIT_L(0); PG8_MMA(0, 0, At, B0); PG8_BAR; PG8_SCHED;
            PG8_LDB(B1, 1, 1); PG8_STAGE(PG8_SB(1, 0), b3, voffB);
            PG8_BAR; PG8_WAIT_L(0); PG8_MMA(0, 1, At, B1); PG8_BAR;
            PG8_LDA(At, 1, 1); PG8_STAGE(PG8_SA(1, 0), a3, voffA);
            PG8_BAR; PG8_WAIT_L(0); PG8_MMA(1, 0, At, B0); PG8_BAR; PG8_SCHED;
            PG8_STAGE(PG8_SB(1, 1), b3 + hstep, voffB);
            PG8_WAIT_V(6); PG8_BAR; PG8_MMA(1, 1, At, B1); PG8_BAR;
            }
        }
        if constexpr (ALIGN_EPI) { if (wr == 0) PG8_BAR; }
        if constexpr (!Epi::AFTER_DRAIN) { E(acc, cur, wr, wc, fr, fq); S.done(cur); }
        if (!has_next) break;
#pragma unroll
        for (int a = 0; a < 2; ++a)
#pragma unroll
            for (int b = 0; b < 2; ++b)
#pragma unroll
                for (int m = 0; m < 4; ++m)
#pragma unroll
                    for (int n = 0; n < 2; ++n) acc[a][b][m][n] = (f32x4){0.f, 0.f, 0.f, 0.f};
        cur = nxt; cA = nA; cB = nB; ++ui;
        if constexpr (ALIGN_EPI) { if (wr == 1) PG8_BAR; }
    }
    PG8_WAIT_V(0);
    if constexpr (!ALIGN_EPI) { if (wr == 0) PG8_BAR; }
    PG8_BAR;
    if constexpr (Epi::AFTER_DRAIN) { E.fused(acc, cur, wr, wc, fr, fq, lds, wid, lane); S.done(cur); }
#undef PG8_SA
#undef PG8_SB
#undef PG8_STAGE
#undef PG8_LDA
#undef PG8_LDB
#undef PG8_MMA
#undef PG8_WAIT_V
#undef PG8_WAIT_VE
#undef PG8_WAIT_L
#undef PG8_BAR
#undef PG8_SCHED
}
}

#ifndef PG8_SP2
#define PG8_SP2 true
#endif
#ifndef PG8_ALIGN
#define PG8_ALIGN true
#endif
namespace pg8 {
typedef int i32x4 __attribute__((ext_vector_type(4)));
typedef int i32x8 __attribute__((ext_vector_type(8)));
struct Gemm8 { const unsigned char* A; const unsigned char* Bt; int M, N, K; };
template <class Epi, class Sched, bool ALIGN_EPI = false, bool SP2 = false>
__device__ __forceinline__ void gemm_phase_f8(PG8_LAS unsigned char* lds, const Gemm8 g, const Sched& S, const Epi& E) {
    const int tid = threadIdx.x, wid = __builtin_amdgcn_readfirstlane(tid >> 6), lane = tid & 63, wr = wid >> 2, wc = wid & 3, fr = lane & 15, fq = lane >> 4;
    const int K = g.K, nt = K / 128;
    unsigned voffA[2], voffB[2];
#pragma unroll
    for (int i = 0; i < 2; ++i) { int R, C; stage_rc(tid * 16 + i * 8192, R, C); const int Rb = Epi::PERM ? ((R & ~31) + perm32(R & 31)) : R;
        voffA[i] = (unsigned)(R * K + C * 2); voffB[i] = (unsigned)(Rb * K + C * 2); }
    const size_t kstep = (size_t)(BK * 2);
    const size_t hstep = (size_t)HALF * K;
    const size_t tstep = 2 * hstep;
    const unsigned ldsw = (unsigned)wid * 1024u;
    const int aoff = lds_byte(wr * 64 + fr, fq * 8), boff = lds_byte(wc * 32 + fr, fq * 8);
#define PG8_SA(b, h) (((b) * 2 + (h)) * HTB)
#define PG8_SB(b, h) ((4 + (b) * 2 + (h)) * HTB)
#define PG8_STAGE(bufoff, gbase, voff) do { _Pragma("unroll") for (int _i = 0; _i < 2; ++_i) \
        __builtin_amdgcn_global_load_lds((const unsigned*)((const char*)(gbase) + (voff)[_i]), (PG8_LAS unsigned*)(lds + (bufoff) + ldsw + _i * 8192), 16, 0, 0); } while (0)
#define PG8_LD32(p) __builtin_shufflevector(*(const PG8_LAS i32x4*)(p), *(const PG8_LAS i32x4*)((p) + 1024), 0, 1, 2, 3, 4, 5, 6, 7)
#define PG8_LDA(dst, b, h) do { _Pragma("unroll") for (int m = 0; m < 4; ++m) dst[m] = PG8_LD32(lds + PG8_SA(b, h) + aoff + m * 2048); } while (0)
#define PG8_LDB(dst, b, h) do { _Pragma("unroll") for (int n = 0; n < 2; ++n) dst[n] = PG8_LD32(lds + PG8_SB(b, h) + boff + n * 2048); } while (0)
#define PG8_MMA(ai, bj, At, Bt) do { __builtin_amdgcn_s_setprio(1); _Pragma("unroll") for (int m = 0; m < 4; ++m) _Pragma("unroll") for (int n = 0; n < 2; ++n) \
        asm volatile("v_mfma_scale_f32_16x16x128_f8f6f4 %0, %1, %2, %0, %3, %3 op_sel_hi:[0,0,0]" : "+v"(acc[ai][bj][m][n]) : "v"(Bt[n]), "v"(At[m]), "v"(one_scale)); __builtin_amdgcn_s_setprio(0); } while (0)
#define PG8_WAIT_V(n) asm volatile("s_waitcnt vmcnt(" #n ")" ::: "memory")
#define PG8_WAIT_VE(nweak, nstrong, flag) asm volatile("s_waitcnt vmcnt(%0)\n\tv_cmp_ne_u32_e32 vcc, 0, %2\n\ts_nop 3\n\ts_cbranch_vccnz 1f\n\ts_waitcnt vmcnt(%1)\n1:" :: "n"(nweak), "n"(nstrong), "v"(flag) : "memory", "vcc")
#define PG8_WAIT_L(n) asm volatile("s_waitcnt lgkmcnt(" #n ")" ::: "memory")
#define PG8_BAR __builtin_amdgcn_s_barrier()
#define PG8_SCHED __builtin_amdgcn_sched_barrier(0)
    Unit cur, nxt; int ui = 0;
    if (!S.next(0, cur)) return;
    f32x4 acc[2][2][4][2];
#pragma unroll
    for (int a = 0; a < 2; ++a)
#pragma unroll
        for (int b = 0; b < 2; ++b)
#pragma unroll
            for (int m = 0; m < 4; ++m)
#pragma unroll
                for (int n = 0; n < 2; ++n) acc[a][b][m][n] = (f32x4){0.f, 0.f, 0.f, 0.f};
    i32x8 At[4], B0[2], B1[2];
    int one_scale = 0x7f7f7f7f; asm volatile("" : "+v"(one_scale));
    const char* cA = (const char*)g.A + (size_t)cur.pm * tstep; const char* cB = (const char*)g.Bt + (size_t)cur.pn * tstep;
    S.a_ready(cur);
    if constexpr (SP2) {
        PG8_STAGE(PG8_SB(0, 0), cB, voffB); PG8_STAGE(PG8_SB(0, 1), cB + hstep, voffB); PG8_STAGE(PG8_SA(0, 0), cA, voffA); PG8_STAGE(PG8_SA(0, 1), cA + hstep, voffA);
        if (wr == 1) PG8_BAR;
        PG8_WAIT_V(2); PG8_BAR;
        PG8_STAGE(PG8_SB(1, 0), cB + kstep, voffB); PG8_STAGE(PG8_SA(1, 0), cA + kstep, voffA); PG8_STAGE(PG8_SB(1, 1), cB + hstep + kstep, voffB);
        PG8_WAIT_V(6); PG8_BAR;
    } else {
        PG8_STAGE(PG8_SB(0, 0), cB, voffB); PG8_STAGE(PG8_SA(0, 0), cA, voffA); PG8_STAGE(PG8_SB(0, 1), cB + hstep, voffB); PG8_STAGE(PG8_SA(0, 1), cA + hstep, voffA);
        if (wr == 1) PG8_BAR;
        PG8_WAIT_V(4); PG8_BAR;
        PG8_STAGE(PG8_SB(1, 0), cB + kstep, voffB); PG8_STAGE(PG8_SA(1, 0), cA + kstep, voffA); PG8_STAGE(PG8_SB(1, 1), cB + hstep + kstep, voffB);
        PG8_WAIT_V(6); PG8_BAR;
    }
    for (;;) {
        const bool has_next = S.next(ui + 1, nxt);
        const char* nA = has_next ? (const char*)g.A + (size_t)nxt.pm * tstep : cA; const char* nB = has_next ? (const char*)g.Bt + (size_t)nxt.pn * tstep : cB;
_Pragma("unroll 1")
        for (int t = 0; t < nt; t += 2) {
            const bool last = (t == nt - 2);
            const int fe = ((t == 0) && (ui > 0)) ? 1 : 0;
            const char* a1 = cA + (size_t)(t + 1) * kstep;
            const char* a2 = last ? nA : cA + (size_t)(t + 2) * kstep; const char* b2 = last ? nB : cB + (size_t)(t + 2) * kstep;
            const char* a3 = a2 + kstep; const char* b3 = b2 + kstep;
            if (last && has_next) S.a_ready(nxt);
            if constexpr (SP2) {
            PG8_LDB(B0, 0, 0); PG8_LDB(B1, 0, 1); PG8_SCHED; PG8_LDA(At, 0, 0); PG8_STAGE(PG8_SA(1, 1), a1 + hstep, voffA);
            PG8_WAIT_VE(8 + Epi::NST, 8, fe); PG8_WAIT_L(0); PG8_BAR; PG8_MMA(0, 0, At, B0); PG8_MMA(0, 1, At, B1); PG8_BAR; PG8_SCHED;
            PG8_LDA(At, 0, 1); PG8_STAGE(PG8_SB(0, 0), b2, voffB); PG8_STAGE(PG8_SB(0, 1), b2 + hstep, voffB); PG8_STAGE(PG8_SA(0, 0), a2, voffA);
            PG8_WAIT_VE(8 + Epi::NST, 8, fe); PG8_WAIT_L(0); PG8_BAR; PG8_MMA(1, 0, At, B0); PG8_MMA(1, 1, At, B1); PG8_BAR; PG8_SCHED;
            PG8_LDB(B0, 1, 0); PG8_LDB(B1, 1, 1); PG8_SCHED; PG8_LDA(At, 1, 0); PG8_STAGE(PG8_SA(0, 1), a2 + hstep, voffA);
            PG8_WAIT_V(8); PG8_WAIT_L(0); PG8_BAR; PG8_MMA(0, 0, At, B0); PG8_MMA(0, 1, At, B1); PG8_BAR; PG8_SCHED;
            PG8_LDA(At, 1, 1); PG8_STAGE(PG8_SB(1, 0), b3, voffB); PG8_STAGE(PG8_SB(1, 1), b3 + hstep, voffB); PG8_STAGE(PG8_SA(1, 0), a3, voffA);
            PG8_WAIT_V(8); PG8_WAIT_L(0); PG8_BAR; PG8_MMA(1, 0, At, B0); PG8_MMA(1, 1, At, B1); PG8_BAR; PG8_SCHED;
            } else {
            PG8_LDB(B0, 0, 0); PG8_SCHED; PG8_LDA(At, 0, 0); PG8_STAGE(PG8_SA(1, 1), a1 + hstep, voffA);
            PG8_WAIT_L(8); PG8_BAR; PG8_WAIT_L(0); PG8_MMA(0, 0, At, B0); PG8_BAR; PG8_SCHED;
            PG8_LDB(B1, 0, 1); PG8_STAGE(PG8_SB(0, 0), b2, voffB);
            PG8_BAR; PG8_WAIT_L(0); PG8_MMA(0, 1, At, B1); PG8_BAR;
            PG8_LDA(At, 0, 1); PG8_STAGE(PG8_SA(0, 0), a2, voffA);
            PG8_BAR; PG8_WAIT_L(0); PG8_MMA(1, 0, At, B0); PG8_BAR; PG8_SCHED;
            PG8_STAGE(PG8_SB(0, 1), b2 + hstep, voffB);
            PG8_WAIT_V(6); PG8_BAR; PG8_MMA(1, 1, At, B1); PG8_BAR;
            PG8_LDB(B0, 1, 0); PG8_SCHED; PG8_LDA(At, 1, 0); PG8_STAGE(PG8_SA(0, 1), a2 + hstep, voffA);
            PG8_WAIT_L(8); PG8_BAR; PG8_WAIT_L(0); PG8_MMA(0, 0, At, B0); PG8_BAR; PG8_SCHED;
            PG8_LDB(B1, 1, 1); PG8_STAGE(PG8_SB(1, 0), b3, voffB);
            PG8_BAR; PG8_WAIT_L(0); PG8_MMA(0, 1, At, B1); PG8_BAR;
            PG8_LDA(At, 1, 1); PG8_STAGE(PG8_SA(1, 0), a3, voffA);
            PG8_BAR; PG8_WAIT_L(0); PG8_MMA(1, 0, At, B0); PG8_BAR; PG8_SCHED;
            PG8_STAGE(PG8_SB(1, 1), b3 + hstep, voffB);
            PG8_WAIT_V(6); PG8_BAR; PG8_MMA(1, 1, At, B1); PG8_BAR;
            }
        }
        asm volatile("s_nop 15\n\ts_nop 15" ::: "memory");
        if constexpr (ALIGN_EPI) { if (wr == 0) PG8_BAR; }
        if constexpr (!Epi::AFTER_DRAIN) { E(acc, cur, wr, wc, fr, fq); S.done(cur); }
        if (!has_next) break;
#pragma unroll
        for (int a = 0; a < 2; ++a)
#pragma unroll
            for (int b = 0; b < 2; ++b)
#pragma unroll
                for (int m = 0; m < 4; ++m)
#pragma unroll
                    for (int n = 0; n < 2; ++n) acc[a][b][m][n] = (f32x4){0.f, 0.f, 0.f, 0.f};
        cur = nxt; cA = nA; cB = nB; ++ui;
        if constexpr (ALIGN_EPI) { if (wr == 1) PG8_BAR; }
    }
    PG8_WAIT_V(0);
    if constexpr (!ALIGN_EPI) { if (wr == 0) PG8_BAR; }
    PG8_BAR;
    if constexpr (Epi::AFTER_DRAIN) { E.fused(acc, cur, wr, wc, fr, fq, lds, wid, lane); S.done(cur); }
#undef PG8_SA
#undef PG8_SB
#undef PG8_STAGE
#undef PG8_LD32
#undef PG8_LDA
#undef PG8_LDB
#undef PG8_MMA
#undef PG8_WAIT_V
#undef PG8_WAIT_VE
#undef PG8_WAIT_L
#undef PG8_BAR
#undef PG8_SCHED
}
}
namespace pg8 {
template <class Epi, class Sched, bool ALIGN_EPI = false, bool SP2 = true>
__device__ __forceinline__ void gemm_phase_f8g(PG8_LAS unsigned char* lds, PG8_LAS int* itab, const Gemm8 g, const Sched& S, const Epi& E) {
    static_assert(SP2, "gather variant: SP2 schedule only");
    const int tid = threadIdx.x, wid = __builtin_amdgcn_readfirstlane(tid >> 6), lane = tid & 63, wr = wid >> 2, wc = wid & 3, fr = lane & 15, fq = lane >> 4;
    const int K = g.K, nt = K / 128;
    unsigned voffB[2], colA[2]; int rowA[2];
#pragma unroll
    for (int i = 0; i < 2; ++i) { int R, C; stage_rc(tid * 16 + i * 8192, R, C); const int Rb = Epi::PERM ? ((R & ~31) + perm32(R & 31)) : R;
        rowA[i] = R; colA[i] = (unsigned)(C * 2); voffB[i] = (unsigned)(Rb * K + C * 2); }
    unsigned vc[2][2], vn[2][2];
#define PG8_IDX_DMA(u_, buf_) do { if (wid < 4) { const int* lp_ = S.rows_list(u_); \
        __builtin_amdgcn_global_load_lds((const unsigned*)(lp_ + 64 * wid + lane), (PG8_LAS unsigned*)(itab + (buf_) * 256 + 64 * wid), 4, 0, 0); } } while (0)
#define PG8_IDX_READ(dst_, u_, buf_) do { const int nr_ = S.nrows(u_); _Pragma("unroll") for (int h_ = 0; h_ < 2; ++h_) _Pragma("unroll") for (int i_ = 0; i_ < 2; ++i_) { \
        const int r_ = h_ * HALF + rowA[i_]; const int t_ = itab[(buf_) * 256 + r_]; dst_[h_][i_] = (unsigned)((r_ < nr_ ? t_ : 0) * K) + colA[i_]; } } while (0)
    const size_t kstep = (size_t)(BK * 2);
    const size_t hstep = (size_t)HALF * K;
    const size_t tstep = 2 * hstep;
    const unsigned ldsw = (unsigned)wid * 1024u;
    const int aoff = lds_byte(wr * 64 + fr, fq * 8), boff = lds_byte(wc * 32 + fr, fq * 8);
#define PG8_SA(b, h) (((b) * 2 + (h)) * HTB)
#define PG8_SB(b, h) ((4 + (b) * 2 + (h)) * HTB)
#define PG8_STAGE(bufoff, gbase, voff) do { _Pragma("unroll") for (int _i = 0; _i < 2; ++_i) \
        __builtin_amdgcn_global_load_lds((const unsigned*)((const char*)(gbase) + (voff)[_i]), (PG8_LAS unsigned*)(lds + (bufoff) + ldsw + _i * 8192), 16, 0, 0); } while (0)
#define PG8_LD32(p) __builtin_shufflevector(*(const PG8_LAS i32x4*)(p), *(const PG8_LAS i32x4*)((p) + 1024), 0, 1, 2, 3, 4, 5, 6, 7)
#define PG8_LDA(dst, b, h) do { _Pragma("unroll") for (int m = 0; m < 4; ++m) dst[m] = PG8_LD32(lds + PG8_SA(b, h) + aoff + m * 2048); } while (0)
#define PG8_LDB(dst, b, h) do { _Pragma("unroll") for (int n = 0; n < 2; ++n) dst[n] = PG8_LD32(lds + PG8_SB(b, h) + boff + n * 2048); } while (0)
#define PG8_MMA(ai, bj, At, Bt) do { __builtin_amdgcn_s_setprio(1); _Pragma("unroll") for (int m = 0; m < 4; ++m) _Pragma("unroll") for (int n = 0; n < 2; ++n) \
        asm volatile("v_mfma_scale_f32_16x16x128_f8f6f4 %0, %1, %2, %0, %3, %3 op_sel_hi:[0,0,0]" : "+v"(acc[ai][bj][m][n]) : "v"(Bt[n]), "v"(At[m]), "v"(one_scale)); __builtin_amdgcn_s_setprio(0); } while (0)
#define PG8_WAIT_V(n) asm volatile("s_waitcnt vmcnt(" #n ")" ::: "memory")
#define PG8_WAIT_VE(nweak, nstrong, flag) asm volatile("s_waitcnt vmcnt(%0)\n\tv_cmp_ne_u32_e32 vcc, 0, %2\n\ts_nop 3\n\ts_cbranch_vccnz 1f\n\ts_waitcnt vmcnt(%1)\n1:" :: "n"(nweak), "n"(nstrong), "v"(flag) : "memory", "vcc")
#define PG8_WAIT_L(n) asm volatile("s_waitcnt lgkmcnt(" #n ")" ::: "memory")
#define PG8_BAR __builtin_amdgcn_s_barrier()
#define PG8_SCHED __builtin_amdgcn_sched_barrier(0)
    Unit cur, nxt; int ui = 0;
    if (!S.next(0, cur)) return;
    f32x4 acc[2][2][4][2];
#pragma unroll
    for (int a = 0; a < 2; ++a)
#pragma unroll
        for (int b = 0; b < 2; ++b)
#pragma unroll
            for (int m = 0; m < 4; ++m)
#pragma unroll
                for (int n = 0; n < 2; ++n) acc[a][b][m][n] = (f32x4){0.f, 0.f, 0.f, 0.f};
    i32x8 At[4], B0[2], B1[2];
    int one_scale = 0x7f7f7f7f; asm volatile("" : "+v"(one_scale));
    const char* gA = (const char*)g.A; const char* cB = (const char*)g.Bt + (size_t)cur.pn * tstep;
    S.a_ready(cur);
    PG8_IDX_DMA(cur, 0); PG8_WAIT_V(0); PG8_BAR; PG8_IDX_READ(vc, cur, 0);
    if constexpr (SP2) {
        PG8_STAGE(PG8_SB(0, 0), cB, voffB); PG8_STAGE(PG8_SB(0, 1), cB + hstep, voffB); PG8_STAGE(PG8_SA(0, 0), gA, vc[0]); PG8_STAGE(PG8_SA(0, 1), gA, vc[1]);
        if (wr == 1) PG8_BAR;
        PG8_WAIT_V(2); PG8_BAR;
        PG8_STAGE(PG8_SB(1, 0), cB + kstep, voffB); PG8_STAGE(PG8_SA(1, 0), gA + kstep, vc[0]); PG8_STAGE(PG8_SB(1, 1), cB + hstep + kstep, voffB);
        PG8_WAIT_V(6); PG8_BAR;
    }
    for (;;) {
        const bool has_next = S.next(ui + 1, nxt);
        const char* nB = has_next ? (const char*)g.Bt + (size_t)nxt.pn * tstep : cB;
        if (has_next) PG8_IDX_DMA(nxt, (ui + 1) & 1);
_Pragma("unroll 1")
        for (int t = 0; t < nt; t += 2) {
            const bool last = (t == nt - 2);
            const int fe = ((t == 0) && (ui > 0)) ? 1 : 0;
            const char* a1 = gA + (size_t)(t + 1) * kstep;
            const char* a2 = gA + (last ? (size_t)0 : (size_t)(t + 2) * kstep); const char* b2 = last ? nB : cB + (size_t)(t + 2) * kstep;
            const char* a3 = a2 + kstep; const char* b3 = b2 + kstep;
            if (last) { if (has_next) { S.a_ready(nxt); PG8_IDX_READ(vn, nxt, (ui + 1) & 1); } else { _Pragma("unroll") for (int h_ = 0; h_ < 2; ++h_) _Pragma("unroll") for (int i_ = 0; i_ < 2; ++i_) vn[h_][i_] = vc[h_][i_]; } }
            unsigned s0[2], s1[2];
            _Pragma("unroll") for (int i_ = 0; i_ < 2; ++i_) { s0[i_] = last ? vn[0][i_] : vc[0][i_]; s1[i_] = last ? vn[1][i_] : vc[1][i_]; }
            if constexpr (SP2) {
            PG8_LDB(B0, 0, 0); PG8_LDB(B1, 0, 1); PG8_SCHED; PG8_LDA(At, 0, 0); PG8_STAGE(PG8_SA(1, 1), a1, vc[1]);
            PG8_WAIT_VE(8 + Epi::NST, 8, fe); PG8_WAIT_L(0); PG8_BAR; PG8_MMA(0, 0, At, B0); PG8_MMA(0, 1, At, B1); PG8_BAR; PG8_SCHED;
            PG8_LDA(At, 0, 1); PG8_STAGE(PG8_SB(0, 0), b2, voffB); PG8_STAGE(PG8_SB(0, 1), b2 + hstep, voffB); PG8_STAGE(PG8_SA(0, 0), a2, s0);
            PG8_WAIT_VE(8 + Epi::NST, 8, fe); PG8_WAIT_L(0); PG8_BAR; PG8_MMA(1, 0, At, B0); PG8_MMA(1, 1, At, B1); PG8_BAR; PG8_SCHED;
            PG8_LDB(B0, 1, 0); PG8_LDB(B1, 1, 1); PG8_SCHED; PG8_LDA(At, 1, 0); PG8_STAGE(PG8_SA(0, 1), a2, s1);
            PG8_WAIT_V(8); PG8_WAIT_L(0); PG8_BAR; PG8_MMA(0, 0, At, B0); PG8_MMA(0, 1, At, B1); PG8_BAR; PG8_SCHED;
            PG8_LDA(At, 1, 1); PG8_STAGE(PG8_SB(1, 0), b3, voffB); PG8_STAGE(PG8_SB(1, 1), b3 + hstep, voffB); PG8_STAGE(PG8_SA(1, 0), a3, s0);
            PG8_WAIT_V(8); PG8_WAIT_L(0); PG8_BAR; PG8_MMA(1, 0, At, B0); PG8_MMA(1, 1, At, B1); PG8_BAR; PG8_SCHED;
            }
        }
        asm volatile("s_nop 15\n\ts_nop 15" ::: "memory");
        if constexpr (ALIGN_EPI) { if (wr == 0) PG8_BAR; }
        if constexpr (!Epi::AFTER_DRAIN) { E(acc, cur, wr, wc, fr, fq); S.done(cur); }
        if (!has_next) break;
#pragma unroll
        for (int a = 0; a < 2; ++a)
#pragma unroll
            for (int b = 0; b < 2; ++b)
#pragma unroll
                for (int m = 0; m < 4; ++m)
#pragma unroll
                    for (int n = 0; n < 2; ++n) acc[a][b][m][n] = (f32x4){0.f, 0.f, 0.f, 0.f};
        cur = nxt; cB = nB; ++ui;
        _Pragma("unroll") for (int h_ = 0; h_ < 2; ++h_) _Pragma("unroll") for (int i_ = 0; i_ < 2; ++i_) vc[h_][i_] = vn[h_][i_];
        if constexpr (ALIGN_EPI) { if (wr == 1) PG8_BAR; }
    }
    PG8_WAIT_V(0);
    if constexpr (!ALIGN_EPI) { if (wr == 0) PG8_BAR; }
    PG8_BAR;
    if constexpr (Epi::AFTER_DRAIN) { E.fused(acc, cur, wr, wc, fr, fq, lds, wid, lane); S.done(cur); }
#undef PG8_SA
#undef PG8_SB
#undef PG8_STAGE
#undef PG8_IDX_DMA
#undef PG8_IDX_READ
#undef PG8_LD32
#undef PG8_LDA
#undef PG8_LDB
#undef PG8_MMA
#undef PG8_WAIT_V
#undef PG8_WAIT_VE
#undef PG8_WAIT_L
#undef PG8_BAR
#undef PG8_SCHED
}
}
constexpr int NWAVES = 8;
constexpr int BATCH = 4, SEQ = 4096, T = BATCH * SEQ, D = 1024, INW = 6656;
constexpr int C_Q = 0, C_K = 512, C_V = 1024, C_CB = 1536, C_CC = 2048, C_CX = 2560, C_QM = 3072, C_G = 3584;
constexpr int MEMT = 256, MROWS = BATCH * MEMT;
constexpr int NE = 32, FF = 1024, TOPK = 4;
constexpr int MAXTILES = 288, SLOTROWS = MAXTILES * 256;
constexpr float RMS_EPS = 1e-6f;

constexpr size_t MiB = 1u << 20;
constexpr size_t WS_CTL = 0, CTL_ZERO_BYTES = 1 * MiB;
constexpr size_t WS_ROUTE = 1 * MiB;
constexpr size_t WS_WIN = 2 * MiB, WS_WKV = 15 * MiB, WS_WBR = 17 * MiB, WS_WO = 20 * MiB, WS_MEMN = 22 * MiB, WS_KV = 24 * MiB;
constexpr size_t WS_WGU = 26 * MiB, WS_WD = 154 * MiB, WS_XN = 218 * MiB, WS_MERGED = 250 * MiB, WS_Y = 282 * MiB;
constexpr size_t WS_PROJ = 426 * MiB, WS_OBR = 634 * MiB, WS_BO = 682 * MiB, WS_END = 778 * MiB;
constexpr size_t WS_WIN8 = 90 * MiB, WS_XN8 = 100 * MiB;
constexpr size_t WS_HF8 = 426 * MiB, WS_LIST = 458 * MiB;
constexpr size_t WS_SSQ = 460 * MiB;
constexpr size_t WS_XG = 426 * MiB, WS_ACT = 570 * MiB;
static_assert(WS_XG + (size_t)SLOTROWS * 1024 * 2 <= WS_ACT && WS_ACT + (size_t)SLOTROWS * 1024 * 2 <= WS_END, "overlay map");
static_assert(WS_Y + (size_t)SLOTROWS * 1024 * 2 <= WS_PROJ && WS_PROJ + (size_t)T * INW * 2 <= WS_OBR, "d_ws map");
constexpr int CW_BAR = 4096;
constexpr int CW_CNT = 8192;

constexpr int RING_OFF = 0, RING_BYTES = 131072;
constexpr int LDSCTL_OFF = 139264, MISC_OFF = LDSCTL_OFF + 320;
constexpr int TAB_OFF = LDSCTL_OFF + 1024;
constexpr int LDS_BYTES = 147456;

#define GAS __attribute__((address_space(1)))
#define LAS __attribute__((address_space(3)))
typedef unsigned short bf16;
typedef unsigned v4u __attribute__((ext_vector_type(4)));
typedef float f32x4 __attribute__((ext_vector_type(4)));
typedef short bf16x8 __attribute__((ext_vector_type(8)));
typedef GAS unsigned gu32;
typedef GAS unsigned long long gu64;
#define RLX_AGENT __ATOMIC_RELAXED, __HIP_MEMORY_SCOPE_AGENT
#define LDS_WAIT() asm volatile("s_waitcnt lgkmcnt(0)" ::: "memory")
#define VM_WAIT() asm volatile("s_waitcnt vmcnt(0)" ::: "memory")
__device__ __forceinline__ unsigned long long rt() { return __builtin_amdgcn_s_memrealtime(); }
__device__ __forceinline__ unsigned f2bf(float f) { unsigned u = __builtin_bit_cast(unsigned, f); return (u + 0x7fffu + ((u >> 16) & 1u)) >> 16; }
__device__ __forceinline__ unsigned pk2(float lo, float hi) { return f2bf(lo) | (f2bf(hi) << 16); }

#define XB_TMO      128
#define XB_XCNT(j)  (256  + 64 * (j))
#define XB_XSUB(j)  (1280 + 64 * (j))
#define XB_XGEN(j)  (2304 + 64 * (j))
#define XB_TOP      3328
#define XB_TOPGEN   3392
#define XCD_BAR_WORDS 3456
#define XB_SPIN_CAP (1u << 18)

__device__ __forceinline__ unsigned xb_ld(unsigned* p)              { return __hip_atomic_load(p, __ATOMIC_RELAXED, __HIP_MEMORY_SCOPE_AGENT); }
__device__ __forceinline__ unsigned xb_add(unsigned* p, unsigned v) { return __hip_atomic_fetch_add(p, v, __ATOMIC_RELAXED, __HIP_MEMORY_SCOPE_AGENT); }
__device__ __forceinline__ unsigned xb_xcc_id() { return (unsigned)__builtin_amdgcn_s_getreg((3 << 11) | 20) & 0xFu; }
#define XB_SPIN(cond, bar) do { unsigned _sp = 0; while (cond) { __builtin_amdgcn_s_sleep(1); \
    if ((++_sp & 255u) == 0u) { if (xb_ld(&(bar)[XB_TMO])) break; if (_sp > XB_SPIN_CAP) { atomicAdd(&(bar)[XB_TMO], 1u); break; } } } } while (0)

struct XcdBarrier {
    unsigned* bar; unsigned x;
    volatile LAS unsigned* st;
};

__device__ __forceinline__ XcdBarrier xcd_barrier_post(unsigned* bar, volatile LAS unsigned* st) {
    XcdBarrier b; b.bar = bar; b.x = xb_xcc_id(); b.st = st;
    if (threadIdx.x == 0) (void)xb_add(&bar[XB_XCNT(b.x)], 1u);
    return b;
}
__device__ __forceinline__ void xcd_barrier_complete(unsigned* bar, unsigned x, unsigned& nloc, unsigned& nx) {
    const unsigned G = gridDim.x * gridDim.y * gridDim.z;
    unsigned sum, cnt, mine, sp = 0u;
    for (;;) {
        sum = 0u; cnt = 0u; mine = 0u;
#pragma unroll
        for (unsigned j = 0; j < 16; ++j) { const unsigned c = xb_ld(&bar[XB_XCNT(j)]); sum += c; cnt += (c > 0u) ? 1u : 0u; mine = (j == x) ? c : mine; }
        if (sum == G) break;
        __builtin_amdgcn_s_sleep(1);
        if ((++sp & 255u) == 0u) { if (xb_ld(&bar[XB_TMO])) break; if (sp > XB_SPIN_CAP) { atomicAdd(&bar[XB_TMO], 1u); break; } }
    }
    nloc = mine > 0u ? mine : 1u; nx = cnt > 0u ? cnt : 1u;
}

__device__ __forceinline__ void xcd_barrier(const XcdBarrier& b) {
    asm volatile("s_waitcnt vmcnt(0)" ::: "memory");
    __syncthreads();
    if (threadIdx.x == 0) {
        unsigned* bar = b.bar;
        __builtin_amdgcn_s_waitcnt(0);
        unsigned nloc = b.st[0], nx = b.st[1];
        if (nloc == 0u) { xcd_barrier_complete(bar, b.x, nloc, nx); b.st[0] = nloc; b.st[1] = nx; }
        const unsigned old = xb_add(&bar[XB_XSUB(b.x)], 1u);
        const unsigned gen = old / nloc;
        if (old + 1u == (gen + 1u) * nloc) {
            __builtin_amdgcn_fence(__ATOMIC_RELEASE, "agent");
            asm volatile("s_waitcnt vmcnt(0)" ::: "memory");
            const unsigned og = xb_add(&bar[XB_TOP], 1u);
            const unsigned tg = og / nx;
            if (og + 1u == (tg + 1u) * nx) xb_add(&bar[XB_TOPGEN], 1u);
            else XB_SPIN(xb_ld(&bar[XB_TOPGEN]) == tg, bar);
            __builtin_amdgcn_fence(__ATOMIC_ACQUIRE, "agent");
            xb_add(&bar[XB_XGEN(b.x)], 1u);
            asm volatile("s_waitcnt vmcnt(0)" ::: "memory");
        } else {
            XB_SPIN(xb_ld(&bar[XB_XGEN(b.x)]) == gen, bar);
            __builtin_amdgcn_fence(__ATOMIC_ACQUIRE, "agent");
            asm volatile("s_waitcnt vmcnt(0)" ::: "memory");
        }
    }
    __syncthreads();
}

struct Frame {
    LAS unsigned char* lds;
    volatile LAS unsigned* MISC;
    gu32* ctl;
    unsigned char* ws; float* out;
    int tid, lane, wave, vcu, G;
};
typedef const __attribute__((address_space(4))) char* kargp_t;
__device__ __forceinline__ const float* in_ptr(int i) {
    kargp_t kp = (kargp_t)__builtin_amdgcn_kernarg_segment_ptr();
    asm volatile("" : "+s"(kp));
    return *(const float* const __attribute__((address_space(4)))*)(kp + 8 * i);
}
enum { I_X = 0, I_MEM, I_MIXG, I_WIN, I_SBQG, I_SBKG, I_CONVW, I_MEMG, I_WKV, I_MEMQG, I_MEMKG, I_WBRSB, I_WBRCONV, I_WBRMEM, I_WO, I_FFNG, I_WROUTER, I_BROUTER, I_WGU, I_BGU, I_WD, I_BD };
#define WSP(TY, off) ((TY*)(F.ws + (off)))

__device__ __forceinline__ float wave_sum(float v) {
#pragma unroll
    for (int o = 1; o < 64; o <<= 1) v += __shfl_xor(v, o);
    return v;
}
typedef unsigned u32x4s __attribute__((ext_vector_type(4)));
typedef unsigned u32x2s __attribute__((ext_vector_type(2)));
typedef float f32x2s __attribute__((ext_vector_type(2)));
__device__ __forceinline__ float bflo(unsigned w) { return __uint_as_float(w << 16); }
__device__ __forceinline__ float bfhi(unsigned w) { return __uint_as_float(w & 0xffff0000u); }
__device__ __forceinline__ unsigned pk4_fp8(float a, float b, float c, float d) {
    a = fminf(fmaxf(a, -448.f), 448.f); b = fminf(fmaxf(b, -448.f), 448.f); c = fminf(fmaxf(c, -448.f), 448.f); d = fminf(fmaxf(d, -448.f), 448.f);
    int w = __builtin_amdgcn_cvt_pk_fp8_f32(a, b, 0, false);
    w = __builtin_amdgcn_cvt_pk_fp8_f32(c, d, w, true);
    return (unsigned)w;
}

constexpr int CI_IN = 16 * 208, CI_KV = 16 * 32, CI_BR = 8 * 32, CI_O = 16 * 32, CI_SMALL = CI_IN + CI_KV + 3 * CI_BR + CI_O, CI_D = NE * 16 * 32, CI_GU = NE * 16 * 64, CI_ALL = CI_SMALL + CI_D + CI_GU;
__host__ __device__ __forceinline__ bool proj_tile_f8(int pn) { return pn >= 14; }
struct ConvItem { const float* W; bf16* WT; int N, K, k0, n0, dst, f8; };
__device__ __forceinline__ ConvItem conv_decode(Frame& F, int it) {
    ConvItem d; int r = it;
    if (r < CI_IN) { const int kb = r / 208, nb = r % 208, pn = nb >> 3; d.f8 = proj_tile_f8(pn) ? 1 : 0; d.W = in_ptr(I_WIN); d.WT = d.f8 ? (bf16*)WSP(unsigned char, WS_WIN8) : WSP(bf16, WS_WIN); d.N = INW; d.K = 1024; d.k0 = 64 * kb; d.n0 = 32 * nb; d.dst = 32 * nb; return d; } r -= CI_IN;
    if (r < CI_KV) { const int kb = r / 32, nb = r % 32; d.W = in_ptr(I_WKV); d.WT = WSP(bf16, WS_WKV); d.N = 1024; d.K = 1024; d.k0 = 64 * kb; d.n0 = 32 * nb; d.dst = 32 * nb; d.f8 = 0; return d; } r -= CI_KV;
    if (r < 3 * CI_BR) { const int br = r / CI_BR, rr = r % CI_BR, kb = rr / 32, nb = rr % 32; d.W = in_ptr(I_WBRSB + br); d.WT = WSP(bf16, WS_WBR) + (size_t)br * 1024 * 512; d.N = 1024; d.K = 512; d.k0 = 64 * kb; d.n0 = 32 * nb; d.dst = 32 * nb; d.f8 = 0; return d; } r -= 3 * CI_BR;
    if (r < CI_O) { const int kb = r / 32, nb = r % 32; d.W = in_ptr(I_WO); d.WT = WSP(bf16, WS_WO); d.N = 1024; d.K = 1024; d.k0 = 64 * kb; d.n0 = 32 * nb; d.dst = 32 * nb; d.f8 = 0; return d; } r -= CI_O;
    if (r < CI_D) { const int e = r / 512, rr = r % 512, kb = rr / 32, nb = rr % 32; d.W = in_ptr(I_WD) + (size_t)e * 1024 * 1024; d.WT = WSP(bf16, WS_WD); d.N = 1024; d.K = 1024; d.k0 = 64 * kb; d.n0 = 32 * nb; d.dst = e * 1024 + 32 * nb; d.f8 = 1; return d; } r -= CI_D;
    { const int e = r / 1024, rr = r % 1024, kb = rr / 64, nb = rr % 64, n0 = 32 * nb, f0 = n0 & 1023;
      d.W = in_ptr(I_WGU) + (size_t)e * 1024 * 2048; d.WT = WSP(bf16, WS_WGU); d.N = 2048; d.K = 1024; d.k0 = 64 * kb; d.n0 = n0;
      d.dst = e * 2048 + (f0 >> 7) * 256 + (n0 >= 1024 ? 128 : 0) + (f0 & 127); d.f8 = 1; return d; }
}
__device__ __forceinline__ void conv_load(const ConvItem& d, f32x4 (&r)[8], int lane) {
    const GAS f32x4* p = (const GAS f32x4*)((const GAS float*)d.W + (size_t)(d.k0 + 8 * (lane >> 3)) * d.N + d.n0 + 4 * (lane & 7));
    const size_t rstep = (size_t)(d.N >> 2);
#pragma unroll
    for (int i = 0; i < 8; ++i) r[i] = p[i * rstep];
}
__device__ __forceinline__ void conv_finish(const ConvItem& d, const f32x4 (&r)[8], LAS float* scr, int lane) {
    const size_t o0 = (size_t)(d.dst + 4 * (lane & 7)) * d.K + d.k0 + 8 * (lane >> 3);
    if (d.f8) {
        GAS unsigned char* o = (GAS unsigned char*)d.WT + o0;
#pragma unroll
        for (int j = 0; j < 4; ++j) { u32x2s w; w.x = pk4_fp8(r[0][j], r[1][j], r[2][j], r[3][j]); w.y = pk4_fp8(r[4][j], r[5][j], r[6][j], r[7][j]); *(GAS u32x2s*)(o + (size_t)j * d.K) = w; }
    } else {
        GAS bf16* o = (GAS bf16*)d.WT + o0;
#pragma unroll
        for (int j = 0; j < 4; ++j) { v4u w; w.x = pk2(r[0][j], r[1][j]); w.y = pk2(r[2][j], r[3][j]); w.z = pk2(r[4][j], r[5][j]); w.w = pk2(r[6][j], r[7][j]); *(GAS v4u*)(o + (size_t)j * d.K) = w; }
    }
}
constexpr int CONV_DEPTH = 6;
constexpr int G_PROJ = 192;
constexpr int CI_D_P0 = 26 * 512;
__device__ __forceinline__ void conv_items(Frame& F, int first, int last, int gw, int ngw, LAS float* scr) {
    if (first + gw >= last) return;
    const int n = (last - first - gw + ngw - 1) / ngw, base = first + gw;
    f32x4 r[CONV_DEPTH][8];
#pragma unroll
    for (int q = 0; q < CONV_DEPTH; ++q) { const int j = q < n ? q : n - 1; const ConvItem d = conv_decode(F, base + j * ngw); conv_load(d, r[q], F.lane); }
    int j0 = 0;
#pragma unroll 1
    for (; j0 + CONV_DEPTH < n; j0 += CONV_DEPTH) {
#pragma unroll
        for (int q = 0; q < CONV_DEPTH; ++q) {
            { const ConvItem d = conv_decode(F, base + (j0 + q) * ngw); conv_finish(d, r[q], scr, F.lane); }
            { const int jn = j0 + q + CONV_DEPTH, j = jn < n ? jn : n - 1; const ConvItem d = conv_decode(F, base + j * ngw); conv_load(d, r[q], F.lane); }
        }
    }
#pragma unroll
    for (int q = 0; q < CONV_DEPTH; ++q) { const int jq = j0 + q, j = jq < n ? jq : n - 1; const ConvItem d = conv_decode(F, base + j * ngw); conv_finish(d, r[q], scr, F.lane); }
}
__device__ __forceinline__ void rms_rows(Frame& F, int gw, int NGW) {
    const int lane = F.lane;
    const float *px = in_ptr(I_X), *pmixg = in_ptr(I_MIXG), *pmem = in_ptr(I_MEM), *pmemg = in_ptr(I_MEMG);
    int m = gw; if (m >= T + MROWS) return;
    f32x4 v[4];
    { const GAS f32x4* xr = (const GAS f32x4*)(m < T ? px + (size_t)m * D : pmem + (size_t)(m - T) * D) + lane;
#pragma unroll
      for (int j = 0; j < 4; ++j) v[j] = xr[64 * j]; }
#pragma unroll 1
    for (;;) {
        const int mn = m + NGW; const bool has = mn < T + MROWS;
        f32x4 vn[4];
        if (has) { const GAS f32x4* xr = (const GAS f32x4*)(mn < T ? px + (size_t)mn * D : pmem + (size_t)(mn - T) * D) + lane;
#pragma unroll
            for (int j = 0; j < 4; ++j) vn[j] = xr[64 * j]; }
        const GAS f32x4* gr = (const GAS f32x4*)(m < T ? pmixg : pmemg) + lane;
        float s = 0.f;
#pragma unroll
        for (int j = 0; j < 4; ++j) s += (v[j].x * v[j].x + v[j].y * v[j].y) + (v[j].z * v[j].z + v[j].w * v[j].w);
        const float r = 1.f / sqrtf(wave_sum(s) * (1.f / 1024.f) + RMS_EPS);
        bf16* orow = m < T ? WSP(bf16, WS_XN) + (size_t)m * D : WSP(bf16, WS_MEMN) + (size_t)(m - T) * D;
        GAS unsigned long long* o8 = (GAS unsigned long long*)orow + lane;
#pragma unroll
        for (int j = 0; j < 4; ++j) { const f32x4 gg = gr[64 * j]; v[j].x *= r * gg.x; v[j].y *= r * gg.y; v[j].z *= r * gg.z; v[j].w *= r * gg.w;
            o8[64 * j] = (unsigned long long)pk2(v[j].x, v[j].y) | ((unsigned long long)pk2(v[j].z, v[j].w) << 32); }
        if (m < T) { GAS unsigned* o4 = (GAS unsigned*)(WSP(unsigned char, WS_XN8) + (size_t)m * D) + lane;
#pragma unroll
            for (int j = 0; j < 4; ++j) o4[64 * j] = pk4_fp8(v[j].x, v[j].y, v[j].z, v[j].w); }
        if (!has) break;
        m = mn;
#pragma unroll
        for (int j = 0; j < 4; ++j) v[j] = vn[j];
    }
}
__device__ __forceinline__ void p0_prologue(Frame& F, int nconv) {
    LAS float* scr = (LAS float*)(F.lds + RING_OFF + F.wave * 16384);
    const int gw = F.vcu * NWAVES + F.wave, NGW = F.G * NWAVES;
    rms_rows(F, gw, NGW);
    conv_items(F, 0, nconv, gw, NGW, scr);
}

typedef float f32x16 __attribute__((ext_vector_type(16)));
__device__ __forceinline__ float swap_max(float v) { auto rr = __builtin_amdgcn_permlane32_swap(__float_as_uint(v), __float_as_uint(v), false, false); return fmaxf(__uint_as_float(rr[0]), __uint_as_float(rr[1])); }
__device__ __forceinline__ float swap_sum(float v) { auto rr = __builtin_amdgcn_permlane32_swap(__float_as_uint(v), __float_as_uint(v), false, false); return __uint_as_float(rr[0]) + __uint_as_float(rr[1]); }
__device__ __forceinline__ float swap_other(float v) { auto rr = __builtin_amdgcn_permlane32_swap(__float_as_uint(v), __float_as_uint(v), false, false); const float a = __uint_as_float(rr[0]), b = __uint_as_float(rr[1]); return (a + b) - v; }
template <int NS> __device__ __forceinline__ void norm_frags(const v4u (&raw)[NS], bf16x8 (&out)[NS], const float* g, int hi, float inv_n, float post) {
    float ss = 0.f;
#pragma unroll
    for (int s = 0; s < NS; ++s) { const v4u c = raw[s]; const float x0 = bflo(c.x), x1 = bfhi(c.x), x2 = bflo(c.y), x3 = bfhi(c.y), x4 = bflo(c.z), x5 = bfhi(c.z), x6 = bflo(c.w), x7 = bfhi(c.w);
        ss += (x0 * x0 + x1 * x1) + (x2 * x2 + x3 * x3) + (x4 * x4 + x5 * x5) + (x6 * x6 + x7 * x7); }
    ss = swap_sum(ss);
    const float r = post * __builtin_amdgcn_rsqf(ss * inv_n + RMS_EPS);
#pragma unroll
    for (int s = 0; s < NS; ++s) { const v4u c = raw[s]; const f32x4 g0 = *(const GAS f32x4*)(g + 16 * s + 8 * hi), g1 = *(const GAS f32x4*)(g + 16 * s + 8 * hi + 4);
        u32x4s w; w.x = pg8::cvt_pk_bf16(bflo(c.x) * r * g0.x, bfhi(c.x) * r * g0.y); w.y = pg8::cvt_pk_bf16(bflo(c.y) * r * g0.z, bfhi(c.y) * r * g0.w);
        w.z = pg8::cvt_pk_bf16(bflo(c.z) * r * g1.x, bfhi(c.z) * r * g1.y); w.w = pg8::cvt_pk_bf16(bflo(c.w) * r * g1.z, bfhi(c.w) * r * g1.w); out[s] = __builtin_bit_cast(bf16x8, w); }
}
constexpr float SB_EXIT_LOG2 = -32.0f;
constexpr int SB_VROW = 72;
__device__ __forceinline__ void sb_tile(Frame& F, int bh, int qt, bf16* OSB, const float* qg, const float* kg) {
    const int lane = F.lane, r32 = lane & 31, hi = lane >> 5, b = bh >> 3, h = bh & 7;
    LAS unsigned char* vt = F.lds + RING_OFF + F.wave * 16384;
    const bf16* base = WSP(bf16, WS_PROJ) + (size_t)(b * SEQ) * INW + h * 64;
    const int t = qt * 32 + r32;
    bf16x8 qf[4];
    { v4u raw[4]; const bf16* qp = base + (size_t)t * INW + C_Q + 8 * hi;
#pragma unroll
      for (int s = 0; s < 4; ++s) raw[s] = *(const GAS v4u*)(qp + 16 * s);
      norm_frags<4>(raw, qf, qg, hi, 1.f / 64.f, 0.125f * 1.4426950408889634f); }
    f32x16 O[2];
#pragma unroll
    for (int d = 0; d < 2; ++d) O[d] = (f32x16){0.f, 0.f, 0.f, 0.f, 0.f, 0.f, 0.f, 0.f, 0.f, 0.f, 0.f, 0.f, 0.f, 0.f, 0.f, 0.f};
    float carry = 0.f;
    v4u kraw[4], vraw[4], knx[4], vnx[4];
    { const bf16* krow = base + (size_t)(qt * 32 + r32) * INW;
#pragma unroll
      for (int s = 0; s < 4; ++s) { kraw[s] = *(const GAS v4u*)(krow + C_K + 16 * s + 8 * hi); vraw[s] = *(const GAS v4u*)(krow + C_V + 32 * hi + 8 * s); } }
#pragma unroll 1
    for (int kt = qt; kt >= 0; --kt) {
        { const bf16* krow = base + (size_t)((kt > 0 ? kt - 1 : 0) * 32 + r32) * INW;
#pragma unroll
          for (int s = 0; s < 4; ++s) { knx[s] = *(const GAS v4u*)(krow + C_K + 16 * s + 8 * hi); vnx[s] = *(const GAS v4u*)(krow + C_V + 32 * hi + 8 * s); } }
        bf16x8 kf[4];
        norm_frags<4>(kraw, kf, kg, hi, 1.f / 64.f, 1.f);
#pragma unroll
        for (int s = 0; s < 4; ++s) { LAS unsigned short* p = (LAS unsigned short*)(vt + (32 * hi + 8 * s) * SB_VROW + r32 * 2); const v4u v = vraw[s];
            p[0 * (SB_VROW / 2)] = (unsigned short)v.x; p[1 * (SB_VROW / 2)] = (unsigned short)(v.x >> 16); p[2 * (SB_VROW / 2)] = (unsigned short)v.y; p[3 * (SB_VROW / 2)] = (unsigned short)(v.y >> 16);
            p[4 * (SB_VROW / 2)] = (unsigned short)v.z; p[5 * (SB_VROW / 2)] = (unsigned short)(v.z >> 16); p[6 * (SB_VROW / 2)] = (unsigned short)v.w; p[7 * (SB_VROW / 2)] = (unsigned short)(v.w >> 16); }
        f32x16 S = {0.f, 0.f, 0.f, 0.f, 0.f, 0.f, 0.f, 0.f, 0.f, 0.f, 0.f, 0.f, 0.f, 0.f, 0.f, 0.f};
#pragma unroll
        for (int s = 0; s < 4; ++s) S = __builtin_amdgcn_mfma_f32_32x32x16_bf16(kf[s], qf[s], S, 0, 0, 0);
        const bool diag = (kt == qt);
        float ls[16], la[16];
#pragma unroll
        for (int r = 0; r < 16; ++r) {
            const int kr = (r & 3) + 8 * (r >> 2) + 4 * hi;
            const bool valid = !diag || kr < r32;
            const float z = S[r], e = __builtin_amdgcn_exp2f(-fabsf(z)), L = __builtin_amdgcn_logf(1.f + e);
            ls[r] = valid ? -(fmaxf(z, 0.f) + L) : 0.f;
            la[r] = valid ? fminf(z, 0.f) - L : -INFINITY;
        }
        float go[4], gp[4];
#pragma unroll
        for (int g = 0; g < 4; ++g) { go[g] = (ls[4 * g] + ls[4 * g + 1]) + (ls[4 * g + 2] + ls[4 * g + 3]); gp[g] = swap_other(go[g]); }
        float after[4];
        after[3] = (hi == 0) ? gp[3] : 0.f;
#pragma unroll
        for (int g = 2; g >= 0; --g) after[g] = after[g + 1] + go[g + 1] + ((hi == 0) ? gp[g] : gp[g + 1]);
        float w[16];
#pragma unroll
        for (int g = 0; g < 4; ++g) {
            const float b3 = carry + after[g], b2 = b3 + ls[4 * g + 3], b1 = b2 + ls[4 * g + 2], b0 = b1 + ls[4 * g + 1];
            w[4 * g + 3] = __builtin_amdgcn_exp2f(la[4 * g + 3] + b3); w[4 * g + 2] = __builtin_amdgcn_exp2f(la[4 * g + 2] + b2);
            w[4 * g + 1] = __builtin_amdgcn_exp2f(la[4 * g + 1] + b1); w[4 * g] = __builtin_amdgcn_exp2f(la[4 * g] + b0);
        }
        carry += ((go[0] + go[1]) + (go[2] + go[3])) + ((gp[0] + gp[1]) + (gp[2] + gp[3]));
        bf16x8 pb[2];
#pragma unroll
        for (int s2 = 0; s2 < 2; ++s2) { u32x4s u; u.x = pg8::cvt_pk_bf16(w[8 * s2], w[8 * s2 + 1]); u.y = pg8::cvt_pk_bf16(w[8 * s2 + 2], w[8 * s2 + 3]); u.z = pg8::cvt_pk_bf16(w[8 * s2 + 4], w[8 * s2 + 5]); u.w = pg8::cvt_pk_bf16(w[8 * s2 + 6], w[8 * s2 + 7]); pb[s2] = __builtin_bit_cast(bf16x8, u); }
        LDS_WAIT(); asm volatile("" ::: "memory");
#pragma unroll
        for (int d = 0; d < 2; ++d)
#pragma unroll
            for (int s2 = 0; s2 < 2; ++s2) {
                const LAS unsigned char* vp = vt + (32 * d + r32) * SB_VROW + (16 * s2 + 4 * hi) * 2;
                const u32x2s lo = *(const LAS u32x2s*)vp, hh = *(const LAS u32x2s*)(vp + 16);
                u32x4s a; a.x = lo.x; a.y = lo.y; a.z = hh.x; a.w = hh.y;
                O[d] = __builtin_amdgcn_mfma_f32_32x32x16_bf16(__builtin_bit_cast(bf16x8, a), pb[s2], O[d], 0, 0, 0);
            }
        LDS_WAIT(); asm volatile("" ::: "memory");
        if (__all(carry < SB_EXIT_LOG2)) break;
#pragma unroll
        for (int s = 0; s < 4; ++s) { kraw[s] = knx[s]; vraw[s] = vnx[s]; }
    }
    bf16* op = OSB + (size_t)(b * SEQ + t) * 512 + h * 64 + 4 * hi;
#pragma unroll
    for (int d = 0; d < 2; ++d)
#pragma unroll
        for (int g = 0; g < 4; ++g) { u32x2s u; u.x = pk2(O[d][4 * g], O[d][4 * g + 1]); u.y = pk2(O[d][4 * g + 2], O[d][4 * g + 3]); *(GAS u32x2s*)(op + 32 * d + 8 * g) = u; }
}
constexpr int MA_KROW = 272, MA_VROW = 520, MA_VOFF = 256 * MA_KROW;
__device__ __forceinline__ void mem_attn_item(Frame& F, int item, bf16* OMEM, const float* mqg, const float* mkg) {
    const int b = item >> 6, h = (item >> 4) & 3, qblk = item & 15, tid = F.tid, lane = F.lane, r32 = lane & 31, hi = lane >> 5;
    LAS unsigned char* kl = F.lds + RING_OFF; LAS unsigned char* vl = kl + MA_VOFF;
    const bf16* kvb = WSP(bf16, WS_KV) + (size_t)(b * MEMT) * 1024 + h * 128;
    __syncthreads();
#pragma unroll
    for (int i = 0; i < 8; ++i) { const int id = tid + 512 * i, row = id >> 4, c = id & 15;
        const v4u cr = *(const GAS v4u*)(kvb + (size_t)row * 1024 + c * 8);
        const float x0 = bflo(cr.x), x1 = bfhi(cr.x), x2 = bflo(cr.y), x3 = bfhi(cr.y), x4 = bflo(cr.z), x5 = bfhi(cr.z), x6 = bflo(cr.w), x7 = bfhi(cr.w);
        float ss = (x0 * x0 + x1 * x1) + (x2 * x2 + x3 * x3) + (x4 * x4 + x5 * x5) + (x6 * x6 + x7 * x7);
        ss += __shfl_xor(ss, 1); ss += __shfl_xor(ss, 2); ss += __shfl_xor(ss, 4); ss += __shfl_xor(ss, 8);
        const float r = __builtin_amdgcn_rsqf(ss * (1.f / 128.f) + RMS_EPS); const f32x4 g0 = *(const GAS f32x4*)(mkg + 8 * c), g1 = *(const GAS f32x4*)(mkg + 8 * c + 4);
        v4u o; o.x = pk2(x0 * r * g0.x, x1 * r * g0.y); o.y = pk2(x2 * r * g0.z, x3 * r * g0.w); o.z = pk2(x4 * r * g1.x, x5 * r * g1.y); o.w = pk2(x6 * r * g1.z, x7 * r * g1.w);
        *(LAS v4u*)(kl + row * MA_KROW + c * 16) = o; }
#pragma unroll
    for (int i = 0; i < 8; ++i) { const int id = tid + 512 * i, key = id & 255, c = id >> 8;
        const v4u v = *(const GAS v4u*)(kvb + (size_t)key * 1024 + 512 + c * 8); LAS unsigned short* vt = (LAS unsigned short*)(vl + (8 * c) * MA_VROW + key * 2);
        vt[0 * (MA_VROW / 2)] = (unsigned short)v.x; vt[1 * (MA_VROW / 2)] = (unsigned short)(v.x >> 16); vt[2 * (MA_VROW / 2)] = (unsigned short)v.y; vt[3 * (MA_VROW / 2)] = (unsigned short)(v.y >> 16);
        vt[4 * (MA_VROW / 2)] = (unsigned short)v.z; vt[5 * (MA_VROW / 2)] = (unsigned short)(v.z >> 16); vt[6 * (MA_VROW / 2)] = (unsigned short)v.w; vt[7 * (MA_VROW / 2)] = (unsigned short)(v.w >> 16); }
    __syncthreads();
    const int t = b * SEQ + qblk * 256 + F.wave * 32 + r32;
    bf16x8 qf[8];
    { v4u raw[8]; const bf16* qp = WSP(bf16, WS_PROJ) + (size_t)t * INW + C_QM + h * 128 + 8 * hi;
#pragma unroll
      for (int s = 0; s < 8; ++s) raw[s] = *(const GAS v4u*)(qp + 16 * s);
      norm_frags<8>(raw, qf, mqg, hi, 1.f / 128.f, 1.f); }
    const LAS unsigned char* kbase = kl + r32 * MA_KROW + hi * 16;
    float m = -INFINITY;
#pragma unroll 1
    for (int kt = 0; kt < 8; ++kt) {
        f32x16 S = {0.f, 0.f, 0.f, 0.f, 0.f, 0.f, 0.f, 0.f, 0.f, 0.f, 0.f, 0.f, 0.f, 0.f, 0.f, 0.f};
#pragma unroll
        for (int s = 0; s < 8; ++s) S = __builtin_amdgcn_mfma_f32_32x32x16_bf16(*(const LAS bf16x8*)(kbase + kt * 32 * MA_KROW + s * 32), qf[s], S, 0, 0, 0);
#pragma unroll
        for (int r = 0; r < 16; ++r) m = fmaxf(m, S[r]);
    }
    m = swap_max(m);
    const float sc2 = 0.08838834764831845f * 1.4426950408889634f;
    const float msc = m * sc2;
    float l = 0.f; f32x16 O[4];
#pragma unroll
    for (int d = 0; d < 4; ++d) O[d] = (f32x16){0.f, 0.f, 0.f, 0.f, 0.f, 0.f, 0.f, 0.f, 0.f, 0.f, 0.f, 0.f, 0.f, 0.f, 0.f, 0.f};
    const LAS unsigned char* vbase = vl + r32 * MA_VROW + hi * 8;
#pragma unroll 1
    for (int kt = 0; kt < 8; ++kt) {
        f32x16 S = {0.f, 0.f, 0.f, 0.f, 0.f, 0.f, 0.f, 0.f, 0.f, 0.f, 0.f, 0.f, 0.f, 0.f, 0.f, 0.f};
#pragma unroll
        for (int s = 0; s < 8; ++s) S = __builtin_amdgcn_mfma_f32_32x32x16_bf16(*(const LAS bf16x8*)(kbase + kt * 32 * MA_KROW + s * 32), qf[s], S, 0, 0, 0);
        float p[16];
#pragma unroll
        for (int r = 0; r < 16; ++r) { p[r] = __builtin_amdgcn_exp2f(S[r] * sc2 - msc); l += p[r]; }
        bf16x8 pb[2];
#pragma unroll
        for (int s2 = 0; s2 < 2; ++s2) { u32x4s w; w.x = pg8::cvt_pk_bf16(p[8 * s2], p[8 * s2 + 1]); w.y = pg8::cvt_pk_bf16(p[8 * s2 + 2], p[8 * s2 + 3]); w.z = pg8::cvt_pk_bf16(p[8 * s2 + 4], p[8 * s2 + 5]); w.w = pg8::cvt_pk_bf16(p[8 * s2 + 6], p[8 * s2 + 7]); pb[s2] = __builtin_bit_cast(bf16x8, w); }
#pragma unroll
        for (int d = 0; d < 4; ++d)
#pragma unroll
            for (int s2 = 0; s2 < 2; ++s2) {
                const LAS unsigned char* vp = vbase + d * 32 * MA_VROW + (kt * 32 + s2 * 16) * 2;
                const u32x2s lo = *(const LAS u32x2s*)vp, hh = *(const LAS u32x2s*)(vp + 16);
                u32x4s a; a.x = lo.x; a.y = lo.y; a.z = hh.x; a.w = hh.y;
                O[d] = __builtin_amdgcn_mfma_f32_32x32x16_bf16(__builtin_bit_cast(bf16x8, a), pb[s2], O[d], 0, 0, 0);
            }
    }
    l = swap_sum(l); const float inv = 1.f / l;
    bf16* op = OMEM + (size_t)t * 512 + h * 128 + 4 * hi;
#pragma unroll
    for (int d = 0; d < 4; ++d)
#pragma unroll
        for (int g = 0; g < 4; ++g) { u32x2s w; w.x = pk2(O[d][4 * g] * inv, O[d][4 * g + 1] * inv); w.y = pk2(O[d][4 * g + 2] * inv, O[d][4 * g + 3] * inv);
            *(GAS u32x2s*)(op + 32 * d + 8 * g) = w; }
    __syncthreads();
}
__device__ __forceinline__ void conv_item4(Frame& F, int t0, bf16* OCONV, const float* cw) {
    const int lane = F.lane, pos0 = t0 & (SEQ - 1), c0 = lane * 8;
    const bf16* pr = WSP(bf16, WS_PROJ) + (size_t)t0 * INW + c0;
    v4u a[6], x[6], bq[4];
#pragma unroll
    for (int j = 0; j < 6; ++j) { const int d = j - 2;
        if (pos0 + d >= 0) { a[j] = *(const GAS v4u*)(pr + (long)d * INW + C_CC); x[j] = *(const GAS v4u*)(pr + (long)d * INW + C_CX); }
        else { a[j] = (v4u){0u, 0u, 0u, 0u}; x[j] = (v4u){0u, 0u, 0u, 0u}; } }
#pragma unroll
    for (int j = 0; j < 4; ++j) bq[j] = *(const GAS v4u*)(pr + (long)j * INW + C_CB);
    float w0[8], w1[8], w2[8];
#pragma unroll
    for (int i = 0; i < 8; ++i) { w0[i] = cw[c0 + i]; w1[i] = cw[512 + c0 + i]; w2[i] = cw[1024 + c0 + i]; }
    float u[6][8];
#pragma unroll
    for (int j = 0; j < 6; ++j) { u[j][0] = bflo(a[j].x) * bflo(x[j].x); u[j][1] = bfhi(a[j].x) * bfhi(x[j].x); u[j][2] = bflo(a[j].y) * bflo(x[j].y); u[j][3] = bfhi(a[j].y) * bfhi(x[j].y);
        u[j][4] = bflo(a[j].z) * bflo(x[j].z); u[j][5] = bfhi(a[j].z) * bfhi(x[j].z); u[j][6] = bflo(a[j].w) * bflo(x[j].w); u[j][7] = bfhi(a[j].w) * bfhi(x[j].w); }
#pragma unroll
    for (int j = 0; j < 4; ++j) {
        const float cb[8] = {bflo(bq[j].x), bfhi(bq[j].x), bflo(bq[j].y), bfhi(bq[j].y), bflo(bq[j].z), bfhi(bq[j].z), bflo(bq[j].w), bfhi(bq[j].w)};
        float r[8];
#pragma unroll
        for (int i = 0; i < 8; ++i) r[i] = cb[i] * (w0[i] * u[j][i] + w1[i] * u[j + 1][i] + w2[i] * u[j + 2][i]);
        v4u o; o.x = pk2(r[0], r[1]); o.y = pk2(r[2], r[3]); o.z = pk2(r[4], r[5]); o.w = pk2(r[6], r[7]);
        *(GAS v4u*)(OCONV + (size_t)(t0 + j) * 512 + c0) = o;
    }
}
#ifndef MIXREP
#define MIXREP 0
#endif
__device__ __forceinline__ void p2_mixers(Frame& F) {
    bf16* OSB = WSP(bf16, WS_OBR); bf16* OCONV = WSP(bf16, WS_OBR) + (size_t)T * 512; bf16* OMEM = WSP(bf16, WS_OBR) + (size_t)2 * T * 512;
    const int gw = F.vcu * NWAVES + F.wave, NGW = F.G * NWAVES;
    { const float* mqg = in_ptr(I_MEMQG); const float* mkg = in_ptr(I_MEMKG);
      for (int item = F.vcu; item < 256; item += F.G) mem_attn_item(F, item, OMEM, mqg, mkg); }
    { const float* qg = in_ptr(I_SBQG); const float* kg = in_ptr(I_SBKG);
      for (int it = F.vcu; it < BATCH * 128; it += F.G) sb_tile(F, (it >> 7) * 8 + F.wave, it & 127, OSB, qg, kg); }
    { const float* cw = in_ptr(I_CONVW);
      for (int t4 = gw; t4 < T / 4; t4 += NGW) conv_item4(F, t4 * 4, OCONV, cw); }
}

__device__ __forceinline__ void p5_route(Frame& F) {
    const int lane = F.lane, w = F.wave, r32 = lane & 31, hi = lane >> 5, tid = F.tid;
    constexpr int TROW = 516;
    LAS float* tile = (LAS float*)(F.lds + RING_OFF);
    LAS float* part = tile + 32 * TROW;
    LAS int* lcnt = (LAS int*)(part + 8 * 32 * 33);
    LAS int* lbase = lcnt + 32;
    LAS float* r2s = (LAS float*)(lbase + 32);
    const float* wrt = in_ptr(I_WROUTER); const float* fg = in_ptr(I_FFNG); const float be = in_ptr(I_BROUTER)[r32];
    const float* ssqp = WSP(float, WS_SSQ);
    f32x4 gq[4];
#pragma unroll
    for (int j = 0; j < 4; ++j) gq[j] = ((const GAS f32x4*)fg)[lane + 64 * j];
    for (int task = F.vcu; task < T / 32; task += F.G) {
        const int tb = task * 32;
        f32x4 xs[4][4]; float rinv4[4];
#pragma unroll
        for (int rr = 0; rr < 4; ++rr) { const int row = tb + 4 * w + rr; const GAS f32x4* xr = (const GAS f32x4*)(F.out + (size_t)row * D) + lane;
#pragma unroll
            for (int j = 0; j < 4; ++j) xs[rr][j] = xr[64 * j];
            const GAS f32x4* sp = (const GAS f32x4*)(ssqp + (size_t)row * 16); const f32x4 s0 = sp[0], s1 = sp[1], s2 = sp[2], s3 = sp[3];
            const float ss = ((s0.x + s0.y) + (s0.z + s0.w)) + ((s1.x + s1.y) + (s1.z + s1.w)) + ((s2.x + s2.y) + (s2.z + s2.w)) + ((s3.x + s3.y) + (s3.z + s3.w));
            rinv4[rr] = 1.f / sqrtf(ss * (1.f / 1024.f) + RMS_EPS); }
#pragma unroll
        for (int rr = 0; rr < 4; ++rr) { const int row = tb + 4 * w + rr; GAS unsigned* o4 = (GAS unsigned*)(WSP(unsigned char, WS_HF8) + (size_t)row * 1024) + lane; const float ri = rinv4[rr];
#pragma unroll
            for (int j = 0; j < 4; ++j) { xs[rr][j] = xs[rr][j] * gq[j]; o4[64 * j] = pk4_fp8(xs[rr][j].x * ri, xs[rr][j].y * ri, xs[rr][j].z * ri, xs[rr][j].w * ri); }
            if (lane == 0) r2s[4 * w + rr] = ri; }
        f32x16 C = {0.f, 0.f, 0.f, 0.f, 0.f, 0.f, 0.f, 0.f, 0.f, 0.f, 0.f, 0.f, 0.f, 0.f, 0.f, 0.f};
#pragma unroll
        for (int hk = 0; hk < 2; ++hk) {
            if (hk) __syncthreads();
#pragma unroll
            for (int rr = 0; rr < 4; ++rr)
#pragma unroll
                for (int jj = 0; jj < 2; ++jj) *(LAS f32x4*)(tile + (4 * w + rr) * TROW + 4 * (lane + 64 * jj)) = xs[rr][2 * hk + jj];
            __syncthreads();
            const int lc = w * 64 + 32 * hi;
            f32x4 xv[8];
#pragma unroll
            for (int i = 0; i < 8; ++i) xv[i] = *(const LAS f32x4*)(tile + r32 * TROW + lc + 4 * i);
            const GAS float* wp = (const GAS float*)wrt + (size_t)(hk * 512 + lc) * 32 + r32;
#pragma unroll
            for (int st = 0; st < 32; ++st) C = __builtin_amdgcn_mfma_f32_32x32x2f32(wp[st * 32], xv[st >> 2][st & 3], C, 0, 0, 0);
        }
#pragma unroll
        for (int r = 0; r < 16; ++r) part[(w * 32 + (r & 3) + 8 * (r >> 2) + 4 * hi) * 33 + r32] = C[r];
        if (tid < 32) lcnt[tid] = 0;
        __syncthreads();
        int my_e[2], loc[2]; float my_g[2];
#pragma unroll
        for (int u = 0; u < 2; ++u) {
            const int j = 4 * w + 2 * hi + u;
            float lg = 0.f;
#pragma unroll
            for (int ww = 0; ww < 8; ++ww) lg += part[(ww * 32 + r32) * 33 + j];
            float val = lg * r2s[j] + be;
            float tv[4]; int ti[4];
#pragma unroll
            for (int rr = 0; rr < 4; ++rr) {
                float bv = val; int bi = r32;
#define TOPK_DPP(ctrl) do { const float ov = __builtin_bit_cast(float, __builtin_amdgcn_update_dpp(0, __builtin_bit_cast(int, bv), ctrl, 0xf, 0xf, false)); const int oi = __builtin_amdgcn_update_dpp(0, bi, ctrl, 0xf, 0xf, false); \
                    if (ov > bv || (ov == bv && oi < bi)) { bv = ov; bi = oi; } } while (0)
                TOPK_DPP(0xB1); TOPK_DPP(0x4E); TOPK_DPP(0x141); TOPK_DPP(0x140);
#undef TOPK_DPP
                { const float ov = __shfl_xor(bv, 16); const int oi = __shfl_xor(bi, 16); if (ov > bv || (ov == bv && oi < bi)) { bv = ov; bi = oi; } }
                tv[rr] = bv; ti[rr] = bi; if (r32 == bi) val = -INFINITY;
            }
            const float e1 = __expf(tv[1] - tv[0]), e2 = __expf(tv[2] - tv[0]), e3 = __expf(tv[3] - tv[0]); const float inv = 1.f / (1.f + e1 + e2 + e3);
            my_e[u] = r32 == 0 ? ti[0] : (r32 == 1 ? ti[1] : (r32 == 2 ? ti[2] : ti[3]));
            my_g[u] = (r32 == 0 ? 1.f : (r32 == 1 ? e1 : (r32 == 2 ? e2 : e3))) * inv;
            loc[u] = 0;
            if (r32 < 4) loc[u] = __hip_atomic_fetch_add((LAS int*)lcnt + my_e[u], 1, __ATOMIC_RELAXED, __HIP_MEMORY_SCOPE_WORKGROUP);
        }
        __syncthreads();
        if (tid < 32) { const int c = lcnt[tid]; int base = 0;
            if (c > 0) base = (int)__hip_atomic_fetch_add((unsigned*)(F.ctl + CW_CNT + 64 * tid), (unsigned)c, __ATOMIC_RELAXED, __HIP_MEMORY_SCOPE_AGENT);
            lbase[tid] = base; }
        __syncthreads();
        if (r32 < 4) {
#pragma unroll
            for (int u = 0; u < 2; ++u) { const int t = tb + 4 * w + 2 * hi + u; const int pos = lbase[my_e[u]] + loc[u];
                WSP(int, WS_ROUTE)[t * 4 + r32] = my_e[u]; WSP(float, WS_ROUTE + 256 * 1024)[t * 4 + r32] = my_g[u]; WSP(int, WS_ROUTE + 512 * 1024)[t * 4 + r32] = pos;
                WSP(int, WS_LIST)[my_e[u] * 16384 + pos] = t; }
        }
        __syncthreads();
    }
}
__device__ __forceinline__ void moe_table(Frame& F) {
    volatile LAS int* tab = (volatile LAS int*)(F.lds + TAB_OFF);
    if (F.tid < 64) {
        const int e = F.tid & 31;
        const unsigned c = __hip_atomic_load((unsigned*)(F.ctl + CW_CNT + 64 * e), __ATOMIC_RELAXED, __HIP_MEMORY_SCOPE_AGENT);
        const int tiles = (int)((c + 255u) >> 8); int inc = tiles;
#pragma unroll
        for (int o = 1; o < 32; o <<= 1) { const int up = __shfl_up(inc, o, 32); if (e >= o) inc += up; }
        if (F.tid < 32) { tab[e] = inc - tiles; tab[48 + e] = (int)c; if (e == 31) { tab[NE] = inc; tab[40] = inc; } }
    }
    __syncthreads();
}
__device__ __forceinline__ void p8_combine(Frame& F) {
    const int gw = F.vcu * NWAVES + F.wave, NGW = F.G * NWAVES, lane = F.lane;
    typedef int i32x4c __attribute__((ext_vector_type(4)));
    const GAS i32x4c* ridx = (const GAS i32x4c*)WSP(int, WS_ROUTE); const GAS i32x4c* rpos = (const GAS i32x4c*)WSP(int, WS_ROUTE + 512 * 1024); const GAS f32x4* rgate = (const GAS f32x4*)WSP(float, WS_ROUTE + 256 * 1024);
    const volatile LAS int* tab = (const volatile LAS int*)(F.lds + TAB_OFF);
    constexpr int TB = 4;
    for (int t0 = gw * TB; t0 < T; t0 += NGW * TB) {
        i32x4c sl[TB]; f32x4 gt[TB];
#pragma unroll
        for (int i = 0; i < TB; ++i) { const i32x4c e4 = ridx[t0 + i], p4 = rpos[t0 + i]; gt[i] = rgate[t0 + i];
#pragma unroll
            for (int k = 0; k < 4; ++k) sl[i][k] = tab[e4[k]] * 256 + p4[k]; }
        f32x4 v[TB][4]; unsigned y[TB][4][4];
#pragma unroll
        for (int i = 0; i < TB; ++i) { const GAS f32x4* xr = (const GAS f32x4*)(F.out + (size_t)(t0 + i) * D) + lane;
#pragma unroll
            for (int j = 0; j < 4; ++j) v[i][j] = xr[64 * j];
#pragma unroll
            for (int k = 0; k < 4; ++k) { const GAS unsigned* y4 = (const GAS unsigned*)(WSP(unsigned char, WS_Y) + (size_t)sl[i][k] * 1024) + lane;
#pragma unroll
                for (int j = 0; j < 4; ++j) y[i][k][j] = y4[64 * j]; } }
#pragma unroll
        for (int i = 0; i < TB; ++i) { GAS f32x4* xw = (GAS f32x4*)(F.out + (size_t)(t0 + i) * D) + lane;
#pragma unroll
            for (int k = 0; k < 4; ++k) { const float g = gt[i][k];
#pragma unroll
                for (int j = 0; j < 4; ++j) { const unsigned w = y[i][k][j]; const f32x2s lo = __builtin_amdgcn_cvt_pk_f32_fp8(w, false), hi = __builtin_amdgcn_cvt_pk_f32_fp8(w, true);
                    v[i][j].x += g * lo.x; v[i][j].y += g * lo.y; v[i][j].z += g * hi.x; v[i][j].w += g * hi.y; } }
#pragma unroll
            for (int j = 0; j < 4; ++j) xw[64 * j] = v[i][j]; }
    }
}

struct EpiGate {
    static constexpr bool PERM = true, AFTER_DRAIN = false; static constexpr int NST = 16;
    const pg8::bf16_t* gates; pg8::bf16_t* sum;
    __device__ __forceinline__ void operator()(const pg8::f32x4 (&acc)[2][2][4][2], const pg8::Unit& u, int wr, int wc, int fr, int fq) const {
        const int br = u.pn >> 2, col0 = (u.pn & 3) * pg8::BM + wc * 32 + 8 * fq, row0 = (u.pm & 63) * pg8::BM + wr * 64 + fr;
        const pg8::bf16_t* gp = gates + br * 1024;
#pragma unroll
        for (int ai = 0; ai < 2; ++ai)
#pragma unroll
            for (int m = 0; m < 4; ++m) { const size_t row = (size_t)(row0 + ai * pg8::HALF + m * 16);
#pragma unroll
                for (int bj = 0; bj < 2; ++bj) { const int col = col0 + bj * pg8::HALF;
                    const pg8::u32x4 g = *(const pg8::u32x4*)(gp + row * INW + col);
                    pg8::u32x4 p = {0u, 0u, 0u, 0u}; if (br != 0) p = *(const pg8::u32x4*)(sum + row * 1024 + col);
                    const pg8::f32x4 v0 = acc[ai][bj][m][0], v1 = acc[ai][bj][m][1];
                    const float gv[8] = {bflo(g.x), bfhi(g.x), bflo(g.y), bfhi(g.y), bflo(g.z), bfhi(g.z), bflo(g.w), bfhi(g.w)};
                    const float pv[8] = {bflo(p.x), bfhi(p.x), bflo(p.y), bfhi(p.y), bflo(p.z), bfhi(p.z), bflo(p.w), bfhi(p.w)};
                    const float av[8] = {v0[0], v0[1], v0[2], v0[3], v1[0], v1[1], v1[2], v1[3]};
                    float o[8];
#pragma unroll
                    for (int i = 0; i < 8; ++i) o[i] = pv[i] + av[i] * __builtin_amdgcn_rcpf(1.f + __builtin_amdgcn_exp2f(-1.4426950408889634f * gv[i]));
                    pg8::u32x4 w; w.x = pg8::cvt_pk_bf16(o[0], o[1]); w.y = pg8::cvt_pk_bf16(o[2], o[3]); w.z = pg8::cvt_pk_bf16(o[4], o[5]); w.w = pg8::cvt_pk_bf16(o[6], o[7]);
                    *(pg8::u32x4*)(sum + row * 1024 + col) = w; }
                if (m & 1) asm volatile("" ::: "memory"); }
    }
};
struct BranchOrder {
    pg8::StaticOrder so;
    __device__ __forceinline__ bool next(int i, pg8::Unit& u) const {
        pg8::Unit tu; const int tile = i / 3, br = i - 3 * tile; if (!so.next(tile, tu)) return false;
        u.pm = br * (T / 256) + tu.pm; u.pn = br * 4 + tu.pn; return true;
    }
    __device__ __forceinline__ void a_ready(const pg8::Unit&) const {}
    __device__ __forceinline__ void done(const pg8::Unit&) const {}
};
struct EpiResF32 {
    static constexpr bool PERM = false, AFTER_DRAIN = false; static constexpr int NST = 32;
    const float* base; float* out; int ldc; float* ssq;
    __device__ __forceinline__ void operator()(const pg8::f32x4 (&acc)[2][2][4][2], const pg8::Unit& u, int wr, int wc, int fr, int fq) const {
        const int col0 = u.pn * pg8::BM + wc * 32 + 4 * fq;
#pragma unroll
        for (int ai = 0; ai < 2; ++ai)
#pragma unroll
            for (int m = 0; m < 4; ++m) { const int row = u.pm * pg8::BM + ai * pg8::HALF + wr * 64 + m * 16 + fr; const size_t off = (size_t)row * ldc + col0; float sq = 0.f;
#pragma unroll
                for (int bj = 0; bj < 2; ++bj)
#pragma unroll
                    for (int n = 0; n < 2; ++n) { const pg8::f32x4 bs = *(const pg8::f32x4*)(base + off + bj * pg8::HALF + n * 16); const pg8::f32x4 o = bs + acc[ai][bj][m][n];
                        *(pg8::f32x4*)(out + off + bj * pg8::HALF + n * 16) = o; sq += (o[0] * o[0] + o[1] * o[1]) + (o[2] * o[2] + o[3] * o[3]); }
                sq += __shfl_xor(sq, 16); sq += __shfl_xor(sq, 32);
                if (fq == 0) ssq[row * 16 + u.pn * 4 + wc] = sq;
                asm volatile("" ::: "memory"); }
    }
};
struct EpiSwiglu {
    static constexpr bool PERM = true, AFTER_DRAIN = false; static constexpr int NST = 8;
    unsigned char* O; const float* bias;
    __device__ __forceinline__ void operator()(const pg8::f32x4 (&acc)[2][2][4][2], const pg8::Unit& u, int wr, int wc, int fr, int fq) const {
        const int e = u.pn >> 3, pl = u.pn & 7, f0 = pl * 128 + wc * 32 + 8 * fq, row0 = u.pm * pg8::BM + wr * 64 + fr;
        const float* bg = bias + e * 2048 + f0;
        pg8::f32x4 bgv[2], blv[2];
#pragma unroll
        for (int n = 0; n < 2; ++n) { bgv[n] = *(const pg8::f32x4*)(bg + 4 * n); blv[n] = *(const pg8::f32x4*)(bg + 1024 + 4 * n); }
#pragma unroll
        for (int ai = 0; ai < 2; ++ai)
#pragma unroll
            for (int m = 0; m < 4; ++m) { unsigned char* rowp = O + (size_t)(row0 + ai * pg8::HALF + m * 16) * 1024 + f0; float a[8];
#pragma unroll
                for (int n = 0; n < 2; ++n) { const pg8::f32x4 g4 = acc[ai][0][m][n] + bgv[n], l4 = acc[ai][1][m][n] + blv[n];
#pragma unroll
                    for (int j = 0; j < 4; ++j) { const float g = fminf(g4[j], 7.f), l = fminf(fmaxf(l4[j], -7.f), 7.f); a[4 * n + j] = g * (l + 1.f) * __builtin_amdgcn_rcpf(1.f + __builtin_amdgcn_exp2f(-1.702f * 1.4426950408889634f * g)); } }
                u32x2s w; w.x = pk4_fp8(a[0], a[1], a[2], a[3]); w.y = pk4_fp8(a[4], a[5], a[6], a[7]);
                *(u32x2s*)rowp = w; }
    }
};
struct EpiF8Bias {
    static constexpr bool PERM = true, AFTER_DRAIN = false; static constexpr int NST = 16;
    unsigned char* O; int ldc; const float* bias; int split_cols;
    __device__ __forceinline__ void operator()(const pg8::f32x4 (&acc)[2][2][4][2], const pg8::Unit& u, int wr, int wc, int fr, int fq) const {
        const int row0 = u.pm * pg8::BM + wr * 64 + fr; int colt = u.pn * pg8::BM; colt -= (colt / split_cols) * split_cols;
        const int col0 = colt + wc * 32 + 8 * fq, bcol0 = u.pn * pg8::BM + wc * 32 + 8 * fq;
        pg8::f32x4 bv[2][2];
#pragma unroll
        for (int bj = 0; bj < 2; ++bj)
#pragma unroll
            for (int n = 0; n < 2; ++n) bv[bj][n] = *(const pg8::f32x4*)(bias + bcol0 + bj * pg8::HALF + 4 * n);
#pragma unroll
        for (int ai = 0; ai < 2; ++ai)
#pragma unroll
            for (int m = 0; m < 4; ++m) { unsigned char* rowp = O + (size_t)(row0 + ai * pg8::HALF + m * 16) * ldc + col0;
#pragma unroll
                for (int bj = 0; bj < 2; ++bj) { const pg8::f32x4 v0 = acc[ai][bj][m][0] + bv[bj][0], v1 = acc[ai][bj][m][1] + bv[bj][1];
                    u32x2s w; w.x = pk4_fp8(v0[0], v0[1], v0[2], v0[3]); w.y = pk4_fp8(v1[0], v1[1], v1[2], v1[3]); *(u32x2s*)(rowp + bj * pg8::HALF) = w; } }
    }
};
struct PartOrder {
    pg8::StaticOrder so; int f8;
    __device__ __forceinline__ bool next(int i, pg8::Unit& u) const {
        pg8::Unit tu; if (!so.next(i, tu)) return false;
        u.pm = tu.pm; u.pn = f8 ? tu.pn + 14 : tu.pn; return true;
    }
    __device__ __forceinline__ void a_ready(const pg8::Unit&) const {}
    __device__ __forceinline__ void done(const pg8::Unit&) const {}
};
struct MoeOrder {
    const volatile LAS int* tab; int nN, ntiles, G, c; const int* list;
    __device__ __forceinline__ bool next(int i, pg8::Unit& u) const {
        const long L = (long)i * G + c; const int nwg = ntiles * nN; if (L >= (long)nwg) return false;
        int wgid = (int)L; { const int q = nwg / 8, r = nwg % 8, xcd = wgid % 8, off = wgid / 8; wgid = (xcd < r ? xcd * (q + 1) : r * (q + 1) + (xcd - r) * q) + off; }
        const int nig = 8 * nN, gid = wgid / nig, fm = gid * 8, gsz = (ntiles - fm) < 8 ? (ntiles - fm) : 8;
        const int pm = fm + ((wgid % nig) % gsz), pl = (wgid % nig) / gsz;
        const int lj = (int)(threadIdx.x & 63); const int tv = tab[lj & 31];
        const int e = (int)__popcll(__ballot(lj >= 1 && lj < NE && tv <= pm));
        u.pm = __builtin_amdgcn_readfirstlane(pm); u.pn = __builtin_amdgcn_readfirstlane(e * nN + pl); return true;
    }
    __device__ __forceinline__ const int* rows_list(const pg8::Unit& u) const { const int e = u.pn / nN; return list + __builtin_amdgcn_readfirstlane(e * 16384 + (u.pm - tab[e]) * 256); }
    __device__ __forceinline__ int nrows(const pg8::Unit& u) const { const int e = u.pn / nN; return __builtin_amdgcn_readfirstlane(tab[48 + e] - (u.pm - tab[e]) * 256); }
    __device__ __forceinline__ void a_ready(const pg8::Unit&) const {}
    __device__ __forceinline__ void done(const pg8::Unit&) const {}
};

struct Args { const float* in[22]; float* out; unsigned char* ws; int ph_lo, ph_hi; };
__global__ void __launch_bounds__(NWAVES * 64, 2) fwd_kernel(Args args) {
    extern __shared__ __attribute__((aligned(16))) unsigned char lds[];
    Frame F;
    F.lds = (LAS unsigned char*)lds;
    F.MISC = (volatile LAS unsigned*)(F.lds + MISC_OFF);
    F.tid = threadIdx.x; F.lane = F.tid & 63; F.wave = __builtin_amdgcn_readfirstlane(F.tid >> 6);
    F.G = gridDim.x; { const int bx = blockIdx.x; F.vcu = (F.G % 8 == 0) ? (bx % 8) * (F.G / 8) + bx / 8 : bx; }
    F.ws = args.ws; F.out = args.out; F.ctl = (gu32*)(F.ws + WS_CTL);
    for (int u = F.tid; u < (LDS_BYTES - LDSCTL_OFF) / 4; u += NWAVES * 64) ((LAS unsigned*)(F.lds + LDSCTL_OFF))[u] = 0u;
    __syncthreads();
    XcdBarrier bar = xcd_barrier_post((unsigned*)(F.ctl + CW_BAR), F.MISC + 8);
    const int lo = args.ph_lo, hi = args.ph_hi;
#ifndef REPMASK
#define REPMASK 0
#endif
#define IN(k) (lo <= (k) && (k) < hi)
#define NREP(k) (((REPMASK >> (k)) & 1) ? 2 : 1)
#define GRID_BAR() xcd_barrier(bar)

    const bool split = (F.G == 256);
    const int g1 = split ? G_PROJ : F.G;
    if (IN(0)) { p0_prologue(F, split ? CI_SMALL + CI_D_P0 : CI_ALL); GRID_BAR(); }
    if (IN(1)) {
        const bool gemm_role = (int)blockIdx.x < g1;
        if (gemm_role) {
            { pg8::Gemm g{WSP(bf16, WS_XN), WSP(bf16, WS_WIN), T, INW, D}; PartOrder S; S.so.init(T, 14 * 256, g1, (int)blockIdx.x); S.f8 = 0;
              pg8::EpiBf16<0> E{WSP(bf16, WS_PROJ), INW, nullptr, 0, 0, 1.f};
              pg8::gemm_phase<pg8::EpiBf16<0>, PartOrder, true, true>(F.lds + RING_OFF, g, S, E); }
            { pg8::Gemm8 g{WSP(unsigned char, WS_XN8), WSP(unsigned char, WS_WIN8), T, INW, D}; PartOrder S; S.so.init(T, 12 * 256, g1, (int)blockIdx.x); S.f8 = 1;
              pg8::EpiBf16<0> E{WSP(bf16, WS_PROJ), INW, nullptr, 0, 0, 1.f};
              pg8::gemm_phase_f8<pg8::EpiBf16<0>, PartOrder, true, true>(F.lds + RING_OFF, g, S, E); } }
        if (!gemm_role || !split) {
            pg8::Gemm g{WSP(bf16, WS_MEMN), WSP(bf16, WS_WKV), MROWS, 1024, D}; pg8::StaticOrder S; S.init(MROWS, 1024, split ? F.G - g1 : F.G, split ? (int)blockIdx.x - g1 : (int)blockIdx.x);
            pg8::EpiBf16<0> E{WSP(bf16, WS_KV), 1024, nullptr, 0, 0, 1.f};
            pg8::gemm_phase<pg8::EpiBf16<0>, pg8::StaticOrder, true, true>(F.lds + RING_OFF, g, S, E); }
        if (!gemm_role) conv_items(F, CI_SMALL + CI_D_P0, CI_ALL, ((int)blockIdx.x - g1) * NWAVES + F.wave, (F.G - g1) * NWAVES, (LAS float*)(F.lds + RING_OFF + F.wave * 16384));
        GRID_BAR();
    }
    if (IN(3)) { _Pragma("unroll 1") for (int rep = 0; rep < NREP(3); ++rep) { p2_mixers(F); GRID_BAR(); } }
    if (IN(4)) _Pragma("unroll 1") for (int rep = 0; rep < NREP(4); ++rep) {
        pg8::Gemm g{WSP(bf16, WS_OBR), WSP(bf16, WS_WBR), 3 * T, 3 * 1024, 512}; BranchOrder S; S.so.init(T, D, F.G, (int)blockIdx.x);
        EpiGate E{WSP(bf16, WS_PROJ) + C_G, WSP(bf16, WS_MERGED)};
        pg8::gemm_phase<EpiGate, BranchOrder, true, true>(F.lds + RING_OFF, g, S, E);
        GRID_BAR();
    }
    if (IN(6)) _Pragma("unroll 1") for (int rep = 0; rep < NREP(6); ++rep) {
        pg8::Gemm g{WSP(bf16, WS_MERGED), WSP(bf16, WS_WO), T, D, D}; pg8::StaticOrder S; S.init(T, D, F.G, (int)blockIdx.x);
        EpiResF32 E{in_ptr(I_X), F.out, D, WSP(float, WS_SSQ)};
        pg8::gemm_phase<EpiResF32, pg8::StaticOrder, true, true>(F.lds + RING_OFF, g, S, E);
        GRID_BAR();
    }
    if (IN(7)) { p5_route(F); GRID_BAR(); }
    if (IN(9)) _Pragma("unroll 1") for (int rep = 0; rep < NREP(9); ++rep) {
        moe_table(F);
        const volatile LAS int* tab = (const volatile LAS int*)(F.lds + TAB_OFF);
        pg8::Gemm8 g{WSP(unsigned char, WS_HF8), WSP(unsigned char, WS_WGU), T, NE * 2048, D}; MoeOrder S{tab, 8, __builtin_amdgcn_readfirstlane(tab[40]), F.G, (int)blockIdx.x, WSP(int, WS_LIST)};
        EpiSwiglu E{WSP(unsigned char, WS_ACT), in_ptr(I_BGU)};
        pg8::gemm_phase_f8g<EpiSwiglu, MoeOrder, true, true>(F.lds + RING_OFF, (LAS int*)(F.lds + TAB_OFF + 2048), g, S, E);
        GRID_BAR();
    }
    if (IN(10)) _Pragma("unroll 1") for (int rep = 0; rep < NREP(10); ++rep) {
        if (!IN(9)) moe_table(F);
        const volatile LAS int* tab = (const volatile LAS int*)(F.lds + TAB_OFF);
        pg8::Gemm8 g{WSP(unsigned char, WS_ACT), WSP(unsigned char, WS_WD), SLOTROWS, NE * 1024, FF}; MoeOrder S{tab, 4, __builtin_amdgcn_readfirstlane(tab[40]), F.G, (int)blockIdx.x, nullptr};
        EpiF8Bias E{WSP(unsigned char, WS_Y), D, in_ptr(I_BD), 1024};
        pg8::gemm_phase_f8<EpiF8Bias, MoeOrder, true, true>(F.lds + RING_OFF, g, S, E);
        GRID_BAR();
    }
    if (IN(11)) { p8_combine(F); }
#undef IN
#undef GRID_BAR
}

extern "C" void kernel_launch(void* const* d_in, const int* in_sizes, int n_in, void* d_out, int out_size, void* d_ws, size_t ws_size, hipStream_t stream) {
    static int grid = 0;
    if (grid == 0) {
        if (n_in != 22 || out_size != T * D || ws_size < WS_END) { fprintf(stderr, "kernel_launch: unexpected problem (n_in %d, out %d, ws %zu)\n", n_in, out_size, ws_size); grid = -1; return; }
        int dev = 0, cus = 0, per_cu = 0;
        if (hipGetDevice(&dev) != hipSuccess || hipDeviceGetAttribute(&cus, hipDeviceAttributeMultiprocessorCount, dev) != hipSuccess) { grid = -1; return; }
        if (hipFuncSetAttribute((const void*)fwd_kernel, hipFuncAttributeMaxDynamicSharedMemorySize, LDS_BYTES) != hipSuccess) { fprintf(stderr, "kernel_launch: hipFuncSetAttribute failed\n"); grid = -1; return; }
        if (hipOccupancyMaxActiveBlocksPerMultiprocessor(&per_cu, (const void*)fwd_kernel, NWAVES * 64, LDS_BYTES) != hipSuccess || per_cu < 1) { fprintf(stderr, "kernel_launch: occupancy query says %d\n", per_cu); (void)hipGetLastError(); grid = -1; return; }
        grid = cus;
    }
    if (grid < 0) return;
    if (hipMemsetAsync((char*)d_ws + WS_CTL, 0, CTL_ZERO_BYTES, stream) != hipSuccess) { fprintf(stderr, "kernel_launch: memset failed\n"); return; }
    Args a{};
    for (int i = 0; i < 22; ++i) a.in[i] = (const float*)d_in[i];
    a.out = (float*)d_out; a.ws = (unsigned char*)d_ws; a.ph_lo = 0; a.ph_hi = 12;
    void* kargs[] = {&a};
    const hipError_t le = hipLaunchCooperativeKernel((const void*)fwd_kernel, dim3(grid), dim3(NWAVES * 64), kargs, LDS_BYTES, stream);
    if (le != hipSuccess) fprintf(stderr, "kernel_launch: launch failed: %s (grid %d)\n", hipGetErrorName(le), grid);
}
```

```cpp
#include <hip/hip_runtime.h>
#include <cstdio>
#include <cstdint>
namespace pg8 {
#define PG8_LAS __attribute__((address_space(3)))
typedef unsigned short bf16_t;
typedef short bf16x8 __attribute__((ext_vector_type(8)));
typedef float f32x4 __attribute__((ext_vector_type(4)));
typedef unsigned u32x4 __attribute__((ext_vector_type(4)));
constexpr int BM = 256, BK = 64, HALF = 128, HTB = HALF * BK * 2  , STAGE_BYTES = 8 * HTB, NXCD = 8, WGM = 8;

__host__ __device__ __forceinline__ int lds_byte(int r, int c) { const int st = (r >> 4) * 2 + (c >> 5), rr = r & 15, cc = c & 31, ob = rr * 64 + cc * 2; return st * 1024 + (ob ^ (((ob >> 9) & 1) << 5)); }
__host__ __device__ __forceinline__ void stage_rc(int b, int& R, int& C) { const int st = b / 1024, sb = b % 1024, swz = sb ^ (((sb >> 9) & 1) << 5); R = (st >> 1) * 16 + swz / 64; C = (st & 1) * 32 + (swz % 64) / 2; }
__host__ __device__ __forceinline__ int perm32(int rho) { const int n = rho >> 4, i = rho & 15; return 8 * (i >> 2) + 4 * n + (i & 3); }

struct Unit { int pm, pn; };
struct Gemm { const bf16_t* A; const bf16_t* Bt; int M, N, K; };

struct StaticOrder {
    int nM, nN, nwg, G, c;
    __host__ __device__ void init(int M, int N, int G_, int c_) { nM = M / BM; nN = N / BM; nwg = nM * nN; G = G_; c = c_; }
    __host__ __device__ bool next(int i, Unit& u) const {
        const long L = (long)i * G + c; if (L >= nwg) return false;
        int wgid = (int)L; { const int q = nwg / NXCD, r = nwg % NXCD, xcd = wgid % NXCD, off = wgid / NXCD; wgid = (xcd < r ? xcd * (q + 1) : r * (q + 1) + (xcd - r) * q) + off; }
        const int nig = WGM * nN, gid = wgid / nig, fm = gid * WGM, gsz = (nM - fm) < WGM ? (nM - fm) : WGM;
        u.pm = fm + ((wgid % nig) % gsz); u.pn = (wgid % nig) / gsz; return true;
    }
    __device__ __forceinline__ void a_ready(const Unit&) const {}
    __device__ __forceinline__ void done(const Unit&) const {}
};

__device__ __forceinline__ unsigned cvt_pk_bf16(float lo, float hi) { unsigned r; asm volatile("v_cvt_pk_bf16_f32 %0, %1, %2" : "=v"(r) : "v"(lo), "v"(hi)); return r; }
typedef float f32x2 __attribute__((ext_vector_type(2)));
__device__ __forceinline__ f32x2 gelu_pk(f32x2 v) {
    const f32x2 av = __builtin_elementwise_abs(v), d = av * 0.2316418882f + 1.0f;
    f32x2 t; t.x = __builtin_amdgcn_rcpf(d.x); t.y = __builtin_amdgcn_rcpf(d.y);
    f32x2 q = t * 0.5307027145f + (-0.7265760135f); q = q * t + 0.7107068705f; q = q * t + (-0.142248368f); q = q * t + 0.127414796f; q = q * t;
    const f32x2 s = (v * v) * (-0.72134752044f);
    f32x2 e; e.x = __builtin_amdgcn_exp2f(s.x); e.y = __builtin_amdgcn_exp2f(s.y);
    const f32x2 m = v * (q * e), r = v - m;
    f32x2 o; o.x = v.x < 0.f ? m.x : r.x; o.y = v.y < 0.f ? m.y : r.y; return o;
}

template <int ACT  > struct EpiBf16 {
    static constexpr int NST = 16;
    static constexpr bool PERM = true, AFTER_DRAIN = false; static_assert(ACT == 0 || ACT == 1, "EpiBf16: ACT is 0 (none) or 1 (gelu_pk)");
    bf16_t* O; int ldc; const float* bias; int split_cols; size_t split_stride; float scale0;
    __device__ __forceinline__ void operator()(const f32x4 (&acc)[2][2][4][2], const Unit& u, int wr, int wc, int fr, int fq) const {
        const int row0 = u.pm * BM + wr * 64 + fr; int colt = u.pn * BM; bf16_t* base = O;
        float sc = 1.f; if (split_cols) { const int t = colt / split_cols; base += (size_t)t * split_stride; colt -= t * split_cols; if (t == 0) sc = scale0; }
        const int col0 = colt + wc * 32 + 8 * fq, bcol0 = u.pn * BM + wc * 32 + 8 * fq;
        f32x4 bv[2][2];
#pragma unroll
        for (int bj = 0; bj < 2; ++bj)
#pragma unroll
            for (int n = 0; n < 2; ++n) bv[bj][n] = bias ? *(const f32x4*)(bias + bcol0 + bj * HALF + 4 * n) : (f32x4){0.f, 0.f, 0.f, 0.f};
#pragma unroll
        for (int ai = 0; ai < 2; ++ai)
#pragma unroll
            for (int m = 0; m < 4; ++m) { bf16_t* rowp = base + (size_t)(row0 + ai * HALF + m * 16) * ldc + col0;
#pragma unroll
                for (int bj = 0; bj < 2; ++bj) { f32x4 v0 = acc[ai][bj][m][0] + bv[bj][0], v1 = acc[ai][bj][m][1] + bv[bj][1];
                    if (ACT == 1) { f32x2 a = gelu_pk((f32x2){v0[0], v0[1]}), b = gelu_pk((f32x2){v0[2], v0[3]}), c = gelu_pk((f32x2){v1[0], v1[1]}), d = gelu_pk((f32x2){v1[2], v1[3]});
                        v0 = (f32x4){a.x, a.y, b.x, b.y}; v1 = (f32x4){c.x, c.y, d.x, d.y}; }
                    v0 = v0 * sc; v1 = v1 * sc; u32x4 w; w.x = cvt_pk_bf16(v0[0], v0[1]); w.y = cvt_pk_bf16(v0[2], v0[3]); w.z = cvt_pk_bf16(v1[0], v1[1]); w.w = cvt_pk_bf16(v1[2], v1[3]);
                    *(u32x4*)(rowp + bj * HALF) = w; } }
    }
};
template <class Epi, class Sched, bool ALIGN_EPI = false, bool SP2 = false>
__device__ __forceinline__ void gemm_phase(PG8_LAS unsigned char* lds, const Gemm g, const Sched& S, const Epi& E) {
    const int tid = threadIdx.x, wid = __builtin_amdgcn_readfirstlane(tid >> 6), lane = tid & 63, wr = wid >> 2, wc = wid & 3, fr = lane & 15, fq = lane >> 4;
    const int K = g.K, nt = K / BK;
    unsigned voffA[2], voffB[2];
#pragma unroll
    for (int i = 0; i < 2; ++i) { int R, C; stage_rc(tid * 16 + i * 8192, R, C); const int Rb = Epi::PERM ? ((R & ~31) + perm32(R & 31)) : R;
        voffA[i] = (unsigned)(R * K + C) * 2u; voffB[i] = (unsigned)(Rb * K + C) * 2u; }
    const size_t kstep = (size_t)(BK * 2);
    const size_t hstep = (size_t)HALF * K * 2;
    const size_t tstep = 2 * hstep;
    const unsigned ldsw = (unsigned)wid * 1024u;
    const int aoff = lds_byte(wr * 64 + fr, fq * 8), boff = lds_byte(wc * 32 + fr, fq * 8);
#define PG8_SA(b, h) (((b) * 2 + (h)) * HTB)
#define PG8_SB(b, h) ((4 + (b) * 2 + (h)) * HTB)
#define PG8_STAGE(bufoff, gbase, voff) do { _Pragma("unroll") for (int _i = 0; _i < 2; ++_i) \
        __builtin_amdgcn_global_load_lds((const unsigned*)((const char*)(gbase) + (voff)[_i]), (PG8_LAS unsigned*)(lds + (bufoff) + ldsw + _i * 8192), 16, 0, 0); } while (0)
#define PG8_LDA(dst, b, h) do { _Pragma("unroll") for (int m = 0; m < 4; ++m) _Pragma("unroll") for (int k = 0; k < 2; ++k) dst[m][k] = *(const PG8_LAS bf16x8*)(lds + PG8_SA(b, h) + aoff + m * 2048 + k * 1024); } while (0)
#define PG8_LDB(dst, b, h) do { _Pragma("unroll") for (int n = 0; n < 2; ++n) _Pragma("unroll") for (int k = 0; k < 2; ++k) dst[n][k] = *(const PG8_LAS bf16x8*)(lds + PG8_SB(b, h) + boff + n * 2048 + k * 1024); } while (0)
#define PG8_MMA(ai, bj, At, Bt) do { __builtin_amdgcn_s_setprio(1); _Pragma("unroll") for (int m = 0; m < 4; ++m) _Pragma("unroll") for (int n = 0; n < 2; ++n) _Pragma("unroll") for (int k = 0; k < 2; ++k) \
        acc[ai][bj][m][n] = __builtin_amdgcn_mfma_f32_16x16x32_bf16(Bt[n][k], At[m][k], acc[ai][bj][m][n], 0, 0, 0); __builtin_amdgcn_s_setprio(0); } while (0)
#define PG8_WAIT_V(n) asm volatile("s_waitcnt vmcnt(" #n ")" ::: "memory")
#define PG8_WAIT_VE(nweak, nstrong, flag) asm volatile("s_waitcnt vmcnt(%0)\n\tv_cmp_ne_u32_e32 vcc, 0, %2\n\ts_nop 3\n\ts_cbranch_vccnz 1f\n\ts_waitcnt vmcnt(%1)\n1:" :: "n"(nweak), "n"(nstrong), "v"(flag) : "memory", "vcc")
#define PG8_WAIT_L(n) asm volatile("s_waitcnt lgkmcnt(" #n ")" ::: "memory")
#define PG8_BAR __builtin_amdgcn_s_barrier()
#define PG8_SCHED __builtin_amdgcn_sched_barrier(0)
    Unit cur, nxt; int ui = 0;
    if (!S.next(0, cur)) return;
    f32x4 acc[2][2][4][2];
#pragma unroll
    for (int a = 0; a < 2; ++a)
#pragma unroll
        for (int b = 0; b < 2; ++b)
#pragma unroll
            for (int m = 0; m < 4; ++m)
#pragma unroll
                for (int n = 0; n < 2; ++n) acc[a][b][m][n] = (f32x4){0.f, 0.f, 0.f, 0.f};
    bf16x8 At[4][2], B0[2][2], B1[2][2];
    const char* cA = (const char*)g.A + (size_t)cur.pm * tstep; const char* cB = (const char*)g.Bt + (size_t)cur.pn * tstep;
    S.a_ready(cur);
    if constexpr (SP2) {
        PG8_STAGE(PG8_SB(0, 0), cB, voffB); PG8_STAGE(PG8_SB(0, 1), cB + hstep, voffB); PG8_STAGE(PG8_SA(0, 0), cA, voffA); PG8_STAGE(PG8_SA(0, 1), cA + hstep, voffA);
        if (wr == 1) PG8_BAR;
        PG8_WAIT_V(2); PG8_BAR;
        PG8_STAGE(PG8_SB(1, 0), cB + kstep, voffB); PG8_STAGE(PG8_SA(1, 0), cA + kstep, voffA); PG8_STAGE(PG8_SB(1, 1), cB + hstep + kstep, voffB);
        PG8_WAIT_V(6); PG8_BAR;
    } else {
        PG8_STAGE(PG8_SB(0, 0), cB, voffB); PG8_STAGE(PG8_SA(0, 0), cA, voffA); PG8_STAGE(PG8_SB(0, 1), cB + hstep, voffB); PG8_STAGE(PG8_SA(0, 1), cA + hstep, voffA);
        if (wr == 1) PG8_BAR;
        PG8_WAIT_V(4); PG8_BAR;
        PG8_STAGE(PG8_SB(1, 0), cB + kstep, voffB); PG8_STAGE(PG8_SA(1, 0), cA + kstep, voffA); PG8_STAGE(PG8_SB(1, 1), cB + hstep + kstep, voffB);
        PG8_WAIT_V(6); PG8_BAR;
    }
    for (;;) {
        const bool has_next = S.next(ui + 1, nxt);
        const char* nA = has_next ? (const char*)g.A + (size_t)nxt.pm * tstep : cA; const char* nB = has_next ? (const char*)g.Bt + (size_t)nxt.pn * tstep : cB;
        for (int t = 0; t < nt; t += 2) {
            const bool last = (t == nt - 2);
            const int fe = ((t == 0) && (ui > 0)) ? 1 : 0;
            const char* a1 = cA + (size_t)(t + 1) * kstep;
            const char* a2 = last ? nA : cA + (size_t)(t + 2) * kstep; const char* b2 = last ? nB : cB + (size_t)(t + 2) * kstep;
            const char* a3 = a2 + kstep; const char* b3 = b2 + kstep;
            if (last && has_next) S.a_ready(nxt);
            if constexpr (SP2) {
            PG8_LDB(B0, 0, 0); PG8_LDB(B1, 0, 1); PG8_SCHED; PG8_LDA(At, 0, 0); PG8_STAGE(PG8_SA(1, 1), a1 + hstep, voffA);
            PG8_WAIT_VE(8 + Epi::NST, 8, fe); PG8_WAIT_L(0); PG8_BAR; PG8_MMA(0, 0, At, B0); PG8_MMA(0, 1, At, B1); PG8_BAR; PG8_SCHED;
            PG8_LDA(At, 0, 1); PG8_STAGE(PG8_SB(0, 0), b2, voffB); PG8_STAGE(PG8_SB(0, 1), b2 + hstep, voffB); PG8_STAGE(PG8_SA(0, 0), a2, voffA);
            PG8_WAIT_VE(8 + Epi::NST, 8, fe); PG8_WAIT_L(0); PG8_BAR; PG8_MMA(1, 0, At, B0); PG8_MMA(1, 1, At, B1); PG8_BAR; PG8_SCHED;
            PG8_LDB(B0, 1, 0); PG8_LDB(B1, 1, 1); PG8_SCHED; PG8_LDA(At, 1, 0); PG8_STAGE(PG8_SA(0, 1), a2 + hstep, voffA);
            PG8_WAIT_V(8); PG8_WAIT_L(0); PG8_BAR; PG8_MMA(0, 0, At, B0); PG8_MMA(0, 1, At, B1); PG8_BAR; PG8_SCHED;
            PG8_LDA(At, 1, 1); PG8_STAGE(PG8_SB(1, 0), b3, voffB); PG8_STAGE(PG8_SB(1, 1), b3 + hstep, voffB); PG8_STAGE(PG8_SA(1, 0), a3, voffA);
            PG8_WAIT_V(8); PG8_WAIT_L(0); PG8_BAR; PG8_MMA(1, 0, At, B0); PG8_MMA(1, 1, At, B1); PG8_BAR; PG8_SCHED;
            } else {
            PG8_LDB(B0, 0, 0); PG8_SCHED; PG8_LDA(At, 0, 0); PG8_STAGE(PG8_SA(1, 1), a1 + hstep, voffA);
            PG8_WAIT_L(8); PG8_BAR; PG8_WAIT_L(0); PG8_MMA(0, 0, At, B0); PG8_BAR; PG8_SCHED;
            PG8_LDB(B1, 0, 1); PG8_STAGE(PG8_SB(0, 0), b2, voffB);
            PG8_BAR; PG8_WAIT_L(0); PG8_MMA(0, 1, At, B1); PG8_BAR;
            PG8_LDA(At, 0, 1); PG8_STAGE(PG8_SA(0, 0), a2, voffA);
            PG8_BAR; PG8_WAIT_L(0); PG8_MMA(1, 0, At, B0); PG8_BAR; PG8_SCHED;
            PG8_STAGE(PG8_SB(0, 1), b2 + hstep, voffB);
            PG8_WAIT_V(6); PG8_BAR; PG8_MMA(1, 1, At, B1); PG8_BAR;
            PG8_LDB(B0, 1, 0); PG8_SCHED; PG8_LDA(At, 1, 0); PG8_STAGE(PG8_SA(0, 1), a2 + hstep, voffA);
            PG8_WAIT_L(8); PG8_BAR; PG8_WAIT_L(0); PG8_MMA(0, 0, At, B0); PG8_BAR; PG8_SCHED;
            PG8_LDB(B1, 1, 1); PG8_STAGE(PG8_SB(1, 0), b3, voffB);
            PG8_BAR; PG8_WAIT_L(0); PG8_MMA(0, 1, At, B1); PG8_BAR;
            PG8_LDA(At, 1, 1); PG8_STAGE(PG8_SA(1, 0), a3, voffA);
            PG8_BAR; PG8_WAIT_L(0); PG8_MMA(1, 0, At, B0); PG8_BAR; PG8_SCHED;
            PG8_STAGE(PG8_SB(1, 1), b3 + hstep, voffB);
            PG8_WAIT_V(6); PG8_BAR; PG8_MMA(1, 1, At, B1); PG8_BAR;
            }
        }
        if constexpr (ALIGN_EPI) { if (wr == 0) PG8_BAR; }
        if constexpr (!Epi::AFTER_DRAIN) { E(acc, cur, wr, wc, fr, fq); S.done(cur); }
        if (!has_next) break;
#pragma unroll
        for (int a = 0; a < 2; ++a)
#pragma unroll
            for (int b = 0; b < 2; ++b)
#pragma unroll
                for (int m = 0; m < 4; ++m)
#pragma unroll
                    for (int n = 0; n < 2; ++n) acc[a][b][m][n] = (f32x4){0.f, 0.f, 0.f, 0.f};
        cur = nxt; cA = nA; cB = nB; ++ui;
        if constexpr (ALIGN_EPI) { if (wr == 1) PG8_BAR; }
    }
    PG8_WAIT_V(0);
    if constexpr (!ALIGN_EPI) { if (wr == 0) PG8_BAR; }
    PG8_BAR;
    if constexpr (Epi::AFTER_DRAIN) { E.fused(acc, cur, wr, wc, fr, fq, lds, wid, lane); S.done(cur); }
#undef PG8_SA
#undef PG8_SB
#undef PG8_STAGE
#undef PG8_LDA
#undef PG8_LDB
#undef PG8_MMA
#undef PG8_WAIT_V
#undef PG8_WAIT_VE
#undef PG8_WAIT_L
#undef PG8_BAR
#undef PG8_SCHED
}
}

#ifndef PG8_SP2
#define PG8_SP2 true
#endif
#ifndef PG8_ALIGN
#define PG8_ALIGN true
#endif
namespace pg8 {
typedef int i32x4 __attribute__((ext_vector_type(4)));
typedef int i32x8 __attribute__((ext_vector_type(8)));
struct Gemm8 { const unsigned char* A; const unsigned char* Bt; int M, N, K; };
template <class Epi, class Sched, bool ALIGN_EPI = false, bool SP2 = false>
__device__ __forceinline__ void gemm_phase_f8(PG8_LAS unsigned char* lds, const Gemm8 g, const Sched& S, const Epi& E) {
    const int tid = threadIdx.x, wid = __builtin_amdgcn_readfirstlane(tid >> 6), lane = tid & 63, wr = wid >> 2, wc = wid & 3, fr = lane & 15, fq = lane >> 4;
    const int K = g.K, nt = K / 128;
    unsigned voffA[2], voffB[2];
#pragma unroll
    for (int i = 0; i < 2; ++i) { int R, C; stage_rc(tid * 16 + i * 8192, R, C); const int Rb = Epi::PERM ? ((R & ~31) + perm32(R & 31)) : R;
        voffA[i] = (unsigned)(R * K + C * 2); voffB[i] = (unsigned)(Rb * K + C * 2); }
    const size_t kstep = (size_t)(BK * 2);
    const size_t hstep = (size_t)HALF * K;
    const size_t tstep = 2 * hstep;
    const unsigned ldsw = (unsigned)wid * 1024u;
    const int aoff = lds_byte(wr * 64 + fr, fq * 8), boff = lds_byte(wc * 32 + fr, fq * 8);
#define PG8_SA(b, h) (((b) * 2 + (h)) * HTB)
#define PG8_SB(b, h) ((4 + (b) * 2 + (h)) * HTB)
#define PG8_STAGE(bufoff, gbase, voff) do { _Pragma("unroll") for (int _i = 0; _i < 2; ++_i) \
        __builtin_amdgcn_global_load_lds((const unsigned*)((const char*)(gbase) + (voff)[_i]), (PG8_LAS unsigned*)(lds + (bufoff) + ldsw + _i * 8192), 16, 0, 0); } while (0)
#define PG8_LD32(p) __builtin_shufflevector(*(const PG8_LAS i32x4*)(p), *(const PG8_LAS i32x4*)((p) + 1024), 0, 1, 2, 3, 4, 5, 6, 7)
#define PG8_LDA(dst, b, h) do { _Pragma("unroll") for (int m = 0; m < 4; ++m) dst[m] = PG8_LD32(lds + PG8_SA(b, h) + aoff + m * 2048); } while (0)
#define PG8_LDB(dst, b, h) do { _Pragma("unroll") for (int n = 0; n < 2; ++n) dst[n] = PG8_LD32(lds + PG8_SB(b, h) + boff + n * 2048); } while (0)
#define PG8_MMA(ai, bj, At, Bt) do { __builtin_amdgcn_s_setprio(1); _Pragma("unroll") for (int m = 0; m < 4; ++m) _Pragma("unroll") for (int n = 0; n < 2; ++n) \
        asm volatile("v_mfma_scale_f32_16x16x128_f8f6f4 %0, %1, %2, %0, %3, %3 op_sel_hi:[0,0,0]" : "+v"(acc[ai][bj][m][n]) : "v"(Bt[n]), "v"(At[m]), "v"(one_scale)); __builtin_amdgcn_s_setprio(0); } while (0)
#define PG8_WAIT_V(n) asm volatile("s_waitcnt vmcnt(" #n ")" ::: "memory")
#define PG8_WAIT_VE(nweak, nstrong, flag) asm volatile("s_waitcnt vmcnt(%0)\n\tv_cmp_ne_u32_e32 vcc, 0, %2\n\ts_nop 3\n\ts_cbranch_vccnz 1f\n\ts_waitcnt vmcnt(%1)\n1:" :: "n"(nweak), "n"(nstrong), "v"(flag) : "memory", "vcc")
#define PG8_WAIT_L(n) asm volatile("s_waitcnt lgkmcnt(" #n ")" ::: "memory")
#define PG8_BAR __builtin_amdgcn_s_barrier()
#define PG8_SCHED __builtin_amdgcn_sched_barrier(0)
    Unit cur, nxt; int ui = 0;
    if (!S.next(0, cur)) return;
    f32x4 acc[2][2][4][2];
#pragma unroll
    for (int a = 0; a < 2; ++a)
#pragma unroll
        for (int b = 0; b < 2; ++b)
#pragma unroll
            for (int m = 0; m < 4; ++m)
#pragma unroll
                for (int n = 0; n < 2; ++n) acc[a][b][m][n] = (f32x4){0.f, 0.f, 0.f, 0.f};
    i32x8 At[4], B0[2], B1[2];
    int one_scale = 0x7f7f7f7f; asm volatile("" : "+v"(one_scale));
    const char* cA = (const char*)g.A + (size_t)cur.pm * tstep; const char* cB = (const char*)g.Bt + (size_t)cur.pn * tstep;
    S.a_ready(cur);
    if constexpr (SP2) {
        PG8_STAGE(PG8_SB(0, 0), cB, voffB); PG8_STAGE(PG8_SB(0, 1), cB + hstep, voffB); PG8_STAGE(PG8_SA(0, 0), cA, voffA); PG8_STAGE(PG8_SA(0, 1), cA + hstep, voffA);
        if (wr == 1) PG8_BAR;
        PG8_WAIT_V(2); PG8_BAR;
        PG8_STAGE(PG8_SB(1, 0), cB + kstep, voffB); PG8_STAGE(PG8_SA(1, 0), cA + kstep, voffA); PG8_STAGE(PG8_SB(1, 1), cB + hstep + kstep, voffB);
        PG8_WAIT_V(6); PG8_BAR;
    } else {
        PG8_STAGE(PG8_SB(0, 0), cB, voffB); PG8_STAGE(PG8_SA(0, 0), cA, voffA); PG8_STAGE(PG8_SB(0, 1), cB + hstep, voffB); PG8_STAGE(PG8_SA(0, 1), cA + hstep, voffA);
        if (wr == 1) PG8_BAR;
        PG8_WAIT_V(4); PG8_BAR;
        PG8_STAGE(PG8_SB(1, 0), cB + kstep, voffB); PG8_STAGE(PG8_SA(1, 0), cA + kstep, voffA); PG8_STAGE(PG8_SB(1, 1), cB + hstep + kstep, voffB);
        PG8_WAIT_V(6); PG8_BAR;
    }
    for (;;) {
        const bool has_next = S.next(ui + 1, nxt);
        const char* nA = has_next ? (const char*)g.A + (size_t)nxt.pm * tstep : cA; const char* nB = has_next ? (const char*)g.Bt + (size_t)nxt.pn * tstep : cB;
_Pragma("unroll 1")
        for (int t = 0; t < nt; t += 2) {
            const bool last = (t == nt - 2);
            const int fe = ((t == 0) && (ui > 0)) ? 1 : 0;
            const char* a1 = cA + (size_t)(t + 1) * kstep;
            const char* a2 = last ? nA : cA + (size_t)(t + 2) * kstep; const char* b2 = last ? nB : cB + (size_t)(t + 2) * kstep;
            const char* a3 = a2 + kstep; const char* b3 = b2 + kstep;
            if (last && has_next) S.a_ready(nxt);
            if constexpr (SP2) {
            PG8_LDB(B0, 0, 0); PG8_LDB(B1, 0, 1); PG8_SCHED; PG8_LDA(At, 0, 0); PG8_STAGE(PG8_SA(1, 1), a1 + hstep, voffA);
            PG8_WAIT_VE(8 + Epi::NST, 8, fe); PG8_WAIT_L(0); PG8_BAR; PG8_MMA(0, 0, At, B0); PG8_MMA(0, 1, At, B1); PG8_BAR; PG8_SCHED;
            PG8_LDA(At, 0, 1); PG8_STAGE(PG8_SB(0, 0), b2, voffB); PG8_STAGE(PG8_SB(0, 1), b2 + hstep, voffB); PG8_STAGE(PG8_SA(0, 0), a2, voffA);
            PG8_WAIT_VE(8 + Epi::NST, 8, fe); PG8_WAIT_L(0); PG8_BAR; PG8_MMA(1, 0, At, B0); PG8_MMA(1, 1, At, B1); PG8_BAR; PG8_SCHED;
            PG8_LDB(B0, 1, 0); PG8_LDB(B1, 1, 1); PG8_SCHED; PG8_LDA(At, 1, 0); PG8_STAGE(PG8_SA(0, 1), a2 + hstep, voffA);
            PG8_WAIT_V(8); PG8_WAIT_L(0); PG8_BAR; PG8_MMA(0, 0, At, B0); PG8_MMA(0, 1, At, B1); PG8_BAR; PG8_SCHED;
            PG8_LDA(At, 1, 1); PG8_STAGE(PG8_SB(1, 0), b3, voffB); PG8_STAGE(PG8_SB(1, 1), b3 + hstep, voffB); PG8_STAGE(PG8_SA(1, 0), a3, voffA);
            PG8_WAIT_V(8); PG8_WAIT_L(0); PG8_BAR; PG8_MMA(1, 0, At, B0); PG8_MMA(1, 1, At, B1); PG8_BAR; PG8_SCHED;
            } else {
            PG8_LDB(B0, 0, 0); PG8_SCHED; PG8_LDA(At, 0, 0); PG8_STAGE(PG8_SA(1, 1), a1 + hstep, voffA);
            PG8_WAIT_L(8); PG8_BAR; PG8_WAIT_L(0); PG8_MMA(0, 0, At, B0); PG8_BAR; PG8_SCHED;
            PG8_LDB(B1, 0, 1); PG8_STAGE(PG8_SB(0, 0), b2, voffB);
            PG8_BAR; PG8_WAIT_L(0); PG8_MMA(0, 1, At, B1); PG8_BAR;
            PG8_LDA(At, 0, 1); PG8_STAGE(PG8_SA(0, 0), a2, voffA);
            PG8_BAR; PG8_WAIT_L(0); PG8_MMA(1, 0, At, B0); PG8_BAR; PG8_SCHED;
            PG8_STAGE(PG8_SB(0, 1), b2 + hstep, voffB);
            PG8_WAIT_V(6); PG8_BAR; PG8_MMA(1, 1, At, B1); PG8_BAR;
            PG8_LDB(B0, 1, 0); PG8_SCHED; PG8_LDA(At, 1, 0); PG8_STAGE(PG8_SA(0, 1), a2 + hstep, voffA);
            PG8_WAIT_L(8); PG8_BAR; PG8_WAIT_L(0); PG8_MMA(0, 0, At, B0); PG8_BAR; PG8_SCHED;
            PG8_LDB(B1, 1, 1); PG8_STAGE(PG8_SB(1, 0), b3, voffB);
            PG8_BAR; PG8_WAIT_L(0); PG8_MMA(0, 1, At, B1); PG8_BAR;
            PG8_LDA(At, 1, 1); PG8_STAGE(PG8_SA(1, 0), a3, voffA);
            PG8_BAR; PG8_WAIT_L(0); PG8_MMA(1, 0, At, B0); PG8_BAR; PG8_SCHED;
            PG8_STAGE(PG8_SB(1, 1), b3 + hstep, voffB);
            PG8_WAIT_V(6); PG8_BAR; PG8_MMA(1, 1, At, B1); PG8_BAR;
            }
        }
        asm volatile("s_nop 15\n\ts_nop 15" ::: "memory");
        if constexpr (ALIGN_EPI) { if (wr == 0) PG8_BAR; }
        if constexpr (!Epi::AFTER_DRAIN) { E(acc, cur, wr, wc, fr, fq); S.done(cur); }
        if (!has_next) break;
#pragma unroll
        for (int a = 0; a < 2; ++a)
#pragma unroll
            for (int b = 0; b < 2; ++b)
#pragma unroll
                for (int m = 0; m < 4; ++m)
#pragma unroll
                    for (int n = 0; n < 2; ++n) acc[a][b][m][n] = (f32x4){0.f, 0.f, 0.f, 0.f};
        cur = nxt; cA = nA; cB = nB; ++ui;
        if constexpr (ALIGN_EPI) { if (wr == 1) PG8_BAR; }
    }
    PG8_WAIT_V(0);
    if constexpr (!ALIGN_EPI) { if (wr == 0) PG8_BAR; }
    PG8_BAR;
    if constexpr (Epi::AFTER_DRAIN) { E.fused(acc, cur, wr, wc, fr, fq, lds, wid, lane); S.done(cur); }
#undef PG8_SA
#undef PG8_SB
#undef PG8_STAGE
#undef PG8_LD32
#undef PG8_LDA
#undef PG8_LDB
#undef PG8_MMA
#undef PG8_WAIT_V
#undef PG8_WAIT_VE
#undef PG8_WAIT_L
#undef PG8_BAR
#undef PG8_SCHED
}
}
namespace pg8 {
template <class Epi, class Sched, bool ALIGN_EPI = false, bool SP2 = true>
__device__ __forceinline__ void gemm_phase_f8g(PG8_LAS unsigned char* lds, PG8_LAS int* itab, const Gemm8 g, const Sched& S, const Epi& E) {
    static_assert(SP2, "gather variant: SP2 schedule only");
    const int tid = threadIdx.x, wid = __builtin_amdgcn_readfirstlane(tid >> 6), lane = tid & 63, wr = wid >> 2, wc = wid & 3, fr = lane & 15, fq = lane >> 4;
    const int K = g.K, nt = K / 128;
    unsigned voffB[2], colA[2]; int rowA[2];
#pragma unroll
    for (int i = 0; i < 2; ++i) { int R, C; stage_rc(tid * 16 + i * 8192, R, C); const int Rb = Epi::PERM ? ((R & ~31) + perm32(R & 31)) : R;
        rowA[i] = R; colA[i] = (unsigned)(C * 2); voffB[i] = (unsigned)(Rb * K + C * 2); }
    unsigned vc[2][2], vn[2][2];
#define PG8_IDX_DMA(u_, buf_) do { if (wid < 4) { const int* lp_ = S.rows_list(u_); \
        __builtin_amdgcn_global_load_lds((const unsigned*)(lp_ + 64 * wid + lane), (PG8_LAS unsigned*)(itab + (buf_) * 256 + 64 * wid), 4, 0, 0); } } while (0)
#define PG8_IDX_READ(dst_, u_, buf_) do { const int nr_ = S.nrows(u_); _Pragma("unroll") for (int h_ = 0; h_ < 2; ++h_) _Pragma("unroll") for (int i_ = 0; i_ < 2; ++i_) { \
        const int r_ = h_ * HALF + rowA[i_]; const int t_ = itab[(buf_) * 256 + r_]; dst_[h_][i_] = (unsigned)((r_ < nr_ ? t_ : 0) * K) + colA[i_]; } } while (0)
    const size_t kstep = (size_t)(BK * 2);
    const size_t hstep = (size_t)HALF * K;
    const size_t tstep = 2 * hstep;
    const unsigned ldsw = (unsigned)wid * 1024u;
    const int aoff = lds_byte(wr * 64 + fr, fq * 8), boff = lds_byte(wc * 32 + fr, fq * 8);
#define PG8_SA(b, h) (((b) * 2 + (h)) * HTB)
#define PG8_SB(b, h) ((4 + (b) * 2 + (h)) * HTB)
#define PG8_STAGE(bufoff, gbase, voff) do { _Pragma("unroll") for (int _i = 0; _i < 2; ++_i) \
        __builtin_amdgcn_global_load_lds((const unsigned*)((const char*)(gbase) + (voff)[_i]), (PG8_LAS unsigned*)(lds + (bufoff) + ldsw + _i * 8192), 16, 0, 0); } while (0)
#define PG8_LD32(p) __builtin_shufflevector(*(const PG8_LAS i32x4*)(p), *(const PG8_LAS i32x4*)((p) + 1024), 0, 1, 2, 3, 4, 5, 6, 7)
#define PG8_LDA(dst, b, h) do { _Pragma("unroll") for (int m = 0; m < 4; ++m) dst[m] = PG8_LD32(lds + PG8_SA(b, h) + aoff + m * 2048); } while (0)
#define PG8_LDB(dst, b, h) do { _Pragma("unroll") for (int n = 0; n < 2; ++n) dst[n] = PG8_LD32(lds + PG8_SB(b, h) + boff + n * 2048); } while (0)
#define PG8_MMA(ai, bj, At, Bt) do { __builtin_amdgcn_s_setprio(1); _Pragma("unroll") for (int m = 0; m < 4; ++m) _Pragma("unroll") for (int n = 0; n < 2; ++n) \
        asm volatile("v_mfma_scale_f32_16x16x128_f8f6f4 %0, %1, %2, %0, %3, %3 op_sel_hi:[0,0,0]" : "+v"(acc[ai][bj][m][n]) : "v"(Bt[n]), "v"(At[m]), "v"(one_scale)); __builtin_amdgcn_s_setprio(0); } while (0)
#define PG8_WAIT_V(n) asm volatile("s_waitcnt vmcnt(" #n ")" ::: "memory")
#define PG8_WAIT_VE(nweak, nstrong, flag) asm volatile("s_waitcnt vmcnt(%0)\n\tv_cmp_ne_u32_e32 vcc, 0, %2\n\ts_nop 3\n\ts_cbranch_vccnz 1f\n\ts_waitcnt vmcnt(%1)\n1:" :: "n"(nweak), "n"(nstrong), "v"(flag) : "memory", "vcc")
#define PG8_WAIT_L(n) asm volatile("s_waitcnt lgkmcnt(" #n ")" ::: "memory")
#define PG8_BAR __builtin_amdgcn_s_barrier()
#define PG8_SCHED __builtin_amdgcn_sched_barrier(0)
    Unit cur, nxt; int ui = 0;
    if (!S.next(0, cur)) return;
    f32x4 acc[2][2][4][2];
#pragma unroll
    for (int a = 0; a < 2; ++a)
#pragma unroll
        for (int b = 0; b < 2; ++b)
#pragma unroll
            for (int m = 0; m < 4; ++m)
#pragma unroll
                for (int n = 0; n < 2; ++n) acc[a][b][m][n] = (f32x4){0.f, 0.f, 0.f, 0.f};
    i32x8 At[4], B0[2], B1[2];
    int one_scale = 0x7f7f7f7f; asm volatile("" : "+v"(one_scale));
    const char* gA = (const char*)g.A; const char* cB = (const char*)g.Bt + (size_t)cur.pn * tstep;
    S.a_ready(cur);
    PG8_IDX_DMA(cur, 0); PG8_WAIT_V(0); PG8_BAR; PG8_IDX_READ(vc, cur, 0);
    if constexpr (SP2) {
        PG8_STAGE(PG8_SB(0, 0), cB, voffB); PG8_STAGE(PG8_SB(0, 1), cB + hstep, voffB); PG8_STAGE(PG8_SA(0, 0), gA, vc[0]); PG8_STAGE(PG8_SA(0, 1), gA, vc[1]);
        if (wr == 1) PG8_BAR;
        PG8_WAIT_V(2); PG8_BAR;
        PG8_STAGE(PG8_SB(1, 0), cB + kstep, voffB); PG8_STAGE(PG8_SA(1, 0), gA + kstep, vc[0]); PG8_STAGE(PG8_SB(1, 1), cB + hstep + kstep, voffB);
        PG8_WAIT_V(6); PG8_BAR;
    }
    for (;;) {
        const bool has_next = S.next(ui + 1, nxt);
        const char* nB = has_next ? (const char*)g.Bt + (size_t)nxt.pn * tstep : cB;
        if (has_next) PG8_IDX_DMA(nxt, (ui + 1) & 1);
_Pragma("unroll 1")
        for (int t = 0; t < nt; t += 2) {
            const bool last = (t == nt - 2);
            const int fe = ((t == 0) && (ui > 0)) ? 1 : 0;
            const char* a1 = gA + (size_t)(t + 1) * kstep;
            const char* a2 = gA + (last ? (size_t)0 : (size_t)(t + 2) * kstep); const char* b2 = last ? nB : cB + (size_t)(t + 2) * kstep;
            const char* a3 = a2 + kstep; const char* b3 = b2 + kstep;
            if (last) { if (has_next) { S.a_ready(nxt); PG8_IDX_READ(vn, nxt, (ui + 1) & 1); } else { _Pragma("unroll") for (int h_ = 0; h_ < 2; ++h_) _Pragma("unroll") for (int i_ = 0; i_ < 2; ++i_) vn[h_][i_] = vc[h_][i_]; } }
            unsigned s0[2], s1[2];
            _Pragma("unroll") for (int i_ = 0; i_ < 2; ++i_) { s0[i_] = last ? vn[0][i_] : vc[0][i_]; s1[i_] = last ? vn[1][i_] : vc[1][i_]; }
            if constexpr (SP2) {
            PG8_LDB(B0, 0, 0); PG8_LDB(B1, 0, 1); PG8_SCHED; PG8_LDA(At, 0, 0); PG8_STAGE(PG8_SA(1, 1), a1, vc[1]);
            PG8_WAIT_VE(8 + Epi::NST, 8, fe); PG8_WAIT_L(0); PG8_BAR; PG8_MMA(0, 0, At, B0); PG8_MMA(0, 1, At, B1); PG8_BAR; PG8_SCHED;
            PG8_LDA(At, 0, 1); PG8_STAGE(PG8_SB(0, 0), b2, voffB); PG8_STAGE(PG8_SB(0, 1), b2 + hstep, voffB); PG8_STAGE(PG8_SA(0, 0), a2, s0);
            PG8_WAIT_VE(8 + Epi::NST, 8, fe); PG8_WAIT_L(0); PG8_BAR; PG8_MMA(1, 0, At, B0); PG8_MMA(1, 1, At, B1); PG8_BAR; PG8_SCHED;
            PG8_LDB(B0, 1, 0); PG8_LDB(B1, 1, 1); PG8_SCHED; PG8_LDA(At, 1, 0); PG8_STAGE(PG8_SA(0, 1), a2, s1);
            PG8_WAIT_V(8); PG8_WAIT_L(0); PG8_BAR; PG8_MMA(0, 0, At, B0); PG8_MMA(0, 1, At, B1); PG8_BAR; PG8_SCHED;
            PG8_LDA(At, 1, 1); PG8_STAGE(PG8_SB(1, 0), b3, voffB); PG8_STAGE(PG8_SB(1, 1), b3 + hstep, voffB); PG8_STAGE(PG8_SA(1, 0), a3, s0);
            PG8_WAIT_V(8); PG8_WAIT_L(0); PG8_BAR; PG8_MMA(1, 0, At, B0); PG8_MMA(1, 1, At, B1); PG8_BAR; PG8_SCHED;
            }
        }
        asm volatile("s_nop 15\n\ts_nop 15" ::: "memory");
        if constexpr (ALIGN_EPI) { if (wr == 0) PG8_BAR; }
        if constexpr (!Epi::AFTER_DRAIN) { E(acc, cur, wr, wc, fr, fq); S.done(cur); }
        if (!has_next) break;
#pragma unroll
        for (int a = 0; a < 2; ++a)
#pragma unroll
            for (int b = 0; b < 2; ++b)
#pragma unroll
                for (int m = 0; m < 4; ++m)
#pragma unroll
                    for (int n = 0; n < 2; ++n) acc[a][b][m][n] = (f32x4){0.f, 0.f, 0.f, 0.f};
        cur = nxt; cB = nB; ++ui;
        _Pragma("unroll") for (int h_ = 0; h_ < 2; ++h_) _Pragma("unroll") for (int i_ = 0; i_ < 2; ++i_) vc[h_][i_] = vn[h_][i_];
        if constexpr (ALIGN_EPI) { if (wr == 1) PG8_BAR; }
    }
    PG8_WAIT_V(0);
    if constexpr (!ALIGN_EPI) { if (wr == 0) PG8_BAR; }
    PG8_BAR;
    if constexpr (Epi::AFTER_DRAIN) { E.fused(acc, cur, wr, wc, fr, fq, lds, wid, lane); S.done(cur); }
#undef PG8_SA
#undef PG8_SB
#undef PG8_STAGE
#undef PG8_IDX_DMA
#undef PG8_IDX_READ
#undef PG8_LD32
#undef PG8_LDA
#undef PG8_LDB
#undef PG8_MMA
#undef PG8_WAIT_V
#undef PG8_WAIT_VE
#undef PG8_WAIT_L
#undef PG8_BAR
#undef PG8_SCHED
}
}
constexpr int NWAVES = 8;
constexpr int BATCH = 4, SEQ = 4096, T = BATCH * SEQ, D = 1024, INW = 6656;
constexpr int C_Q = 0, C_K = 512, C_V = 1024, C_CB = 1536, C_CC = 2048, C_CX = 2560, C_QM = 3072, C_G = 3584;
constexpr int MEMT = 256, MROWS = BATCH * MEMT;
constexpr int NE = 32, FF = 1024, TOPK = 4;
constexpr int MAXTILES = 288, SLOTROWS = MAXTILES * 256;
constexpr float RMS_EPS = 1e-6f;

constexpr size_t MiB = 1u << 20;
constexpr size_t WS_CTL = 0, CTL_ZERO_BYTES = 1 * MiB;
constexpr size_t WS_ROUTE = 1 * MiB;
constexpr size_t WS_WIN = 2 * MiB, WS_WKV = 15 * MiB, WS_WBR = 17 * MiB, WS_WO = 20 * MiB, WS_MEMN = 22 * MiB, WS_KV = 24 * MiB;
constexpr size_t WS_WGU = 26 * MiB, WS_WD = 154 * MiB, WS_XN = 218 * MiB, WS_MERGED = 250 * MiB, WS_Y = 282 * MiB;
constexpr size_t WS_PROJ = 426 * MiB, WS_OBR = 634 * MiB, WS_BO = 682 * MiB, WS_END = 778 * MiB;
constexpr size_t WS_WIN8 = 90 * MiB, WS_XN8 = 100 * MiB;
constexpr size_t WS_HF8 = 426 * MiB, WS_LIST = 458 * MiB;
constexpr size_t WS_SSQ = 460 * MiB;
constexpr size_t WS_XG = 426 * MiB, WS_ACT = 570 * MiB;
static_assert(WS_XG + (size_t)SLOTROWS * 1024 * 2 <= WS_ACT && WS_ACT + (size_t)SLOTROWS * 1024 * 2 <= WS_END, "overlay map");
static_assert(WS_Y + (size_t)SLOTROWS * 1024 * 2 <= WS_PROJ && WS_PROJ + (size_t)T * INW * 2 <= WS_OBR, "d_ws map");
constexpr int CW_BAR = 4096;
constexpr int CW_CNT = 8192;

constexpr int RING_OFF = 0, RING_BYTES = 131072;
constexpr int LDSCTL_OFF = 139264, MISC_OFF = LDSCTL_OFF + 320;
constexpr int TAB_OFF = LDSCTL_OFF + 1024;
constexpr int LDS_BYTES = 147456;

#define GAS __attribute__((address_space(1)))
#define LAS __attribute__((address_space(3)))
typedef unsigned short bf16;
typedef unsigned v4u __attribute__((ext_vector_type(4)));
typedef float f32x4 __attribute__((ext_vector_type(4)));
typedef short bf16x8 __attribute__((ext_vector_type(8)));
typedef GAS unsigned gu32;
typedef GAS unsigned long long gu64;
#define RLX_AGENT __ATOMIC_RELAXED, __HIP_MEMORY_SCOPE_AGENT
#define LDS_WAIT() asm volatile("s_waitcnt lgkmcnt(0)" ::: "memory")
#define VM_WAIT() asm volatile("s_waitcnt vmcnt(0)" ::: "memory")
__device__ __forceinline__ unsigned long long rt() { return __builtin_amdgcn_s_memrealtime(); }
__device__ __forceinline__ unsigned f2bf(float f) { unsigned u = __builtin_bit_cast(unsigned, f); return (u + 0x7fffu + ((u >> 16) & 1u)) >> 16; }
__device__ __forceinline__ unsigned pk2(float lo, float hi) { return f2bf(lo) | (f2bf(hi) << 16); }

#define XB_TMO      128
#define XB_XCNT(j)  (256  + 64 * (j))
#define XB_XSUB(j)  (1280 + 64 * (j))
#define XB_XGEN(j)  (2304 + 64 * (j))
#define XB_TOP      3328
#define XB_TOPGEN   3392
#define XCD_BAR_WORDS 3456
#define XB_SPIN_CAP (1u << 18)

__device__ __forceinline__ unsigned xb_ld(unsigned* p)              { return __hip_atomic_load(p, __ATOMIC_RELAXED, __HIP_MEMORY_SCOPE_AGENT); }
__device__ __forceinline__ unsigned xb_add(unsigned* p, unsigned v) { return __hip_atomic_fetch_add(p, v, __ATOMIC_RELAXED, __HIP_MEMORY_SCOPE_AGENT); }
__device__ __forceinline__ unsigned xb_xcc_id() { return (unsigned)__builtin_amdgcn_s_getreg((3 << 11) | 20) & 0xFu; }
#define XB_SPIN(cond, bar) do { unsigned _sp = 0; while (cond) { __builtin_amdgcn_s_sleep(1); \
    if ((++_sp & 255u) == 0u) { if (xb_ld(&(bar)[XB_TMO])) break; if (_sp > XB_SPIN_CAP) { atomicAdd(&(bar)[XB_TMO], 1u); break; } } } } while (0)

struct XcdBarrier {
    unsigned* bar; unsigned x;
    volatile LAS unsigned* st;
};

__device__ __forceinline__ XcdBarrier xcd_barrier_post(unsigned* bar, volatile LAS unsigned* st) {
    XcdBarrier b; b.bar = bar; b.x = xb_xcc_id(); b.st = st;
    if (threadIdx.x == 0) (void)xb_add(&bar[XB_XCNT(b.x)], 1u);
    return b;
}
__device__ __forceinline__ void xcd_barrier_complete(unsigned* bar, unsigned x, unsigned& nloc, unsigned& nx) {
    const unsigned G = gridDim.x * gridDim.y * gridDim.z;
    unsigned sum, cnt, mine, sp = 0u;
    for (;;) {
        sum = 0u; cnt = 0u; mine = 0u;
#pragma unroll
        for (unsigned j = 0; j < 16; ++j) { const unsigned c = xb_ld(&bar[XB_XCNT(j)]); sum += c; cnt += (c > 0u) ? 1u : 0u; mine = (j == x) ? c : mine; }
        if (sum == G) break;
        __builtin_amdgcn_s_sleep(1);
        if ((++sp & 255u) == 0u) { if (xb_ld(&bar[XB_TMO])) break; if (sp > XB_SPIN_CAP) { atomicAdd(&bar[XB_TMO], 1u); break; } }
    }
    nloc = mine > 0u ? mine : 1u; nx = cnt > 0u ? cnt : 1u;
}

__device__ __forceinline__ void xcd_barrier(const XcdBarrier& b) {
    asm volatile("s_waitcnt vmcnt(0)" ::: "memory");
    __syncthreads();
    if (threadIdx.x == 0) {
        unsigned* bar = b.bar;
        __builtin_amdgcn_s_waitcnt(0);
        unsigned nloc = b.st[0], nx = b.st[1];
        if (nloc == 0u) { xcd_barrier_complete(bar, b.x, nloc, nx); b.st[0] = nloc; b.st[1] = nx; }
        const unsigned old = xb_add(&bar[XB_XSUB(b.x)], 1u);
        const unsigned gen = old / nloc;
        if (old + 1u == (gen + 1u) * nloc) {
            __builtin_amdgcn_fence(__ATOMIC_RELEASE, "agent");
            asm volatile("s_waitcnt vmcnt(0)" ::: "memory");
            const unsigned og = xb_add(&bar[XB_TOP], 1u);
            const unsigned tg = og / nx;
            if (og + 1u == (tg + 1u) * nx) xb_add(&bar[XB_TOPGEN], 1u);
            else XB_SPIN(xb_ld(&bar[XB_TOPGEN]) == tg, bar);
            __builtin_amdgcn_fence(__ATOMIC_ACQUIRE, "agent");
            xb_add(&bar[XB_XGEN(b.x)], 1u);
            asm volatile("s_waitcnt vmcnt(0)" ::: "memory");
        } else {
            XB_SPIN(xb_ld(&bar[XB_XGEN(b.x)]) == gen, bar);
            __builtin_amdgcn_fence(__ATOMIC_ACQUIRE, "agent");
            asm volatile("s_waitcnt vmcnt(0)" ::: "memory");
        }
    }
    __syncthreads();
}

struct Frame {
    LAS unsigned char* lds;
    volatile LAS unsigned* MISC;
    gu32* ctl;
    unsigned char* ws; float* out;
    int tid, lane, wave, vcu, G;
};
typedef const __attribute__((address_space(4))) char* kargp_t;
__device__ __forceinline__ const float* in_ptr(int i) {
    kargp_t kp = (kargp_t)__builtin_amdgcn_kernarg_segment_ptr();
    asm volatile("" : "+s"(kp));
    return *(const float* const __attribute__((address_space(4)))*)(kp + 8 * i);
}
enum { I_X = 0, I_MEM, I_MIXG, I_WIN, I_SBQG, I_SBKG, I_CONVW, I_MEMG, I_WKV, I_MEMQG, I_MEMKG, I_WBRSB, I_WBRCONV, I_WBRMEM, I_WO, I_FFNG, I_WROUTER, I_BROUTER, I_WGU, I_BGU, I_WD, I_BD };
#define WSP(TY, off) ((TY*)(F.ws + (off)))

__device__ __forceinline__ float wave_sum(float v) {
#pragma unroll
    for (int o = 1; o < 64; o <<= 1) v += __shfl_xor(v, o);
    return v;
}
typedef unsigned u32x4s __attribute__((ext_vector_type(4)));
typedef unsigned u32x2s __attribute__((ext_vector_type(2)));
typedef float f32x2s __attribute__((ext_vector_type(2)));
__device__ __forceinline__ float bflo(unsigned w) { return __uint_as_float(w << 16); }
__device__ __forceinline__ float bfhi(unsigned w) { return __uint_as_float(w & 0xffff0000u); }
__device__ __forceinline__ unsigned pk4_fp8(float a, float b, float c, float d) {
    a = fminf(fmaxf(a, -448.f), 448.f); b = fminf(fmaxf(b, -448.f), 448.f); c = fminf(fmaxf(c, -448.f), 448.f); d = fminf(fmaxf(d, -448.f), 448.f);
    int w = __builtin_amdgcn_cvt_pk_fp8_f32(a, b, 0, false);
    w = __builtin_amdgcn_cvt_pk_fp8_f32(c, d, w, true);
    return (unsigned)w;
}

constexpr int CI_IN = 16 * 208, CI_KV = 16 * 32, CI_BR = 8 * 32, CI_O = 16 * 32, CI_SMALL = CI_IN + CI_KV + 3 * CI_BR + CI_O, CI_D = NE * 16 * 32, CI_GU = NE * 16 * 64, CI_ALL = CI_SMALL + CI_D + CI_GU;
__host__ __device__ __forceinline__ bool proj_tile_f8(int pn) { return pn >= 14; }
struct ConvItem { const float* W; bf16* WT; int N, K, k0, n0, dst, f8; };
__device__ __forceinline__ ConvItem conv_decode(Frame& F, int it) {
    ConvItem d; int r = it;
    if (r < CI_IN) { const int kb = r / 208, nb = r % 208, pn = nb >> 3; d.f8 = proj_tile_f8(pn) ? 1 : 0; d.W = in_ptr(I_WIN); d.WT = d.f8 ? (bf16*)WSP(unsigned char, WS_WIN8) : WSP(bf16, WS_WIN); d.N = INW; d.K = 1024; d.k0 = 64 * kb; d.n0 = 32 * nb; d.dst = 32 * nb; return d; } r -= CI_IN;
    if (r < CI_KV) { const int kb = r / 32, nb = r % 32; d.W = in_ptr(I_WKV); d.WT = WSP(bf16, WS_WKV); d.N = 1024; d.K = 1024; d.k0 = 64 * kb; d.n0 = 32 * nb; d.dst = 32 * nb; d.f8 = 0; return d; } r -= CI_KV;
    if (r < 3 * CI_BR) { const int br = r / CI_BR, rr = r % CI_BR, kb = rr / 32, nb = rr % 32; d.W = in_ptr(I_WBRSB + br); d.WT = WSP(bf16, WS_WBR) + (size_t)br * 1024 * 512; d.N = 1024; d.K = 512; d.k0 = 64 * kb; d.n0 = 32 * nb; d.dst = 32 * nb; d.f8 = 0; return d; } r -= 3 * CI_BR;
    if (r < CI_O) { const int kb = r / 32, nb = r % 32; d.W = in_ptr(I_WO); d.WT = WSP(bf16, WS_WO); d.N = 1024; d.K = 1024; d.k0 = 64 * kb; d.n0 = 32 * nb; d.dst = 32 * nb; d.f8 = 0; return d; } r -= CI_O;
    if (r < CI_D) { const int e = r / 512, rr = r % 512, kb = rr / 32, nb = rr % 32; d.W = in_ptr(I_WD) + (size_t)e * 1024 * 1024; d.WT = WSP(bf16, WS_WD); d.N = 1024; d.K = 1024; d.k0 = 64 * kb; d.n0 = 32 * nb; d.dst = e * 1024 + 32 * nb; d.f8 = 1; return d; } r -= CI_D;
    { const int e = r / 1024, rr = r % 1024, kb = rr / 64, nb = rr % 64, n0 = 32 * nb, f0 = n0 & 1023;
      d.W = in_ptr(I_WGU) + (size_t)e * 1024 * 2048; d.WT = WSP(bf16, WS_WGU); d.N = 2048; d.K = 1024; d.k0 = 64 * kb; d.n0 = n0;
      d.dst = e * 2048 + (f0 >> 7) * 256 + (n0 >= 1024 ? 128 : 0) + (f0 & 127); d.f8 = 1; return d; }
}
__device__ __forceinline__ void conv_load(const ConvItem& d, f32x4 (&r)[8], int lane) {
    const GAS f32x4* p = (const GAS f32x4*)((const GAS float*)d.W + (size_t)(d.k0 + 8 * (lane >> 3)) * d.N + d.n0 + 4 * (lane & 7));
    const size_t rstep = (size_t)(d.N >> 2);
#pragma unroll
    for (int i = 0; i < 8; ++i) r[i] = p[i * rstep];
}
__device__ __forceinline__ void conv_finish(const ConvItem& d, const f32x4 (&r)[8], LAS float* scr, int lane) {
    const size_t o0 = (size_t)(d.dst + 4 * (lane & 7)) * d.K + d.k0 + 8 * (lane >> 3);
    if (d.f8) {
        GAS unsigned char* o = (GAS unsigned char*)d.WT + o0;
#pragma unroll
        for (int j = 0; j < 4; ++j) { u32x2s w; w.x = pk4_fp8(r[0][j], r[1][j], r[2][j], r[3][j]); w.y = pk4_fp8(r[4][j], r[5][j], r[6][j], r[7][j]); *(GAS u32x2s*)(o + (size_t)j * d.K) = w; }
    } else {
        GAS bf16* o = (GAS bf16*)d.WT + o0;
#pragma unroll
        for (int j = 0; j < 4; ++j) { v4u w; w.x = pk2(r[0][j], r[1][j]); w.y = pk2(r[2][j], r[3][j]); w.z = pk2(r[4][j], r[5][j]); w.w = pk2(r[6][j], r[7][j]); *(GAS v4u*)(o + (size_t)j * d.K) = w; }
    }
}
constexpr int CONV_DEPTH = 6;
constexpr int G_PROJ = 192;
constexpr int CI_D_P0 = 32 * 512;
__device__ __forceinline__ void conv_items(Frame& F, int first, int last, int gw, int ngw, LAS float* scr) {
    if (first + gw >= last) return;
    const int n = (last - first - gw + ngw - 1) / ngw, base = first + gw;
    f32x4 r[CONV_DEPTH][8];
#pragma unroll
    for (int q = 0; q < CONV_DEPTH; ++q) { const int j = q < n ? q : n - 1; const ConvItem d = conv_decode(F, base + j * ngw); conv_load(d, r[q], F.lane); }
    int j0 = 0;
#pragma unroll 1
    for (; j0 + CONV_DEPTH < n; j0 += CONV_DEPTH) {
#pragma unroll
        for (int q = 0; q < CONV_DEPTH; ++q) {
            { const ConvItem d = conv_decode(F, base + (j0 + q) * ngw); conv_finish(d, r[q], scr, F.lane); }
            { const int jn = j0 + q + CONV_DEPTH, j = jn < n ? jn : n - 1; const ConvItem d = conv_decode(F, base + j * ngw); conv_load(d, r[q], F.lane); }
        }
    }
#pragma unroll
    for (int q = 0; q < CONV_DEPTH; ++q) { const int jq = j0 + q, j = jq < n ? jq : n - 1; const ConvItem d = conv_decode(F, base + j * ngw); conv_finish(d, r[q], scr, F.lane); }
}
__device__ __forceinline__ void rms_rows(Frame& F, int gw, int NGW) {
    const int lane = F.lane;
    const float *px = in_ptr(I_X), *pmixg = in_ptr(I_MIXG), *pmem = in_ptr(I_MEM), *pmemg = in_ptr(I_MEMG);
    int m = gw; if (m >= T + MROWS) return;
    f32x4 v[4];
    { const GAS f32x4* xr = (const GAS f32x4*)(m < T ? px + (size_t)m * D : pmem + (size_t)(m - T) * D) + lane;
#pragma unroll
      for (int j = 0; j < 4; ++j) v[j] = xr[64 * j]; }
#pragma unroll 1
    for (;;) {
        const int mn = m + NGW; const bool has = mn < T + MROWS;
        f32x4 vn[4];
        if (has) { const GAS f32x4* xr = (const GAS f32x4*)(mn < T ? px + (size_t)mn * D : pmem + (size_t)(mn - T) * D) + lane;
#pragma unroll
            for (int j = 0; j < 4; ++j) vn[j] = xr[64 * j]; }
        const GAS f32x4* gr = (const GAS f32x4*)(m < T ? pmixg : pmemg) + lane;
        float s = 0.f;
#pragma unroll
        for (int j = 0; j < 4; ++j) s += (v[j].x * v[j].x + v[j].y * v[j].y) + (v[j].z * v[j].z + v[j].w * v[j].w);
        const float r = 1.f / sqrtf(wave_sum(s) * (1.f / 1024.f) + RMS_EPS);
        bf16* orow = m < T ? WSP(bf16, WS_XN) + (size_t)m * D : WSP(bf16, WS_MEMN) + (size_t)(m - T) * D;
        GAS unsigned long long* o8 = (GAS unsigned long long*)orow + lane;
#pragma unroll
        for (int j = 0; j < 4; ++j) { const f32x4 gg = gr[64 * j]; v[j].x *= r * gg.x; v[j].y *= r * gg.y; v[j].z *= r * gg.z; v[j].w *= r * gg.w;
            o8[64 * j] = (unsigned long long)pk2(v[j].x, v[j].y) | ((unsigned long long)pk2(v[j].z, v[j].w) << 32); }
        if (m < T) { GAS unsigned* o4 = (GAS unsigned*)(WSP(unsigned char, WS_XN8) + (size_t)m * D) + lane;
#pragma unroll
            for (int j = 0; j < 4; ++j) o4[64 * j] = pk4_fp8(v[j].x, v[j].y, v[j].z, v[j].w); }
        if (!has) break;
        m = mn;
#pragma unroll
        for (int j = 0; j < 4; ++j) v[j] = vn[j];
    }
}
__device__ __forceinline__ void p0_prologue(Frame& F, int nconv) {
    LAS float* scr = (LAS float*)(F.lds + RING_OFF + F.wave * 16384);
    const int gw = F.vcu * NWAVES + F.wave, NGW = F.G * NWAVES;
    rms_rows(F, gw, NGW);
    conv_items(F, 0, nconv, gw, NGW, scr);
}

typedef float f32x16 __attribute__((ext_vector_type(16)));
__device__ __forceinline__ float swap_max(float v) { auto rr = __builtin_amdgcn_permlane32_swap(__float_as_uint(v), __float_as_uint(v), false, false); return fmaxf(__uint_as_float(rr[0]), __uint_as_float(rr[1])); }
__device__ __forceinline__ float swap_sum(float v) { auto rr = __builtin_amdgcn_permlane32_swap(__float_as_uint(v), __float_as_uint(v), false, false); return __uint_as_float(rr[0]) + __uint_as_float(rr[1]); }
__device__ __forceinline__ float swap_other(float v) { auto rr = __builtin_amdgcn_permlane32_swap(__float_as_uint(v), __float_as_uint(v), false, false); const float a = __uint_as_float(rr[0]), b = __uint_as_float(rr[1]); return (a + b) - v; }
template <int NS> __device__ __forceinline__ void norm_frags(const v4u (&raw)[NS], bf16x8 (&out)[NS], const float* g, int hi, float inv_n, float post) {
    float ss = 0.f;
#pragma unroll
    for (int s = 0; s < NS; ++s) { const v4u c = raw[s]; const float x0 = bflo(c.x), x1 = bfhi(c.x), x2 = bflo(c.y), x3 = bfhi(c.y), x4 = bflo(c.z), x5 = bfhi(c.z), x6 = bflo(c.w), x7 = bfhi(c.w);
        ss += (x0 * x0 + x1 * x1) + (x2 * x2 + x3 * x3) + (x4 * x4 + x5 * x5) + (x6 * x6 + x7 * x7); }
    ss = swap_sum(ss);
    const float r = post * __builtin_amdgcn_rsqf(ss * inv_n + RMS_EPS);
#pragma unroll
    for (int s = 0; s < NS; ++s) { const v4u c = raw[s]; const f32x4 g0 = *(const GAS f32x4*)(g + 16 * s + 8 * hi), g1 = *(const GAS f32x4*)(g + 16 * s + 8 * hi + 4);
        u32x4s w; w.x = pg8::cvt_pk_bf16(bflo(c.x) * r * g0.x, bfhi(c.x) * r * g0.y); w.y = pg8::cvt_pk_bf16(bflo(c.y) * r * g0.z, bfhi(c.y) * r * g0.w);
        w.z = pg8::cvt_pk_bf16(bflo(c.z) * r * g1.x, bfhi(c.z) * r * g1.y); w.w = pg8::cvt_pk_bf16(bflo(c.w) * r * g1.z, bfhi(c.w) * r * g1.w); out[s] = __builtin_bit_cast(bf16x8, w); }
}
constexpr float SB_EXIT_LOG2 = -32.0f;
constexpr int SB_VROW = 72;
__device__ __forceinline__ void sb_tile(Frame& F, int bh, int qt, bf16* OSB, const float* qg, const float* kg) {
    const int lane = F.lane, r32 = lane & 31, hi = lane >> 5, b = bh >> 3, h = bh & 7;
    LAS unsigned char* vt = F.lds + RING_OFF + F.wave * 16384;
    const bf16* base = WSP(bf16, WS_PROJ) + (size_t)(b * SEQ) * INW + h * 64;
    const int t = qt * 32 + r32;
    bf16x8 qf[4];
    { v4u raw[4]; const bf16* qp = base + (size_t)t * INW + C_Q + 8 * hi;
#pragma unroll
      for (int s = 0; s < 4; ++s) raw[s] = *(const GAS v4u*)(qp + 16 * s);
      norm_frags<4>(raw, qf, qg, hi, 1.f / 64.f, 0.125f * 1.4426950408889634f); }
    f32x16 O[2];
#pragma unroll
    for (int d = 0; d < 2; ++d) O[d] = (f32x16){0.f, 0.f, 0.f, 0.f, 0.f, 0.f, 0.f, 0.f, 0.f, 0.f, 0.f, 0.f, 0.f, 0.f, 0.f, 0.f};
    float carry = 0.f;
    v4u kraw[4], vraw[4], knx[4], vnx[4];
    { const bf16* krow = base + (size_t)(qt * 32 + r32) * INW;
#pragma unroll
      for (int s = 0; s < 4; ++s) { kraw[s] = *(const GAS v4u*)(krow + C_K + 16 * s + 8 * hi); vraw[s] = *(const GAS v4u*)(krow + C_V + 32 * hi + 8 * s); } }
#pragma unroll 1
    for (int kt = qt; kt >= 0; --kt) {
        { const bf16* krow = base + (size_t)((kt > 0 ? kt - 1 : 0) * 32 + r32) * INW;
#pragma unroll
          for (int s = 0; s < 4; ++s) { knx[s] = *(const GAS v4u*)(krow + C_K + 16 * s + 8 * hi); vnx[s] = *(const GAS v4u*)(krow + C_V + 32 * hi + 8 * s); } }
        bf16x8 kf[4];
        norm_frags<4>(kraw, kf, kg, hi, 1.f / 64.f, 1.f);
#pragma unroll
        for (int s = 0; s < 4; ++s) { LAS unsigned short* p = (LAS unsigned short*)(vt + (32 * hi + 8 * s) * SB_VROW + r32 * 2); const v4u v = vraw[s];
            p[0 * (SB_VROW / 2)] = (unsigned short)v.x; p[1 * (SB_VROW / 2)] = (unsigned short)(v.x >> 16); p[2 * (SB_VROW / 2)] = (unsigned short)v.y; p[3 * (SB_VROW / 2)] = (unsigned short)(v.y >> 16);
            p[4 * (SB_VROW / 2)] = (unsigned short)v.z; p[5 * (SB_VROW / 2)] = (unsigned short)(v.z >> 16); p[6 * (SB_VROW / 2)] = (unsigned short)v.w; p[7 * (SB_VROW / 2)] = (unsigned short)(v.w >> 16); }
        f32x16 S = {0.f, 0.f, 0.f, 0.f, 0.f, 0.f, 0.f, 0.f, 0.f, 0.f, 0.f, 0.f, 0.f, 0.f, 0.f, 0.f};
#pragma unroll
        for (int s = 0; s < 4; ++s) S = __builtin_amdgcn_mfma_f32_32x32x16_bf16(kf[s], qf[s], S, 0, 0, 0);
        const bool diag = (kt == qt);
        float ls[16], la[16];
#pragma unroll
        for (int r = 0; r < 16; ++r) {
            const int kr = (r & 3) + 8 * (r >> 2) + 4 * hi;
            const bool valid = !diag || kr < r32;
            const float z = S[r], e = __builtin_amdgcn_exp2f(-fabsf(z)), L = __builtin_amdgcn_logf(1.f + e);
            ls[r] = valid ? -(fmaxf(z, 0.f) + L) : 0.f;
            la[r] = valid ? fminf(z, 0.f) - L : -INFINITY;
        }
        float go[4], gp[4];
#pragma unroll
        for (int g = 0; g < 4; ++g) { go[g] = (ls[4 * g] + ls[4 * g + 1]) + (ls[4 * g + 2] + ls[4 * g + 3]); gp[g] = swap_other(go[g]); }
        float after[4];
        after[3] = (hi == 0) ? gp[3] : 0.f;
#pragma unroll
        for (int g = 2; g >= 0; --g) after[g] = after[g + 1] + go[g + 1] + ((hi == 0) ? gp[g] : gp[g + 1]);
        float w[16];
#pragma unroll
        for (int g = 0; g < 4; ++g) {
            const float b3 = carry + after[g], b2 = b3 + ls[4 * g + 3], b1 = b2 + ls[4 * g + 2], b0 = b1 + ls[4 * g + 1];
            w[4 * g + 3] = __builtin_amdgcn_exp2f(la[4 * g + 3] + b3); w[4 * g + 2] = __builtin_amdgcn_exp2f(la[4 * g + 2] + b2);
            w[4 * g + 1] = __builtin_amdgcn_exp2f(la[4 * g + 1] + b1); w[4 * g] = __builtin_amdgcn_exp2f(la[4 * g] + b0);
        }
        carry += ((go[0] + go[1]) + (go[2] + go[3])) + ((gp[0] + gp[1]) + (gp[2] + gp[3]));
        bf16x8 pb[2];
#pragma unroll
        for (int s2 = 0; s2 < 2; ++s2) { u32x4s u; u.x = pg8::cvt_pk_bf16(w[8 * s2], w[8 * s2 + 1]); u.y = pg8::cvt_pk_bf16(w[8 * s2 + 2], w[8 * s2 + 3]); u.z = pg8::cvt_pk_bf16(w[8 * s2 + 4], w[8 * s2 + 5]); u.w = pg8::cvt_pk_bf16(w[8 * s2 + 6], w[8 * s2 + 7]); pb[s2] = __builtin_bit_cast(bf16x8, u); }
        LDS_WAIT(); asm volatile("" ::: "memory");
#pragma unroll
        for (int d = 0; d < 2; ++d)
#pragma unroll
            for (int s2 = 0; s2 < 2; ++s2) {
                const LAS unsigned char* vp = vt + (32 * d + r32) * SB_VROW + (16 * s2 + 4 * hi) * 2;
                const u32x2s lo = *(const LAS u32x2s*)vp, hh = *(const LAS u32x2s*)(vp + 16);
                u32x4s a; a.x = lo.x; a.y = lo.y; a.z = hh.x; a.w = hh.y;
                O[d] = __builtin_amdgcn_mfma_f32_32x32x16_bf16(__builtin_bit_cast(bf16x8, a), pb[s2], O[d], 0, 0, 0);
            }
        LDS_WAIT(); asm volatile("" ::: "memory");
        if (__all(carry < SB_EXIT_LOG2)) break;
#pragma unroll
        for (int s = 0; s < 4; ++s) { kraw[s] = knx[s]; vraw[s] = vnx[s]; }
    }
    bf16* op = OSB + (size_t)(b * SEQ + t) * 512 + h * 64 + 4 * hi;
#pragma unroll
    for (int d = 0; d < 2; ++d)
#pragma unroll
        for (int g = 0; g < 4; ++g) { u32x2s u; u.x = pk2(O[d][4 * g], O[d][4 * g + 1]); u.y = pk2(O[d][4 * g + 2], O[d][4 * g + 3]); *(GAS u32x2s*)(op + 32 * d + 8 * g) = u; }
}
constexpr int MA_KROW = 272, MA_VROW = 520, MA_VOFF = 256 * MA_KROW;
__device__ __forceinline__ void mem_attn_item(Frame& F, int item, bf16* OMEM, const float* mqg, const float* mkg) {
    const int b = item >> 6, h = (item >> 4) & 3, qblk = item & 15, tid = F.tid, lane = F.lane, r32 = lane & 31, hi = lane >> 5;
    LAS unsigned char* kl = F.lds + RING_OFF; LAS unsigned char* vl = kl + MA_VOFF;
    const bf16* kvb = WSP(bf16, WS_KV) + (size_t)(b * MEMT) * 1024 + h * 128;
    __syncthreads();
#pragma unroll
    for (int i = 0; i < 8; ++i) { const int id = tid + 512 * i, row = id >> 4, c = id & 15;
        const v4u cr = *(const GAS v4u*)(kvb + (size_t)row * 1024 + c * 8);
        const float x0 = bflo(cr.x), x1 = bfhi(cr.x), x2 = bflo(cr.y), x3 = bfhi(cr.y), x4 = bflo(cr.z), x5 = bfhi(cr.z), x6 = bflo(cr.w), x7 = bfhi(cr.w);
        float ss = (x0 * x0 + x1 * x1) + (x2 * x2 + x3 * x3) + (x4 * x4 + x5 * x5) + (x6 * x6 + x7 * x7);
        ss += __shfl_xor(ss, 1); ss += __shfl_xor(ss, 2); ss += __shfl_xor(ss, 4); ss += __shfl_xor(ss, 8);
        const float r = __builtin_amdgcn_rsqf(ss * (1.f / 128.f) + RMS_EPS); const f32x4 g0 = *(const GAS f32x4*)(mkg + 8 * c), g1 = *(const GAS f32x4*)(mkg + 8 * c + 4);
        v4u o; o.x = pk2(x0 * r * g0.x, x1 * r * g0.y); o.y = pk2(x2 * r * g0.z, x3 * r * g0.w); o.z = pk2(x4 * r * g1.x, x5 * r * g1.y); o.w = pk2(x6 * r * g1.z, x7 * r * g1.w);
        *(LAS v4u*)(kl + row * MA_KROW + c * 16) = o; }
#pragma unroll
    for (int i = 0; i < 8; ++i) { const int id = tid + 512 * i, key = id & 255, c = id >> 8;
        const v4u v = *(const GAS v4u*)(kvb + (size_t)key * 1024 + 512 + c * 8); LAS unsigned short* vt = (LAS unsigned short*)(vl + (8 * c) * MA_VROW + key * 2);
        vt[0 * (MA_VROW / 2)] = (unsigned short)v.x; vt[1 * (MA_VROW / 2)] = (unsigned short)(v.x >> 16); vt[2 * (MA_VROW / 2)] = (unsigned short)v.y; vt[3 * (MA_VROW / 2)] = (unsigned short)(v.y >> 16);
        vt[4 * (MA_VROW / 2)] = (unsigned short)v.z; vt[5 * (MA_VROW / 2)] = (unsigned short)(v.z >> 16); vt[6 * (MA_VROW / 2)] = (unsigned short)v.w; vt[7 * (MA_VROW / 2)] = (unsigned short)(v.w >> 16); }
    __syncthreads();
    const int t = b * SEQ + qblk * 256 + F.wave * 32 + r32;
    bf16x8 qf[8];
    { v4u raw[8]; const bf16* qp = WSP(bf16, WS_PROJ) + (size_t)t * INW + C_QM + h * 128 + 8 * hi;
#pragma unroll
      for (int s = 0; s < 8; ++s) raw[s] = *(const GAS v4u*)(qp + 16 * s);
      norm_frags<8>(raw, qf, mqg, hi, 1.f / 128.f, 1.f); }
    const LAS unsigned char* kbase = kl + r32 * MA_KROW + hi * 16;
    float m = -INFINITY;
#pragma unroll 1
    for (int kt = 0; kt < 8; ++kt) {
        f32x16 S = {0.f, 0.f, 0.f, 0.f, 0.f, 0.f, 0.f, 0.f, 0.f, 0.f, 0.f, 0.f, 0.f, 0.f, 0.f, 0.f};
#pragma unroll
        for (int s = 0; s < 8; ++s) S = __builtin_amdgcn_mfma_f32_32x32x16_bf16(*(const LAS bf16x8*)(kbase + kt * 32 * MA_KROW + s * 32), qf[s], S, 0, 0, 0);
#pragma unroll
        for (int r = 0; r < 16; ++r) m = fmaxf(m, S[r]);
    }
    m = swap_max(m);
    const float sc2 = 0.08838834764831845f * 1.4426950408889634f;
    const float msc = m * sc2;
    float l = 0.f; f32x16 O[4];
#pragma unroll
    for (int d = 0; d < 4; ++d) O[d] = (f32x16){0.f, 0.f, 0.f, 0.f, 0.f, 0.f, 0.f, 0.f, 0.f, 0.f, 0.f, 0.f, 0.f, 0.f, 0.f, 0.f};
    const LAS unsigned char* vbase = vl + r32 * MA_VROW + hi * 8;
#pragma unroll 1
    for (int kt = 0; kt < 8; ++kt) {
        f32x16 S = {0.f, 0.f, 0.f, 0.f, 0.f, 0.f, 0.f, 0.f, 0.f, 0.f, 0.f, 0.f, 0.f, 0.f, 0.f, 0.f};
#pragma unroll
        for (int s = 0; s < 8; ++s) S = __builtin_amdgcn_mfma_f32_32x32x16_bf16(*(const LAS bf16x8*)(kbase + kt * 32 * MA_KROW + s * 32), qf[s], S, 0, 0, 0);
        float p[16];
#pragma unroll
        for (int r = 0; r < 16; ++r) { p[r] = __builtin_amdgcn_exp2f(S[r] * sc2 - msc); l += p[r]; }
        bf16x8 pb[2];
#pragma unroll
        for (int s2 = 0; s2 < 2; ++s2) { u32x4s w; w.x = pg8::cvt_pk_bf16(p[8 * s2], p[8 * s2 + 1]); w.y = pg8::cvt_pk_bf16(p[8 * s2 + 2], p[8 * s2 + 3]); w.z = pg8::cvt_pk_bf16(p[8 * s2 + 4], p[8 * s2 + 5]); w.w = pg8::cvt_pk_bf16(p[8 * s2 + 6], p[8 * s2 + 7]); pb[s2] = __builtin_bit_cast(bf16x8, w); }
#pragma unroll
        for (int d = 0; d < 4; ++d)
#pragma unroll
            for (int s2 = 0; s2 < 2; ++s2) {
                const LAS unsigned char* vp = vbase + d * 32 * MA_VROW + (kt * 32 + s2 * 16) * 2;
                const u32x2s lo = *(const LAS u32x2s*)vp, hh = *(const LAS u32x2s*)(vp + 16);
                u32x4s a; a.x = lo.x; a.y = lo.y; a.z = hh.x; a.w = hh.y;
                O[d] = __builtin_amdgcn_mfma_f32_32x32x16_bf16(__builtin_bit_cast(bf16x8, a), pb[s2], O[d], 0, 0, 0);
            }
    }
    l = swap_sum(l); const float inv = 1.f / l;
    bf16* op = OMEM + (size_t)t * 512 + h * 128 + 4 * hi;
#pragma unroll
    for (int d = 0; d < 4; ++d)
#pragma unroll
        for (int g = 0; g < 4; ++g) { u32x2s w; w.x = pk2(O[d][4 * g] * inv, O[d][4 * g + 1] * inv); w.y = pk2(O[d][4 * g + 2] * inv, O[d][4 * g + 3] * inv);
            *(GAS u32x2s*)(op + 32 * d + 8 * g) = w; }
    __syncthreads();
}
__device__ __forceinline__ void conv_item4(Frame& F, int t0, bf16* OCONV, const float* cw) {
    const int lane = F.lane, pos0 = t0 & (SEQ - 1), c0 = lane * 8;
    const bf16* pr = WSP(bf16, WS_PROJ) + (size_t)t0 * INW + c0;
    v4u a[6], x[6], bq[4];
#pragma unroll
    for (int j = 0; j < 6; ++j) { const int d = j - 2;
        if (pos0 + d >= 0) { a[j] = *(const GAS v4u*)(pr + (long)d * INW + C_CC); x[j] = *(const GAS v4u*)(pr + (long)d * INW + C_CX); }
        else { a[j] = (v4u){0u, 0u, 0u, 0u}; x[j] = (v4u){0u, 0u, 0u, 0u}; } }
#pragma unroll
    for (int j = 0; j < 4; ++j) bq[j] = *(const GAS v4u*)(pr + (long)j * INW + C_CB);
    float w0[8], w1[8], w2[8];
#pragma unroll
    for (int i = 0; i < 8; ++i) { w0[i] = cw[c0 + i]; w1[i] = cw[512 + c0 + i]; w2[i] = cw[1024 + c0 + i]; }
    float u[6][8];
#pragma unroll
    for (int j = 0; j < 6; ++j) { u[j][0] = bflo(a[j].x) * bflo(x[j].x); u[j][1] = bfhi(a[j].x) * bfhi(x[j].x); u[j][2] = bflo(a[j].y) * bflo(x[j].y); u[j][3] = bfhi(a[j].y) * bfhi(x[j].y);
        u[j][4] = bflo(a[j].z) * bflo(x[j].z); u[j][5] = bfhi(a[j].z) * bfhi(x[j].z); u[j][6] = bflo(a[j].w) * bflo(x[j].w); u[j][7] = bfhi(a[j].w) * bfhi(x[j].w); }
#pragma unroll
    for (int j = 0; j < 4; ++j) {
        const float cb[8] = {bflo(bq[j].x), bfhi(bq[j].x), bflo(bq[j].y), bfhi(bq[j].y), bflo(bq[j].z), bfhi(bq[j].z), bflo(bq[j].w), bfhi(bq[j].w)};
        float r[8];
#pragma unroll
        for (int i = 0; i < 8; ++i) r[i] = cb[i] * (w0[i] * u[j][i] + w1[i] * u[j + 1][i] + w2[i] * u[j + 2][i]);
        v4u o; o.x = pk2(r[0], r[1]); o.y = pk2(r[2], r[3]); o.z = pk2(r[4], r[5]); o.w = pk2(r[6], r[7]);
        *(GAS v4u*)(OCONV + (size_t)(t0 + j) * 512 + c0) = o;
    }
}
#ifndef MIXREP
#define MIXREP 0
#endif
__device__ __forceinline__ void p2_mixers(Frame& F) {
    bf16* OSB = WSP(bf16, WS_OBR); bf16* OCONV = WSP(bf16, WS_OBR) + (size_t)T * 512; bf16* OMEM = WSP(bf16, WS_OBR) + (size_t)2 * T * 512;
    const int gw = F.vcu * NWAVES + F.wave, NGW = F.G * NWAVES;
    { const float* mqg = in_ptr(I_MEMQG); const float* mkg = in_ptr(I_MEMKG);
      for (int item = F.vcu; item < 256; item += F.G) mem_attn_item(F, item, OMEM, mqg, mkg); }
    { const float* qg = in_ptr(I_SBQG); const float* kg = in_ptr(I_SBKG);
      for (int it = F.vcu; it < BATCH * 128; it += F.G) sb_tile(F, (it >> 7) * 8 + F.wave, it & 127, OSB, qg, kg); }
    { const float* cw = in_ptr(I_CONVW);
      for (int t4 = gw; t4 < T / 4; t4 += NGW) conv_item4(F, t4 * 4, OCONV, cw); }
}

__device__ __forceinline__ void p5_route(Frame& F) {
    const int lane = F.lane, w = F.wave, r32 = lane & 31, hi = lane >> 5, tid = F.tid;
    constexpr int TROW = 516;
    LAS float* tile = (LAS float*)(F.lds + RING_OFF);
    LAS float* part = tile + 32 * TROW;
    LAS int* lcnt = (LAS int*)(part + 8 * 32 * 33);
    LAS int* lbase = lcnt + 32;
    LAS float* r2s = (LAS float*)(lbase + 32);
    const float* wrt = in_ptr(I_WROUTER); const float* fg = in_ptr(I_FFNG); const float be = in_ptr(I_BROUTER)[r32];
    const float* ssqp = WSP(float, WS_SSQ);
    f32x4 gq[4];
#pragma unroll
    for (int j = 0; j < 4; ++j) gq[j] = ((const GAS f32x4*)fg)[lane + 64 * j];
    for (int task = F.vcu; task < T / 32; task += F.G) {
        const int tb = task * 32;
        f32x4 xs[4][4]; float rinv4[4];
#pragma unroll
        for (int rr = 0; rr < 4; ++rr) { const int row = tb + 4 * w + rr; const GAS f32x4* xr = (const GAS f32x4*)(F.out + (size_t)row * D) + lane;
#pragma unroll
            for (int j = 0; j < 4; ++j) xs[rr][j] = xr[64 * j];
            const GAS f32x4* sp = (const GAS f32x4*)(ssqp + (size_t)row * 16); const f32x4 s0 = sp[0], s1 = sp[1], s2 = sp[2], s3 = sp[3];
            const float ss = ((s0.x + s0.y) + (s0.z + s0.w)) + ((s1.x + s1.y) + (s1.z + s1.w)) + ((s2.x + s2.y) + (s2.z + s2.w)) + ((s3.x + s3.y) + (s3.z + s3.w));
            rinv4[rr] = 1.f / sqrtf(ss * (1.f / 1024.f) + RMS_EPS); }
#pragma unroll
        for (int rr = 0; rr < 4; ++rr) { const int row = tb + 4 * w + rr; GAS unsigned* o4 = (GAS unsigned*)(WSP(unsigned char, WS_HF8) + (size_t)row * 1024) + lane; const float ri = rinv4[rr];
#pragma unroll
            for (int j = 0; j < 4; ++j) { xs[rr][j] = xs[rr][j] * gq[j]; o4[64 * j] = pk4_fp8(xs[rr][j].x * ri, xs[rr][j].y * ri, xs[rr][j].z * ri, xs[rr][j].w * ri); }
            if (lane == 0) r2s[4 * w + rr] = ri; }
        f32x16 C = {0.f, 0.f, 0.f, 0.f, 0.f, 0.f, 0.f, 0.f, 0.f, 0.f, 0.f, 0.f, 0.f, 0.f, 0.f, 0.f};
#pragma unroll
        for (int hk = 0; hk < 2; ++hk) {
            if (hk) __syncthreads();
#pragma unroll
            for (int rr = 0; rr < 4; ++rr)
#pragma unroll
                for (int jj = 0; jj < 2; ++jj) *(LAS f32x4*)(tile + (4 * w + rr) * TROW + 4 * (lane + 64 * jj)) = xs[rr][2 * hk + jj];
            __syncthreads();
            const int lc = w * 64 + 32 * hi;
            f32x4 xv[8];
#pragma unroll
            for (int i = 0; i < 8; ++i) xv[i] = *(const LAS f32x4*)(tile + r32 * TROW + lc + 4 * i);
            const GAS float* wp = (const GAS float*)wrt + (size_t)(hk * 512 + lc) * 32 + r32;
#pragma unroll
            for (int st = 0; st < 32; ++st) C = __builtin_amdgcn_mfma_f32_32x32x2f32(wp[st * 32], xv[st >> 2][st & 3], C, 0, 0, 0);
        }
#pragma unroll
        for (int r = 0; r < 16; ++r) part[(w * 32 + (r & 3) + 8 * (r >> 2) + 4 * hi) * 33 + r32] = C[r];
        if (tid < 32) lcnt[tid] = 0;
        __syncthreads();
        int my_e[2], loc[2]; float my_g[2];
#pragma unroll
        for (int u = 0; u < 2; ++u) {
            const int j = 4 * w + 2 * hi + u;
            float lg = 0.f;
#pragma unroll
            for (int ww = 0; ww < 8; ++ww) lg += part[(ww * 32 + r32) * 33 + j];
            float val = lg * r2s[j] + be;
            float tv[4]; int ti[4];
#pragma unroll
            for (int rr = 0; rr < 4; ++rr) {
                float bv = val; int bi = r32;
#define TOPK_DPP(ctrl) do { const float ov = __builtin_bit_cast(float, __builtin_amdgcn_update_dpp(0, __builtin_bit_cast(int, bv), ctrl, 0xf, 0xf, false)); const int oi = __builtin_amdgcn_update_dpp(0, bi, ctrl, 0xf, 0xf, false); \
                    if (ov > bv || (ov == bv && oi < bi)) { bv = ov; bi = oi; } } while (0)
                TOPK_DPP(0xB1); TOPK_DPP(0x4E); TOPK_DPP(0x141); TOPK_DPP(0x140);
#undef TOPK_DPP
                { const float ov = __shfl_xor(bv, 16); const int oi = __shfl_xor(bi, 16); if (ov > bv || (ov == bv && oi < bi)) { bv = ov; bi = oi; } }
                tv[rr] = bv; ti[rr] = bi; if (r32 == bi) val = -INFINITY;
            }
            const float e1 = __expf(tv[1] - tv[0]), e2 = __expf(tv[2] - tv[0]), e3 = __expf(tv[3] - tv[0]); const float inv = 1.f / (1.f + e1 + e2 + e3);
            my_e[u] = r32 == 0 ? ti[0] : (r32 == 1 ? ti[1] : (r32 == 2 ? ti[2] : ti[3]));
            my_g[u] = (r32 == 0 ? 1.f : (r32 == 1 ? e1 : (r32 == 2 ? e2 : e3))) * inv;
            loc[u] = 0;
            if (r32 < 4) loc[u] = __hip_atomic_fetch_add((LAS int*)lcnt + my_e[u], 1, __ATOMIC_RELAXED, __HIP_MEMORY_SCOPE_WORKGROUP);
        }
        __syncthreads();
        if (tid < 32) { const int c = lcnt[tid]; int base = 0;
            if (c > 0) base = (int)__hip_atomic_fetch_add((unsigned*)(F.ctl + CW_CNT + 64 * tid), (unsigned)c, __ATOMIC_RELAXED, __HIP_MEMORY_SCOPE_AGENT);
            lbase[tid] = base; }
        __syncthreads();
        if (r32 < 4) {
#pragma unroll
            for (int u = 0; u < 2; ++u) { const int t = tb + 4 * w + 2 * hi + u; const int pos = lbase[my_e[u]] + loc[u];
                WSP(int, WS_ROUTE)[t * 4 + r32] = my_e[u]; WSP(float, WS_ROUTE + 256 * 1024)[t * 4 + r32] = my_g[u]; WSP(int, WS_ROUTE + 512 * 1024)[t * 4 + r32] = pos;
                WSP(int, WS_LIST)[my_e[u] * 16384 + pos] = t; }
        }
        __syncthreads();
    }
}
__device__ __forceinline__ void moe_table(Frame& F) {
    volatile LAS int* tab = (volatile LAS int*)(F.lds + TAB_OFF);
    if (F.tid < 64) {
        const int e = F.tid & 31;
        const unsigned c = __hip_atomic_load((unsigned*)(F.ctl + CW_CNT + 64 * e), __ATOMIC_RELAXED, __HIP_MEMORY_SCOPE_AGENT);
        const int tiles = (int)((c + 255u) >> 8); int inc = tiles;
#pragma unroll
        for (int o = 1; o < 32; o <<= 1) { const int up = __shfl_up(inc, o, 32); if (e >= o) inc += up; }
        if (F.tid < 32) { tab[e] = inc - tiles; tab[48 + e] = (int)c; if (e == 31) { tab[NE] = inc; tab[40] = inc; } }
    }
    __syncthreads();
}
__device__ __forceinline__ void p8_combine(Frame& F) {
    const int gw = F.vcu * NWAVES + F.wave, NGW = F.G * NWAVES, lane = F.lane;
    typedef int i32x4c __attribute__((ext_vector_type(4)));
    const GAS i32x4c* ridx = (const GAS i32x4c*)WSP(int, WS_ROUTE); const GAS i32x4c* rpos = (const GAS i32x4c*)WSP(int, WS_ROUTE + 512 * 1024); const GAS f32x4* rgate = (const GAS f32x4*)WSP(float, WS_ROUTE + 256 * 1024);
    const volatile LAS int* tab = (const volatile LAS int*)(F.lds + TAB_OFF);
    constexpr int TB = 4;
    for (int t0 = gw * TB; t0 < T; t0 += NGW * TB) {
        i32x4c sl[TB]; f32x4 gt[TB];
#pragma unroll
        for (int i = 0; i < TB; ++i) { const i32x4c e4 = ridx[t0 + i], p4 = rpos[t0 + i]; gt[i] = rgate[t0 + i];
#pragma unroll
            for (int k = 0; k < 4; ++k) sl[i][k] = tab[e4[k]] * 256 + p4[k]; }
        f32x4 v[TB][4]; unsigned y[TB][4][4];
#pragma unroll
        for (int i = 0; i < TB; ++i) { const GAS f32x4* xr = (const GAS f32x4*)(F.out + (size_t)(t0 + i) * D) + lane;
#pragma unroll
            for (int j = 0; j < 4; ++j) v[i][j] = xr[64 * j];
#pragma unroll
            for (int k = 0; k < 4; ++k) { const GAS unsigned* y4 = (const GAS unsigned*)(WSP(unsigned char, WS_Y) + (size_t)sl[i][k] * 1024) + lane;
#pragma unroll
                for (int j = 0; j < 4; ++j) y[i][k][j] = y4[64 * j]; } }
#pragma unroll
        for (int i = 0; i < TB; ++i) { GAS f32x4* xw = (GAS f32x4*)(F.out + (size_t)(t0 + i) * D) + lane;
#pragma unroll
            for (int k = 0; k < 4; ++k) { const float g = gt[i][k];
#pragma unroll
                for (int j = 0; j < 4; ++j) { const unsigned w = y[i][k][j]; const f32x2s lo = __builtin_amdgcn_cvt_pk_f32_fp8(w, false), hi = __builtin_amdgcn_cvt_pk_f32_fp8(w, true);
                    v[i][j].x += g * lo.x; v[i][j].y += g * lo.y; v[i][j].z += g * hi.x; v[i][j].w += g * hi.y; } }
#pragma unroll
            for (int j = 0; j < 4; ++j) xw[64 * j] = v[i][j]; }
    }
}

struct EpiGate {
    static constexpr bool PERM = true, AFTER_DRAIN = false; static constexpr int NST = 16;
    const pg8::bf16_t* gates; pg8::bf16_t* sum;
    __device__ __forceinline__ void operator()(const pg8::f32x4 (&acc)[2][2][4][2], const pg8::Unit& u, int wr, int wc, int fr, int fq) const {
        const int br = u.pn >> 2, col0 = (u.pn & 3) * pg8::BM + wc * 32 + 8 * fq, row0 = (u.pm & 63) * pg8::BM + wr * 64 + fr;
        const pg8::bf16_t* gp = gates + br * 1024;
#pragma unroll
        for (int ai = 0; ai < 2; ++ai)
#pragma unroll
            for (int m = 0; m < 4; ++m) { const size_t row = (size_t)(row0 + ai * pg8::HALF + m * 16);
#pragma unroll
                for (int bj = 0; bj < 2; ++bj) { const int col = col0 + bj * pg8::HALF;
                    const pg8::u32x4 g = *(const pg8::u32x4*)(gp + row * INW + col);
                    pg8::u32x4 p = {0u, 0u, 0u, 0u}; if (br != 0) p = *(const pg8::u32x4*)(sum + row * 1024 + col);
                    const pg8::f32x4 v0 = acc[ai][bj][m][0], v1 = acc[ai][bj][m][1];
                    const float gv[8] = {bflo(g.x), bfhi(g.x), bflo(g.y), bfhi(g.y), bflo(g.z), bfhi(g.z), bflo(g.w), bfhi(g.w)};
                    const float pv[8] = {bflo(p.x), bfhi(p.x), bflo(p.y), bfhi(p.y), bflo(p.z), bfhi(p.z), bflo(p.w), bfhi(p.w)};
                    const float av[8] = {v0[0], v0[1], v0[2], v0[3], v1[0], v1[1], v1[2], v1[3]};
                    float o[8];
#pragma unroll
                    for (int i = 0; i < 8; ++i) o[i] = pv[i] + av[i] * __builtin_amdgcn_rcpf(1.f + __builtin_amdgcn_exp2f(-1.4426950408889634f * gv[i]));
                    pg8::u32x4 w; w.x = pg8::cvt_pk_bf16(o[0], o[1]); w.y = pg8::cvt_pk_bf16(o[2], o[3]); w.z = pg8::cvt_pk_bf16(o[4], o[5]); w.w = pg8::cvt_pk_bf16(o[6], o[7]);
                    *(pg8::u32x4*)(sum + row * 1024 + col) = w; }
                if (m & 1) asm volatile("" ::: "memory"); }
    }
};
struct BranchOrder {
    pg8::StaticOrder so;
    __device__ __forceinline__ bool next(int i, pg8::Unit& u) const {
        pg8::Unit tu; const int tile = i / 3, br = i - 3 * tile; if (!so.next(tile, tu)) return false;
        u.pm = br * (T / 256) + tu.pm; u.pn = br * 4 + tu.pn; return true;
    }
    __device__ __forceinline__ void a_ready(const pg8::Unit&) const {}
    __device__ __forceinline__ void done(const pg8::Unit&) const {}
};
struct EpiResF32 {
    static constexpr bool PERM = false, AFTER_DRAIN = false; static constexpr int NST = 32;
    const float* base; float* out; int ldc; float* ssq;
    __device__ __forceinline__ void operator()(const pg8::f32x4 (&acc)[2][2][4][2], const pg8::Unit& u, int wr, int wc, int fr, int fq) const {
        const int col0 = u.pn * pg8::BM + wc * 32 + 4 * fq;
#pragma unroll
        for (int ai = 0; ai < 2; ++ai)
#pragma unroll
            for (int m = 0; m < 4; ++m) { const int row = u.pm * pg8::BM + ai * pg8::HALF + wr * 64 + m * 16 + fr; const size_t off = (size_t)row * ldc + col0; float sq = 0.f;
#pragma unroll
                for (int bj = 0; bj < 2; ++bj)
#pragma unroll
                    for (int n = 0; n < 2; ++n) { const pg8::f32x4 bs = *(const pg8::f32x4*)(base + off + bj * pg8::HALF + n * 16); const pg8::f32x4 o = bs + acc[ai][bj][m][n];
                        *(pg8::f32x4*)(out + off + bj * pg8::HALF + n * 16) = o; sq += (o[0] * o[0] + o[1] * o[1]) + (o[2] * o[2] + o[3] * o[3]); }
                sq += __shfl_xor(sq, 16); sq += __shfl_xor(sq, 32);
                if (fq == 0) ssq[row * 16 + u.pn * 4 + wc] = sq;
                asm volatile("" ::: "memory"); }
    }
};
struct EpiSwiglu {
    static constexpr bool PERM = true, AFTER_DRAIN = false; static constexpr int NST = 8;
    unsigned char* O; const float* bias;
    __device__ __forceinline__ void operator()(const pg8::f32x4 (&acc)[2][2][4][2], const pg8::Unit& u, int wr, int wc, int fr, int fq) const {
        const int e = u.pn >> 3, pl = u.pn & 7, f0 = pl * 128 + wc * 32 + 8 * fq, row0 = u.pm * pg8::BM + wr * 64 + fr;
        const float* bg = bias + e * 2048 + f0;
        pg8::f32x4 bgv[2], blv[2];
#pragma unroll
        for (int n = 0; n < 2; ++n) { bgv[n] = *(const pg8::f32x4*)(bg + 4 * n); blv[n] = *(const pg8::f32x4*)(bg + 1024 + 4 * n); }
#pragma unroll
        for (int ai = 0; ai < 2; ++ai)
#pragma unroll
            for (int m = 0; m < 4; ++m) { unsigned char* rowp = O + (size_t)(row0 + ai * pg8::HALF + m * 16) * 1024 + f0; float a[8];
#pragma unroll
                for (int n = 0; n < 2; ++n) { const pg8::f32x4 g4 = acc[ai][0][m][n] + bgv[n], l4 = acc[ai][1][m][n] + blv[n];
#pragma unroll
                    for (int j = 0; j < 4; ++j) { const float g = fminf(g4[j], 7.f), l = fminf(fmaxf(l4[j], -7.f), 7.f); a[4 * n + j] = g * (l + 1.f) * __builtin_amdgcn_rcpf(1.f + __builtin_amdgcn_exp2f(-1.702f * 1.4426950408889634f * g)); } }
                u32x2s w; w.x = pk4_fp8(a[0], a[1], a[2], a[3]); w.y = pk4_fp8(a[4], a[5], a[6], a[7]);
                *(u32x2s*)rowp = w; }
    }
};
struct EpiF8Bias {
    static constexpr bool PERM = true, AFTER_DRAIN = false; static constexpr int NST = 16;
    unsigned char* O; int ldc; const float* bias; int split_cols;
    __device__ __forceinline__ void operator()(const pg8::f32x4 (&acc)[2][2][4][2], const pg8::Unit& u, int wr, int wc, int fr, int fq) const {
        const int row0 = u.pm * pg8::BM + wr * 64 + fr; int colt = u.pn * pg8::BM; colt -= (colt / split_cols) * split_cols;
        const int col0 = colt + wc * 32 + 8 * fq, bcol0 = u.pn * pg8::BM + wc * 32 + 8 * fq;
        pg8::f32x4 bv[2][2];
#pragma unroll
        for (int bj = 0; bj < 2; ++bj)
#pragma unroll
            for (int n = 0; n < 2; ++n) bv[bj][n] = *(const pg8::f32x4*)(bias + bcol0 + bj * pg8::HALF + 4 * n);
#pragma unroll
        for (int ai = 0; ai < 2; ++ai)
#pragma unroll
            for (int m = 0; m < 4; ++m) { unsigned char* rowp = O + (size_t)(row0 + ai * pg8::HALF + m * 16) * ldc + col0;
#pragma unroll
                for (int bj = 0; bj < 2; ++bj) { const pg8::f32x4 v0 = acc[ai][bj][m][0] + bv[bj][0], v1 = acc[ai][bj][m][1] + bv[bj][1];
                    u32x2s w; w.x = pk4_fp8(v0[0], v0[1], v0[2], v0[3]); w.y = pk4_fp8(v1[0], v1[1], v1[2], v1[3]); *(u32x2s*)(rowp + bj * pg8::HALF) = w; } }
    }
};
struct PartOrder {
    pg8::StaticOrder so; int f8;
    __device__ __forceinline__ bool next(int i, pg8::Unit& u) const {
        pg8::Unit tu; if (!so.next(i, tu)) return false;
        u.pm = tu.pm; u.pn = f8 ? tu.pn + 14 : tu.pn; return true;
    }
    __device__ __forceinline__ void a_ready(const pg8::Unit&) const {}
    __device__ __forceinline__ void done(const pg8::Unit&) const {}
};
struct MoeOrder {
    const volatile LAS int* tab; int nN, ntiles, G, c; const int* list;
    __device__ __forceinline__ bool next(int i, pg8::Unit& u) const {
        const long L = (long)i * G + c; const int nwg = ntiles * nN; if (L >= (long)nwg) return false;
        int wgid = (int)L; { const int q = nwg / 8, r = nwg % 8, xcd = wgid % 8, off = wgid / 8; wgid = (xcd < r ? xcd * (q + 1) : r * (q + 1) + (xcd - r) * q) + off; }
        const int nig = 8 * nN, gid = wgid / nig, fm = gid * 8, gsz = (ntiles - fm) < 8 ? (ntiles - fm) : 8;
        const int pm = fm + ((wgid % nig) % gsz), pl = (wgid % nig) / gsz;
        const int lj = (int)(threadIdx.x & 63); const int tv = tab[lj & 31];
        const int e = (int)__popcll(__ballot(lj >= 1 && lj < NE && tv <= pm));
        u.pm = __builtin_amdgcn_readfirstlane(pm); u.pn = __builtin_amdgcn_readfirstlane(e * nN + pl); return true;
    }
    __device__ __forceinline__ const int* rows_list(const pg8::Unit& u) const { const int e = u.pn / nN; return list + __builtin_amdgcn_readfirstlane(e * 16384 + (u.pm - tab[e]) * 256); }
    __device__ __forceinline__ int nrows(const pg8::Unit& u) const { const int e = u.pn / nN; return __builtin_amdgcn_readfirstlane(tab[48 + e] - (u.pm - tab[e]) * 256); }
    __device__ __forceinline__ void a_ready(const pg8::Unit&) const {}
    __device__ __forceinline__ void done(const pg8::Unit&) const {}
};

struct Args { const float* in[22]; float* out; unsigned char* ws; int ph_lo, ph_hi; };
__global__ void __launch_bounds__(NWAVES * 64, 2) fwd_kernel(Args args) {
    extern __shared__ __attribute__((aligned(16))) unsigned char lds[];
    Frame F;
    F.lds = (LAS unsigned char*)lds;
    F.MISC = (volatile LAS unsigned*)(F.lds + MISC_OFF);
    F.tid = threadIdx.x; F.lane = F.tid & 63; F.wave = __builtin_amdgcn_readfirstlane(F.tid >> 6);
    F.G = gridDim.x; { const int bx = blockIdx.x; F.vcu = (F.G % 8 == 0) ? (bx % 8) * (F.G / 8) + bx / 8 : bx; }
    F.ws = args.ws; F.out = args.out; F.ctl = (gu32*)(F.ws + WS_CTL);
    for (int u = F.tid; u < (LDS_BYTES - LDSCTL_OFF) / 4; u += NWAVES * 64) ((LAS unsigned*)(F.lds + LDSCTL_OFF))[u] = 0u;
    __syncthreads();
    XcdBarrier bar = xcd_barrier_post((unsigned*)(F.ctl + CW_BAR), F.MISC + 8);
    const int lo = args.ph_lo, hi = args.ph_hi;
#ifndef REPMASK
#define REPMASK 0
#endif
#define IN(k) (lo <= (k) && (k) < hi)
#define NREP(k) (((REPMASK >> (k)) & 1) ? 2 : 1)
#define GRID_BAR() xcd_barrier(bar)

    const bool split = (F.G == 256);
    const int g1 = split ? G_PROJ : F.G;
    if (IN(0)) { p0_prologue(F, split ? CI_SMALL + CI_D_P0 : CI_ALL); GRID_BAR(); }
    if (IN(1)) {
        const bool gemm_role = (int)blockIdx.x < g1;
        if (gemm_role) {
            { pg8::Gemm g{WSP(bf16, WS_XN), WSP(bf16, WS_WIN), T, INW, D}; PartOrder S; S.so.init(T, 14 * 256, g1, (int)blockIdx.x); S.f8 = 0;
              pg8::EpiBf16<0> E{WSP(bf16, WS_PROJ), INW, nullptr, 0, 0, 1.f};
              pg8::gemm_phase<pg8::EpiBf16<0>, PartOrder, true, true>(F.lds + RING_OFF, g, S, E); }
            { pg8::Gemm8 g{WSP(unsigned char, WS_XN8), WSP(unsigned char, WS_WIN8), T, INW, D}; PartOrder S; S.so.init(T, 12 * 256, g1, (int)blockIdx.x); S.f8 = 1;
              pg8::EpiBf16<0> E{WSP(bf16, WS_PROJ), INW, nullptr, 0, 0, 1.f};
              pg8::gemm_phase_f8<pg8::EpiBf16<0>, PartOrder, true, true>(F.lds + RING_OFF, g, S, E); } }
        if (!gemm_role || !split) {
            pg8::Gemm g{WSP(bf16, WS_MEMN), WSP(bf16, WS_WKV), MROWS, 1024, D}; pg8::StaticOrder S; S.init(MROWS, 1024, split ? F.G - g1 : F.G, split ? (int)blockIdx.x - g1 : (int)blockIdx.x);
            pg8::EpiBf16<0> E{WSP(bf16, WS_KV), 1024, nullptr, 0, 0, 1.f};
            pg8::gemm_phase<pg8::EpiBf16<0>, pg8::StaticOrder, true, true>(F.lds + RING_OFF, g, S, E); }
        if (!gemm_role) conv_items(F, CI_SMALL + CI_D_P0, CI_ALL, ((int)blockIdx.x - g1) * NWAVES + F.wave, (F.G - g1) * NWAVES, (LAS float*)(F.lds + RING_OFF + F.wave * 16384));
        GRID_BAR();
    }
    if (IN(3)) { _Pragma("unroll 1") for (int rep = 0; rep < NREP(3); ++rep) { p2_mixers(F); GRID_BAR(); } }
    if (IN(4)) _Pragma("unroll 1") for (int rep = 0; rep < NREP(4); ++rep) {
        pg8::Gemm g{WSP(bf16, WS_OBR), WSP(bf16, WS_WBR), 3 * T, 3 * 1024, 512}; BranchOrder S; S.so.init(T, D, F.G, (int)blockIdx.x);
        EpiGate E{WSP(bf16, WS_PROJ) + C_G, WSP(bf16, WS_MERGED)};
        pg8::gemm_phase<EpiGate, BranchOrder, true, true>(F.lds + RING_OFF, g, S, E);
        GRID_BAR();
    }
    if (IN(6)) _Pragma("unroll 1") for (int rep = 0; rep < NREP(6); ++rep) {
        pg8::Gemm g{WSP(bf16, WS_MERGED), WSP(bf16, WS_WO), T, D, D}; pg8::StaticOrder S; S.init(T, D, F.G, (int)blockIdx.x);
        EpiResF32 E{in_ptr(I_X), F.out, D, WSP(float, WS_SSQ)};
        pg8::gemm_phase<EpiResF32, pg8::StaticOrder, true, true>(F.lds + RING_OFF, g, S, E);
        GRID_BAR();
    }
    if (IN(7)) { p5_route(F); GRID_BAR(); }
    if (IN(9)) _Pragma("unroll 1") for (int rep = 0; rep < NREP(9); ++rep) {
        moe_table(F);
        const volatile LAS int* tab = (const volatile LAS int*)(F.lds + TAB_OFF);
        pg8::Gemm8 g{WSP(unsigned char, WS_HF8), WSP(unsigned char, WS_WGU), T, NE * 2048, D}; MoeOrder S{tab, 8, __builtin_amdgcn_readfirstlane(tab[40]), F.G, (int)blockIdx.x, WSP(int, WS_LIST)};
        EpiSwiglu E{WSP(unsigned char, WS_ACT), in_ptr(I_BGU)};
        pg8::gemm_phase_f8g<EpiSwiglu, MoeOrder, true, true>(F.lds + RING_OFF, (LAS int*)(F.lds + TAB_OFF + 2048), g, S, E);
        GRID_BAR();
    }
    if (IN(10)) _Pragma("unroll 1") for (int rep = 0; rep < NREP(10); ++rep) {
        if (!IN(9)) moe_table(F);
        const volatile LAS int* tab = (const volatile LAS int*)(F.lds + TAB_OFF);
        pg8::Gemm8 g{WSP(unsigned char, WS_ACT), WSP(unsigned char, WS_WD), SLOTROWS, NE * 1024, FF}; MoeOrder S{tab, 4, __builtin_amdgcn_readfirstlane(tab[40]), F.G, (int)blockIdx.x, nullptr};
        EpiF8Bias E{WSP(unsigned char, WS_Y), D, in_ptr(I_BD), 1024};
        pg8::gemm_phase_f8<EpiF8Bias, MoeOrder, true, true>(F.lds + RING_OFF, g, S, E);
        GRID_BAR();
    }
    if (IN(11)) { p8_combine(F); }
#undef IN
#undef GRID_BAR
}

extern "C" void kernel_launch(void* const* d_in, const int* in_sizes, int n_in, void* d_out, int out_size, void* d_ws, size_t ws_size, hipStream_t stream) {
    static int grid = 0;
    if (grid == 0) {
        if (n_in != 22 || out_size != T * D || ws_size < WS_END) { fprintf(stderr, "kernel_launch: unexpected problem (n_in %d, out %d, ws %zu)\n", n_in, out_size, ws_size); grid = -1; return; }
        int dev = 0, cus = 0, per_cu = 0;
        if (hipGetDevice(&dev) != hipSuccess || hipDeviceGetAttribute(&cus, hipDeviceAttributeMultiprocessorCount, dev) != hipSuccess) { grid = -1; return; }
        if (hipFuncSetAttribute((const void*)fwd_kernel, hipFuncAttributeMaxDynamicSharedMemorySize, LDS_BYTES) != hipSuccess) { fprintf(stderr, "kernel_launch: hipFuncSetAttribute failed\n"); grid = -1; return; }
        if (hipOccupancyMaxActiveBlocksPerMultiprocessor(&per_cu, (const void*)fwd_kernel, NWAVES * 64, LDS_BYTES) != hipSuccess || per_cu < 1) { fprintf(stderr, "kernel_launch: occupancy query says %d\n", per_cu); (void)hipGetLastError(); grid = -1; return; }
        grid = cus;
    }
    if (grid < 0) return;
    if (hipMemsetAsync((char*)d_ws + WS_CTL, 0, CTL_ZERO_BYTES, stream) != hipSuccess) { fprintf(stderr, "kernel_launch: memset failed\n"); return; }
    Args a{};
    for (int i = 0; i < 22; ++i) a.in[i] = (const float*)d_in[i];
    a.out = (float*)d_out; a.ws = (unsigned char*)d_ws; a.ph_lo = 0; a.ph_hi = 12;
    void* kargs[] = {&a};
    const hipError_t le = hipLaunchCooperativeKernel((const void*)fwd_kernel, dim3(grid), dim3(NWAVES * 64), kargs, LDS_BYTES, stream);
    if (le != hipSuccess) fprintf(stderr, "kernel_launch: launch failed: %s (grid %d)\n", hipGetErrorName(le), grid);
}
```

```cpp
#define P0_WD_EXPERTS 0
#include <hip/hip_runtime.h>
#include <cstdio>
#include <cstdint>
namespace pg8 {
#define PG8_LAS __attribute__((address_space(3)))
typedef unsigned short bf16_t;
typedef short bf16x8 __attribute__((ext_vector_type(8)));
typedef float f32x4 __attribute__((ext_vector_type(4)));
typedef unsigned u32x4 __attribute__((ext_vector_type(4)));
constexpr int BM = 256, BK = 64, HALF = 128, HTB = HALF * BK * 2  , STAGE_BYTES = 8 * HTB, NXCD = 8, WGM = 8;

__host__ __device__ __forceinline__ int lds_byte(int r, int c) { const int st = (r >> 4) * 2 + (c >> 5), rr = r & 15, cc = c & 31, ob = rr * 64 + cc * 2; return st * 1024 + (ob ^ (((ob >> 9) & 1) << 5)); }
__host__ __device__ __forceinline__ void stage_rc(int b, int& R, int& C) { const int st = b / 1024, sb = b % 1024, swz = sb ^ (((sb >> 9) & 1) << 5); R = (st >> 1) * 16 + swz / 64; C = (st & 1) * 32 + (swz % 64) / 2; }
__host__ __device__ __forceinline__ int perm32(int rho) { const int n = rho >> 4, i = rho & 15; return 8 * (i >> 2) + 4 * n + (i & 3); }

struct Unit { int pm, pn; };
struct Gemm { const bf16_t* A; const bf16_t* Bt; int M, N, K; };

struct StaticOrder {
    int nM, nN, nwg, G, c;
    __host__ __device__ void init(int M, int N, int G_, int c_) { nM = M / BM; nN = N / BM; nwg = nM * nN; G = G_; c = c_; }
    __host__ __device__ bool next(int i, Unit& u) const {
        const long L = (long)i * G + c; if (L >= nwg) return false;
        int wgid = (int)L; { const int q = nwg / NXCD, r = nwg % NXCD, xcd = wgid % NXCD, off = wgid / NXCD; wgid = (xcd < r ? xcd * (q + 1) : r * (q + 1) + (xcd - r) * q) + off; }
        const int nig = WGM * nN, gid = wgid / nig, fm = gid * WGM, gsz = (nM - fm) < WGM ? (nM - fm) : WGM;
        u.pm = fm + ((wgid % nig) % gsz); u.pn = (wgid % nig) / gsz; return true;
    }
    __device__ __forceinline__ void a_ready(const Unit&) const {}
    __device__ __forceinline__ void done(const Unit&) const {}
};

__device__ __forceinline__ unsigned cvt_pk_bf16(float lo, float hi) { unsigned r; asm volatile("v_cvt_pk_bf16_f32 %0, %1, %2" : "=v"(r) : "v"(lo), "v"(hi)); return r; }
typedef float f32x2 __attribute__((ext_vector_type(2)));
__device__ __forceinline__ f32x2 gelu_pk(f32x2 v) {
    const f32x2 av = __builtin_elementwise_abs(v), d = av * 0.2316418882f + 1.0f;
    f32x2 t; t.x = __builtin_amdgcn_rcpf(d.x); t.y = __builtin_amdgcn_rcpf(d.y);
    f32x2 q = t * 0.5307027145f + (-0.7265760135f); q = q * t + 0.7107068705f; q = q * t + (-0.142248368f); q = q * t + 0.127414796f; q = q * t;
    const f32x2 s = (v * v) * (-0.72134752044f);
    f32x2 e; e.x = __builtin_amdgcn_exp2f(s.x); e.y = __builtin_amdgcn_exp2f(s.y);
    const f32x2 m = v * (q * e), r = v - m;
    f32x2 o; o.x = v.x < 0.f ? m.x : r.x; o.y = v.y < 0.f ? m.y : r.y; return o;
}

template <int ACT  > struct EpiBf16 {
    static constexpr int NST = 16;
    static constexpr bool KEEP_ACC = false;
    static constexpr bool PERM = true, AFTER_DRAIN = false; static_assert(ACT == 0 || ACT == 1, "EpiBf16: ACT is 0 (none) or 1 (gelu_pk)");
    bf16_t* O; int ldc; const float* bias; int split_cols; size_t split_stride; float scale0;
    __device__ __forceinline__ void operator()(const f32x4 (&acc)[2][2][4][2], const Unit& u, int wr, int wc, int fr, int fq) const {
        const int row0 = u.pm * BM + wr * 64 + fr; int colt = u.pn * BM; bf16_t* base = O;
        float sc = 1.f; if (split_cols) { const int t = colt / split_cols; base += (size_t)t * split_stride; colt -= t * split_cols; if (t == 0) sc = scale0; }
        const int col0 = colt + wc * 32 + 8 * fq, bcol0 = u.pn * BM + wc * 32 + 8 * fq;
        f32x4 bv[2][2];
#pragma unroll
        for (int bj = 0; bj < 2; ++bj)
#pragma unroll
            for (int n = 0; n < 2; ++n) bv[bj][n] = bias ? *(const f32x4*)(bias + bcol0 + bj * HALF + 4 * n) : (f32x4){0.f, 0.f, 0.f, 0.f};
#pragma unroll
        for (int ai = 0; ai < 2; ++ai)
#pragma unroll
            for (int m = 0; m < 4; ++m) { bf16_t* rowp = base + (size_t)(row0 + ai * HALF + m * 16) * ldc + col0;
#pragma unroll
                for (int bj = 0; bj < 2; ++bj) { f32x4 v0 = acc[ai][bj][m][0] + bv[bj][0], v1 = acc[ai][bj][m][1] + bv[bj][1];
                    if (ACT == 1) { f32x2 a = gelu_pk((f32x2){v0[0], v0[1]}), b = gelu_pk((f32x2){v0[2], v0[3]}), c = gelu_pk((f32x2){v1[0], v1[1]}), d = gelu_pk((f32x2){v1[2], v1[3]});
                        v0 = (f32x4){a.x, a.y, b.x, b.y}; v1 = (f32x4){c.x, c.y, d.x, d.y}; }
                    v0 = v0 * sc; v1 = v1 * sc; u32x4 w; w.x = cvt_pk_bf16(v0[0], v0[1]); w.y = cvt_pk_bf16(v0[2], v0[3]); w.z = cvt_pk_bf16(v1[0], v1[1]); w.w = cvt_pk_bf16(v1[2], v1[3]);
                    *(u32x4*)(rowp + bj * HALF) = w; } }
    }
};
template <class Epi, class Sched, bool ALIGN_EPI = false, bool SP2 = false>
__device__ __forceinline__ void gemm_phase(PG8_LAS unsigned char* lds, const Gemm g, const Sched& S, const Epi& E) {
    const int tid = threadIdx.x, wid = __builtin_amdgcn_readfirstlane(tid >> 6), lane = tid & 63, wr = wid >> 2, wc = wid & 3, fr = lane & 15, fq = lane >> 4;
    const int K = g.K, nt = K / BK;
    unsigned voffA[2], voffB[2];
#pragma unroll
    for (int i = 0; i < 2; ++i) { int R, C; stage_rc(tid * 16 + i * 8192, R, C); const int Rb = Epi::PERM ? ((R & ~31) + perm32(R & 31)) : R;
        voffA[i] = (unsigned)(R * K + C) * 2u; voffB[i] = (unsigned)(Rb * K + C) * 2u; }
    const size_t kstep = (size_t)(BK * 2);
    const size_t hstep = (size_t)HALF * K * 2;
    const size_t tstep = 2 * hstep;
    const unsigned ldsw = (unsigned)wid * 1024u;
    const int aoff = lds_byte(wr * 64 + fr, fq * 8), boff = lds_byte(wc * 32 + fr, fq * 8);
#define PG8_SA(b, h) (((b) * 2 + (h)) * HTB)
#define PG8_SB(b, h) ((4 + (b) * 2 + (h)) * HTB)
#define PG8_STAGE(bufoff, gbase, voff) do { _Pragma("unroll") for (int _i = 0; _i < 2; ++_i) \
        __builtin_amdgcn_global_load_lds((const unsigned*)((const char*)(gbase) + (voff)[_i]), (PG8_LAS unsigned*)(lds + (bufoff) + ldsw + _i * 8192), 16, 0, 0); } while (0)
#define PG8_LDA(dst, b, h) do { _Pragma("unroll") for (int m = 0; m < 4; ++m) _Pragma("unroll") for (int k = 0; k < 2; ++k) dst[m][k] = *(const PG8_LAS bf16x8*)(lds + PG8_SA(b, h) + aoff + m * 2048 + k * 1024); } while (0)
#define PG8_LDB(dst, b, h) do { _Pragma("unroll") for (int n = 0; n < 2; ++n) _Pragma("unroll") for (int k = 0; k < 2; ++k) dst[n][k] = *(const PG8_LAS bf16x8*)(lds + PG8_SB(b, h) + boff + n * 2048 + k * 1024); } while (0)
#define PG8_MMA(ai, bj, At, Bt) do { __builtin_amdgcn_s_setprio(1); _Pragma("unroll") for (int m = 0; m < 4; ++m) _Pragma("unroll") for (int n = 0; n < 2; ++n) _Pragma("unroll") for (int k = 0; k < 2; ++k) \
        acc[ai][bj][m][n] = __builtin_amdgcn_mfma_f32_16x16x32_bf16(Bt[n][k], At[m][k], acc[ai][bj][m][n], 0, 0, 0); __builtin_amdgcn_s_setprio(0); } while (0)
#define PG8_WAIT_V(n) asm volatile("s_waitcnt vmcnt(" #n ")" ::: "memory")
#define PG8_WAIT_VE(nweak, nstrong, flag) asm volatile("s_waitcnt vmcnt(%0)\n\tv_cmp_ne_u32_e32 vcc, 0, %2\n\ts_nop 3\n\ts_cbranch_vccnz 1f\n\ts_waitcnt vmcnt(%1)\n1:" :: "n"(nweak), "n"(nstrong), "v"(flag) : "memory", "vcc")
#define PG8_WAIT_L(n) asm volatile("s_waitcnt lgkmcnt(" #n ")" ::: "memory")
#define PG8_BAR __builtin_amdgcn_s_barrier()
#define PG8_SCHED __builtin_amdgcn_sched_barrier(0)
    Unit cur, nxt; int ui = 0;
    if (!S.next(0, cur)) return;
    f32x4 acc[2][2][4][2];
#pragma unroll
    for (int a = 0; a < 2; ++a)
#pragma unroll
        for (int b = 0; b < 2; ++b)
#pragma unroll
            for (int m = 0; m < 4; ++m)
#pragma unroll
                for (int n = 0; n < 2; ++n) acc[a][b][m][n] = (f32x4){0.f, 0.f, 0.f, 0.f};
    bf16x8 At[4][2], B0[2][2], B1[2][2];
    const char* cA = (const char*)g.A + (size_t)cur.pm * tstep; const char* cB = (const char*)g.Bt + (size_t)cur.pn * tstep;
    S.a_ready(cur);
    if constexpr (SP2) {
        PG8_STAGE(PG8_SB(0, 0), cB, voffB); PG8_STAGE(PG8_SB(0, 1), cB + hstep, voffB); PG8_STAGE(PG8_SA(0, 0), cA, voffA); PG8_STAGE(PG8_SA(0, 1), cA + hstep, voffA);
        if (wr == 1) PG8_BAR;
        PG8_WAIT_V(2); PG8_BAR;
        PG8_STAGE(PG8_SB(1, 0), cB + kstep, voffB); PG8_STAGE(PG8_SA(1, 0), cA + kstep, voffA); PG8_STAGE(PG8_SB(1, 1), cB + hstep + kstep, voffB);
        PG8_WAIT_V(6); PG8_BAR;
    } else {
        PG8_STAGE(PG8_SB(0, 0), cB, voffB); PG8_STAGE(PG8_SA(0, 0), cA, voffA); PG8_STAGE(PG8_SB(0, 1), cB + hstep, voffB); PG8_STAGE(PG8_SA(0, 1), cA + hstep, voffA);
        if (wr == 1) PG8_BAR;
        PG8_WAIT_V(4); PG8_BAR;
        PG8_STAGE(PG8_SB(1, 0), cB + kstep, voffB); PG8_STAGE(PG8_SA(1, 0), cA + kstep, voffA); PG8_STAGE(PG8_SB(1, 1), cB + hstep + kstep, voffB);
        PG8_WAIT_V(6); PG8_BAR;
    }
    for (;;) {
        const bool has_next = S.next(ui + 1, nxt);
        const char* nA = has_next ? (const char*)g.A + (size_t)nxt.pm * tstep : cA; const char* nB = has_next ? (const char*)g.Bt + (size_t)nxt.pn * tstep : cB;
        for (int t = 0; t < nt; t += 2) {
            const bool last = (t == nt - 2);
            const int fe = ((t == 0) && (ui > 0)) ? 1 : 0;
            const char* a1 = cA + (size_t)(t + 1) * kstep;
            const char* a2 = last ? nA : cA + (size_t)(t + 2) * kstep; const char* b2 = last ? nB : cB + (size_t)(t + 2) * kstep;
            const char* a3 = a2 + kstep; const char* b3 = b2 + kstep;
            if (last && has_next) S.a_ready(nxt);
            if constexpr (SP2) {
            PG8_LDB(B0, 0, 0); PG8_LDB(B1, 0, 1); PG8_SCHED; PG8_LDA(At, 0, 0); PG8_STAGE(PG8_SA(1, 1), a1 + hstep, voffA);
            PG8_WAIT_VE(8 + Epi::NST, 8, fe); PG8_WAIT_L(0); PG8_BAR; PG8_MMA(0, 0, At, B0); PG8_MMA(0, 1, At, B1); PG8_BAR; PG8_SCHED;
            PG8_LDA(At, 0, 1); PG8_STAGE(PG8_SB(0, 0), b2, voffB); PG8_STAGE(PG8_SB(0, 1), b2 + hstep, voffB); PG8_STAGE(PG8_SA(0, 0), a2, voffA);
            PG8_WAIT_VE(8 + Epi::NST, 8, fe); PG8_WAIT_L(0); PG8_BAR; PG8_MMA(1, 0, At, B0); PG8_MMA(1, 1, At, B1); PG8_BAR; PG8_SCHED;
            PG8_LDB(B0, 1, 0); PG8_LDB(B1, 1, 1); PG8_SCHED; PG8_LDA(At, 1, 0); PG8_STAGE(PG8_SA(0, 1), a2 + hstep, voffA);
            PG8_WAIT_V(8); PG8_WAIT_L(0); PG8_BAR; PG8_MMA(0, 0, At, B0); PG8_MMA(0, 1, At, B1); PG8_BAR; PG8_SCHED;
            PG8_LDA(At, 1, 1); PG8_STAGE(PG8_SB(1, 0), b3, voffB); PG8_STAGE(PG8_SB(1, 1), b3 + hstep, voffB); PG8_STAGE(PG8_SA(1, 0), a3, voffA);
            PG8_WAIT_V(8); PG8_WAIT_L(0); PG8_BAR; PG8_MMA(1, 0, At, B0); PG8_MMA(1, 1, At, B1); PG8_BAR; PG8_SCHED;
            } else {
            PG8_LDB(B0, 0, 0); PG8_SCHED; PG8_LDA(At, 0, 0); PG8_STAGE(PG8_SA(1, 1), a1 + hstep, voffA);
            PG8_WAIT_L(8); PG8_BAR; PG8_WAIT_L(0); PG8_MMA(0, 0, At, B0); PG8_BAR; PG8_SCHED;
            PG8_LDB(B1, 0, 1); PG8_STAGE(PG8_SB(0, 0), b2, voffB);
            PG8_BAR; PG8_WAIT_L(0); PG8_MMA(0, 1, At, B1); PG8_BAR;
            PG8_LDA(At, 0, 1); PG8_STAGE(PG8_SA(0, 0), a2, voffA);
            PG8_BAR; PG8_WAIT_L(0); PG8_MMA(1, 0, At, B0); PG8_BAR; PG8_SCHED;
            PG8_STAGE(PG8_SB(0, 1), b2 + hstep, voffB);
            PG8_WAIT_V(6); PG8_BAR; PG8_MMA(1, 1, At, B1); PG8_BAR;
            PG8_LDB(B0, 1, 0); PG8_SCHED; PG8_LDA(At, 1, 0); PG8_STAGE(PG8_SA(0, 1), a2 + hstep, voffA);
            PG8_WAIT_L(8); PG8_BAR; PG8_WAIT_L(0); PG8_MMA(0, 0, At, B0); PG8_BAR; PG8_SCHED;
            PG8_LDB(B1, 1, 1); PG8_STAGE(PG8_SB(1, 0), b3, voffB);
            PG8_BAR; PG8_WAIT_L(0); PG8_MMA(0, 1, At, B1); PG8_BAR;
            PG8_LDA(At, 1, 1); PG8_STAGE(PG8_SA(1, 0), a3, voffA);
            PG8_BAR; PG8_WAIT_L(0); PG8_MMA(1, 0, At, B0); PG8_BAR; PG8_SCHED;
            PG8_STAGE(PG8_SB(1, 1), b3 + hstep, voffB);
            PG8_WAIT_V(6); PG8_BAR; PG8_MMA(1, 1, At, B1); PG8_BAR;
            }
        }
        if constexpr (ALIGN_EPI) { if (wr == 0) PG8_BAR; }
        if constexpr (!Epi::AFTER_DRAIN) { E(acc, cur, wr, wc, fr, fq); S.done(cur); }
        if (!has_next) break;
        bool carry = false; if constexpr (Epi::KEEP_ACC) carry = E.keep_acc(cur);
        if (!carry) {
#pragma unroll
        for (int a = 0; a < 2; ++a)
#pragma unroll
            for (int b = 0; b < 2; ++b)
#pragma unroll
                for (int m = 0; m < 4; ++m)
#pragma unroll
                    for (int n = 0; n < 2; ++n) acc[a][b][m][n] = (f32x4){0.f, 0.f, 0.f, 0.f};
        }
        cur = nxt; cA = nA; cB = nB; ++ui;
        if constexpr (ALIGN_EPI) { if (wr == 1) PG8_BAR; }
    }
    PG8_WAIT_V(0);
    if constexpr (!ALIGN_EPI) { if (wr == 0) PG8_BAR; }
    PG8_BAR;
    if constexpr (Epi::AFTER_DRAIN) { E.fused(acc, cur, wr, wc, fr, fq, lds, wid, lane); S.done(cur); }
#undef PG8_SA
#undef PG8_SB
#undef PG8_STAGE
#undef PG8_LDA
#undef PG8_LDB
#undef PG8_MMA
#undef PG8_WAIT_V
#undef PG8_WAIT_VE
#undef PG8_WAIT_L
#undef PG8_BAR
#undef PG8_SCHED
}
}

#ifndef PG8_SP2
#define PG8_SP2 true
#endif
#ifndef PG8_ALIGN
#define PG8_ALIGN true
#endif
namespace pg8 {
typedef int i32x4 __attribute__((ext_vector_type(4)));
typedef int i32x8 __attribute__((ext_vector_type(8)));
struct Gemm8 { const unsigned char* A; const unsigned char* Bt; int M, N, K; };
template <class Epi, class Sched, bool ALIGN_EPI = false, bool SP2 = false>
__device__ __forceinline__ void gemm_phase_f8(PG8_LAS unsigned char* lds, const Gemm8 g, const Sched& S, const Epi& E) {
    const int tid = threadIdx.x, wid = __builtin_amdgcn_readfirstlane(tid >> 6), lane = tid & 63, wr = wid >> 2, wc = wid & 3, fr = lane & 15, fq = lane >> 4;
    const int K = g.K, nt = K / 128;
    unsigned voffA[2], voffB[2];
#pragma unroll
    for (int i = 0; i < 2; ++i) { int R, C; stage_rc(tid * 16 + i * 8192, R, C); const int Rb = Epi::PERM ? ((R & ~31) + perm32(R & 31)) : R;
        voffA[i] = (unsigned)(R * K + C * 2); voffB[i] = (unsigned)(Rb * K + C * 2); }
    const size_t kstep = (size_t)(BK * 2);
    const size_t hstep = (size_t)HALF * K;
    const size_t tstep = 2 * hstep;
    const unsigned ldsw = (unsigned)wid * 1024u;
    const int aoff = lds_byte(wr * 64 + fr, fq * 8), boff = lds_byte(wc * 32 + fr, fq * 8);
#define PG8_SA(b, h) (((b) * 2 + (h)) * HTB)
#define PG8_SB(b, h) ((4 + (b) * 2 + (h)) * HTB)
#define PG8_STAGE(bufoff, gbase, voff) do { _Pragma("unroll") for (int _i = 0; _i < 2; ++_i) \
        __builtin_amdgcn_global_load_lds((const unsigned*)((const char*)(gbase) + (voff)[_i]), (PG8_LAS unsigned*)(lds + (bufoff) + ldsw + _i * 8192), 16, 0, 0); } while (0)
#define PG8_LD32(p) __builtin_shufflevector(*(const PG8_LAS i32x4*)(p), *(const PG8_LAS i32x4*)((p) + 1024), 0, 1, 2, 3, 4, 5, 6, 7)
#define PG8_LDA(dst, b, h) do { _Pragma("unroll") for (int m = 0; m < 4; ++m) dst[m] = PG8_LD32(lds + PG8_SA(b, h) + aoff + m * 2048); } while (0)
#define PG8_LDB(dst, b, h) do { _Pragma("unroll") for (int n = 0; n < 2; ++n) dst[n] = PG8_LD32(lds + PG8_SB(b, h) + boff + n * 2048); } while (0)
#define PG8_MMA(ai, bj, At, Bt) do { __builtin_amdgcn_s_setprio(1); _Pragma("unroll") for (int m = 0; m < 4; ++m) _Pragma("unroll") for (int n = 0; n < 2; ++n) \
        asm volatile("v_mfma_scale_f32_16x16x128_f8f6f4 %0, %1, %2, %0, %3, %3 op_sel_hi:[0,0,0]" : "+v"(acc[ai][bj][m][n]) : "v"(Bt[n]), "v"(At[m]), "v"(one_scale)); __builtin_amdgcn_s_setprio(0); } while (0)
#define PG8_WAIT_V(n) asm volatile("s_waitcnt vmcnt(" #n ")" ::: "memory")
#define PG8_WAIT_VE(nweak, nstrong, flag) asm volatile("s_waitcnt vmcnt(%0)\n\tv_cmp_ne_u32_e32 vcc, 0, %2\n\ts_nop 3\n\ts_cbranch_vccnz 1f\n\ts_waitcnt vmcnt(%1)\n1:" :: "n"(nweak), "n"(nstrong), "v"(flag) : "memory", "vcc")
#define PG8_WAIT_L(n) asm volatile("s_waitcnt lgkmcnt(" #n ")" ::: "memory")
#define PG8_BAR __builtin_amdgcn_s_barrier()
#define PG8_SCHED __builtin_amdgcn_sched_barrier(0)
    Unit cur, nxt; int ui = 0;
    if (!S.next(0, cur)) return;
    f32x4 acc[2][2][4][2];
#pragma unroll
    for (int a = 0; a < 2; ++a)
#pragma unroll
        for (int b = 0; b < 2; ++b)
#pragma unroll
            for (int m = 0; m < 4; ++m)
#pragma unroll
                for (int n = 0; n < 2; ++n) acc[a][b][m][n] = (f32x4){0.f, 0.f, 0.f, 0.f};
    i32x8 At[4], B0[2], B1[2];
    int one_scale = 0x7f7f7f7f; asm volatile("" : "+v"(one_scale));
    const char* cA = (const char*)g.A + (size_t)cur.pm * tstep; const char* cB = (const char*)g.Bt + (size_t)cur.pn * tstep;
    S.a_ready(cur);
    if constexpr (SP2) {
        PG8_STAGE(PG8_SB(0, 0), cB, voffB); PG8_STAGE(PG8_SB(0, 1), cB + hstep, voffB); PG8_STAGE(PG8_SA(0, 0), cA, voffA); PG8_STAGE(PG8_SA(0, 1), cA + hstep, voffA);
        if (wr == 1) PG8_BAR;
        PG8_WAIT_V(2); PG8_BAR;
        PG8_STAGE(PG8_SB(1, 0), cB + kstep, voffB); PG8_STAGE(PG8_SA(1, 0), cA + kstep, voffA); PG8_STAGE(PG8_SB(1, 1), cB + hstep + kstep, voffB);
        PG8_WAIT_V(6); PG8_BAR;
    } else {
        PG8_STAGE(PG8_SB(0, 0), cB, voffB); PG8_STAGE(PG8_SA(0, 0), cA, voffA); PG8_STAGE(PG8_SB(0, 1), cB + hstep, voffB); PG8_STAGE(PG8_SA(0, 1), cA + hstep, voffA);
        if (wr == 1) PG8_BAR;
        PG8_WAIT_V(4); PG8_BAR;
        PG8_STAGE(PG8_SB(1, 0), cB + kstep, voffB); PG8_STAGE(PG8_SA(1, 0), cA + kstep, voffA); PG8_STAGE(PG8_SB(1, 1), cB + hstep + kstep, voffB);
        PG8_WAIT_V(6); PG8_BAR;
    }
    for (;;) {
        const bool has_next = S.next(ui + 1, nxt);
        const char* nA = has_next ? (const char*)g.A + (size_t)nxt.pm * tstep : cA; const char* nB = has_next ? (const char*)g.Bt + (size_t)nxt.pn * tstep : cB;
_Pragma("unroll 1")
        for (int t = 0; t < nt; t += 2) {
            const bool last = (t == nt - 2);
            const int fe = ((t == 0) && (ui > 0)) ? 1 : 0;
            const char* a1 = cA + (size_t)(t + 1) * kstep;
            const char* a2 = last ? nA : cA + (size_t)(t + 2) * kstep; const char* b2 = last ? nB : cB + (size_t)(t + 2) * kstep;
            const char* a3 = a2 + kstep; const char* b3 = b2 + kstep;
            if (last && has_next) S.a_ready(nxt);
            if constexpr (SP2) {
            PG8_LDB(B0, 0, 0); PG8_LDB(B1, 0, 1); PG8_SCHED; PG8_LDA(At, 0, 0); PG8_STAGE(PG8_SA(1, 1), a1 + hstep, voffA);
            PG8_WAIT_VE(8 + Epi::NST, 8, fe); PG8_WAIT_L(0); PG8_BAR; PG8_MMA(0, 0, At, B0); PG8_MMA(0, 1, At, B1); PG8_BAR; PG8_SCHED;
            PG8_LDA(At, 0, 1); PG8_STAGE(PG8_SB(0, 0), b2, voffB); PG8_STAGE(PG8_SB(0, 1), b2 + hstep, voffB); PG8_STAGE(PG8_SA(0, 0), a2, voffA);
            PG8_WAIT_VE(8 + Epi::NST, 8, fe); PG8_WAIT_L(0); PG8_BAR; PG8_MMA(1, 0, At, B0); PG8_MMA(1, 1, At, B1); PG8_BAR; PG8_SCHED;
            PG8_LDB(B0, 1, 0); PG8_LDB(B1, 1, 1); PG8_SCHED; PG8_LDA(At, 1, 0); PG8_STAGE(PG8_SA(0, 1), a2 + hstep, voffA);
            PG8_WAIT_V(8); PG8_WAIT_L(0); PG8_BAR; PG8_MMA(0, 0, At, B0); PG8_MMA(0, 1, At, B1); PG8_BAR; PG8_SCHED;
            PG8_LDA(At, 1, 1); PG8_STAGE(PG8_SB(1, 0), b3, voffB); PG8_STAGE(PG8_SB(1, 1), b3 + hstep, voffB); PG8_STAGE(PG8_SA(1, 0), a3, voffA);
            PG8_WAIT_V(8); PG8_WAIT_L(0); PG8_BAR; PG8_MMA(1, 0, At, B0); PG8_MMA(1, 1, At, B1); PG8_BAR; PG8_SCHED;
            } else {
            PG8_LDB(B0, 0, 0); PG8_SCHED; PG8_LDA(At, 0, 0); PG8_STAGE(PG8_SA(1, 1), a1 + hstep, voffA);
            PG8_WAIT_L(8); PG8_BAR; PG8_WAIT_L(0); PG8_MMA(0, 0, At, B0); PG8_BAR; PG8_SCHED;
            PG8_LDB(B1, 0, 1); PG8_STAGE(PG8_SB(0, 0), b2, voffB);
            PG8_BAR; PG8_WAIT_L(0); PG8_MMA(0, 1, At, B1); PG8_BAR;
            PG8_LDA(At, 0, 1); PG8_STAGE(PG8_SA(0, 0), a2, voffA);
            PG8_BAR; PG8_WAIT_L(0); PG8_MMA(1, 0, At, B0); PG8_BAR; PG8_SCHED;
            PG8_STAGE(PG8_SB(0, 1), b2 + hstep, voffB);
            PG8_WAIT_V(6); PG8_BAR; PG8_MMA(1, 1, At, B1); PG8_BAR;
            PG8_LDB(B0, 1, 0); PG8_SCHED; PG8_LDA(At, 1, 0); PG8_STAGE(PG8_SA(0, 1), a2 + hstep, voffA);
            PG8_WAIT_L(8); PG8_BAR; PG8_WAIT_L(0); PG8_MMA(0, 0, At, B0); PG8_BAR; PG8_SCHED;
            PG8_LDB(B1, 1, 1); PG8_STAGE(PG8_SB(1, 0), b3, voffB);
            PG8_BAR; PG8_WAIT_L(0); PG8_MMA(0, 1, At, B1); PG8_BAR;
            PG8_LDA(At, 1, 1); PG8_STAGE(PG8_SA(1, 0), a3, voffA);
            PG8_BAR; PG8_WAIT_L(0); PG8_MMA(1, 0, At, B0); PG8_BAR; PG8_SCHED;
            PG8_STAGE(PG8_SB(1, 1), b3 + hstep, voffB);
            PG8_WAIT_V(6); PG8_BAR; PG8_MMA(1, 1, At, B1); PG8_BAR;
            }
        }
        asm volatile("s_nop 15\n\ts_nop 15" ::: "memory");
        if constexpr (ALIGN_EPI) { if (wr == 0) PG8_BAR; }
        if constexpr (!Epi::AFTER_DRAIN) { E(acc, cur, wr, wc, fr, fq); S.done(cur); }
        if (!has_next) break;
#pragma unroll
        for (int a = 0; a < 2; ++a)
#pragma unroll
            for (int b = 0; b < 2; ++b)
#pragma unroll
                for (int m = 0; m < 4; ++m)
#pragma unroll
                    for (int n = 0; n < 2; ++n) acc[a][b][m][n] = (f32x4){0.f, 0.f, 0.f, 0.f};
        cur = nxt; cA = nA; cB = nB; ++ui;
        if constexpr (ALIGN_EPI) { if (wr == 1) PG8_BAR; }
    }
    PG8_WAIT_V(0);
    if constexpr (!ALIGN_EPI) { if (wr == 0) PG8_BAR; }
    PG8_BAR;
    if constexpr (Epi::AFTER_DRAIN) { E.fused(acc, cur, wr, wc, fr, fq, lds, wid, lane); S.done(cur); }
#undef PG8_SA
#undef PG8_SB
#undef PG8_STAGE
#undef PG8_LD32
#undef PG8_LDA
#undef PG8_LDB
#undef PG8_MMA
#undef PG8_WAIT_V
#undef PG8_WAIT_VE
#undef PG8_WAIT_L
#undef PG8_BAR
#undef PG8_SCHED
}
}
namespace pg8 {
template <class Epi, class Sched, bool ALIGN_EPI = false, bool SP2 = true>
__device__ __forceinline__ void gemm_phase_f8g(PG8_LAS unsigned char* lds, PG8_LAS int* itab, const Gemm8 g, const Sched& S, const Epi& E) {
    static_assert(SP2, "gather variant: SP2 schedule only");
    const int tid = threadIdx.x, wid = __builtin_amdgcn_readfirstlane(tid >> 6), lane = tid & 63, wr = wid >> 2, wc = wid & 3, fr = lane & 15, fq = lane >> 4;
    const int K = g.K, nt = K / 128;
    unsigned voffB[2], colA[2]; int rowA[2];
#pragma unroll
    for (int i = 0; i < 2; ++i) { int R, C; stage_rc(tid * 16 + i * 8192, R, C); const int Rb = Epi::PERM ? ((R & ~31) + perm32(R & 31)) : R;
        rowA[i] = R; colA[i] = (unsigned)(C * 2); voffB[i] = (unsigned)(Rb * K + C * 2); }
    unsigned vc[2][2], vn[2][2];
#define PG8_IDX_DMA(u_, buf_) do { if (wid < 4) { const int* lp_ = S.rows_list(u_); \
        __builtin_amdgcn_global_load_lds((const unsigned*)(lp_ + 64 * wid + lane), (PG8_LAS unsigned*)(itab + (buf_) * 256 + 64 * wid), 4, 0, 0); } } while (0)
#define PG8_IDX_READ(dst_, u_, buf_) do { const int nr_ = S.nrows(u_); _Pragma("unroll") for (int h_ = 0; h_ < 2; ++h_) _Pragma("unroll") for (int i_ = 0; i_ < 2; ++i_) { \
        const int r_ = h_ * HALF + rowA[i_]; const int t_ = itab[(buf_) * 256 + r_]; dst_[h_][i_] = (unsigned)((r_ < nr_ ? t_ : 0) * K) + colA[i_]; } } while (0)
    const size_t kstep = (size_t)(BK * 2);
    const size_t hstep = (size_t)HALF * K;
    const size_t tstep = 2 * hstep;
    const unsigned ldsw = (unsigned)wid * 1024u;
    const int aoff = lds_byte(wr * 64 + fr, fq * 8), boff = lds_byte(wc * 32 + fr, fq * 8);
#define PG8_SA(b, h) (((b) * 2 + (h)) * HTB)
#define PG8_SB(b, h) ((4 + (b) * 2 + (h)) * HTB)
#define PG8_STAGE(bufoff, gbase, voff) do { _Pragma("unroll") for (int _i = 0; _i < 2; ++_i) \
        __builtin_amdgcn_global_load_lds((const unsigned*)((const char*)(gbase) + (voff)[_i]), (PG8_LAS unsigned*)(lds + (bufoff) + ldsw + _i * 8192), 16, 0, 0); } while (0)
#define PG8_LD32(p) __builtin_shufflevector(*(const PG8_LAS i32x4*)(p), *(const PG8_LAS i32x4*)((p) + 1024), 0, 1, 2, 3, 4, 5, 6, 7)
#define PG8_LDA(dst, b, h) do { _Pragma("unroll") for (int m = 0; m < 4; ++m) dst[m] = PG8_LD32(lds + PG8_SA(b, h) + aoff + m * 2048); } while (0)
#define PG8_LDB(dst, b, h) do { _Pragma("unroll") for (int n = 0; n < 2; ++n) dst[n] = PG8_LD32(lds + PG8_SB(b, h) + boff + n * 2048); } while (0)
#define PG8_MMA(ai, bj, At, Bt) do { __builtin_amdgcn_s_setprio(1); _Pragma("unroll") for (int m = 0; m < 4; ++m) _Pragma("unroll") for (int n = 0; n < 2; ++n) \
        asm volatile("v_mfma_scale_f32_16x16x128_f8f6f4 %0, %1, %2, %0, %3, %3 op_sel_hi:[0,0,0]" : "+v"(acc[ai][bj][m][n]) : "v"(Bt[n]), "v"(At[m]), "v"(one_scale)); __builtin_amdgcn_s_setprio(0); } while (0)
#define PG8_WAIT_V(n) asm volatile("s_waitcnt vmcnt(" #n ")" ::: "memory")
#define PG8_WAIT_VE(nweak, nstrong, flag) asm volatile("s_waitcnt vmcnt(%0)\n\tv_cmp_ne_u32_e32 vcc, 0, %2\n\ts_nop 3\n\ts_cbranch_vccnz 1f\n\ts_waitcnt vmcnt(%1)\n1:" :: "n"(nweak), "n"(nstrong), "v"(flag) : "memory", "vcc")
#define PG8_WAIT_L(n) asm volatile("s_waitcnt lgkmcnt(" #n ")" ::: "memory")
#define PG8_BAR __builtin_amdgcn_s_barrier()
#define PG8_SCHED __builtin_amdgcn_sched_barrier(0)
    Unit cur, nxt; int ui = 0;
    if (!S.next(0, cur)) return;
    f32x4 acc[2][2][4][2];
#pragma unroll
    for (int a = 0; a < 2; ++a)
#pragma unroll
        for (int b = 0; b < 2; ++b)
#pragma unroll
            for (int m = 0; m < 4; ++m)
#pragma unroll
                for (int n = 0; n < 2; ++n) acc[a][b][m][n] = (f32x4){0.f, 0.f, 0.f, 0.f};
    i32x8 At[4], B0[2], B1[2];
    int one_scale = 0x7f7f7f7f; asm volatile("" : "+v"(one_scale));
    const char* gA = (const char*)g.A; const char* cB = (const char*)g.Bt + (size_t)cur.pn * tstep;
    S.a_ready(cur);
    PG8_IDX_DMA(cur, 0); PG8_WAIT_V(0); PG8_BAR; PG8_IDX_READ(vc, cur, 0);
    if constexpr (SP2) {
        PG8_STAGE(PG8_SB(0, 0), cB, voffB); PG8_STAGE(PG8_SB(0, 1), cB + hstep, voffB); PG8_STAGE(PG8_SA(0, 0), gA, vc[0]); PG8_STAGE(PG8_SA(0, 1), gA, vc[1]);
        if (wr == 1) PG8_BAR;
        PG8_WAIT_V(2); PG8_BAR;
        PG8_STAGE(PG8_SB(1, 0), cB + kstep, voffB); PG8_STAGE(PG8_SA(1, 0), gA + kstep, vc[0]); PG8_STAGE(PG8_SB(1, 1), cB + hstep + kstep, voffB);
        PG8_WAIT_V(6); PG8_BAR;
    }
    for (;;) {
        const bool has_next = S.next(ui + 1, nxt);
        const char* nB = has_next ? (const char*)g.Bt + (size_t)nxt.pn * tstep : cB;
        if (has_next) PG8_IDX_DMA(nxt, (ui + 1) & 1);
_Pragma("unroll 1")
        for (int t = 0; t < nt; t += 2) {
            const bool last = (t == nt - 2);
            const int fe = ((t == 0) && (ui > 0)) ? 1 : 0;
            const char* a1 = gA + (size_t)(t + 1) * kstep;
            const char* a2 = gA + (last ? (size_t)0 : (size_t)(t + 2) * kstep); const char* b2 = last ? nB : cB + (size_t)(t + 2) * kstep;
            const char* a3 = a2 + kstep; const char* b3 = b2 + kstep;
            if (last) { if (has_next) { S.a_ready(nxt); PG8_IDX_READ(vn, nxt, (ui + 1) & 1); } else { _Pragma("unroll") for (int h_ = 0; h_ < 2; ++h_) _Pragma("unroll") for (int i_ = 0; i_ < 2; ++i_) vn[h_][i_] = vc[h_][i_]; } }
            unsigned s0[2], s1[2];
            _Pragma("unroll") for (int i_ = 0; i_ < 2; ++i_) { s0[i_] = last ? vn[0][i_] : vc[0][i_]; s1[i_] = last ? vn[1][i_] : vc[1][i_]; }
            if constexpr (SP2) {
            PG8_LDB(B0, 0, 0); PG8_LDB(B1, 0, 1); PG8_SCHED; PG8_LDA(At, 0, 0); PG8_STAGE(PG8_SA(1, 1), a1, vc[1]);
            PG8_WAIT_VE(8 + Epi::NST, 8, fe); PG8_WAIT_L(0); PG8_BAR; PG8_MMA(0, 0, At, B0); PG8_MMA(0, 1, At, B1); PG8_BAR; PG8_SCHED;
            PG8_LDA(At, 0, 1); PG8_STAGE(PG8_SB(0, 0), b2, voffB); PG8_STAGE(PG8_SB(0, 1), b2 + hstep, voffB); PG8_STAGE(PG8_SA(0, 0), a2, s0);
            PG8_WAIT_VE(8 + Epi::NST, 8, fe); PG8_WAIT_L(0); PG8_BAR; PG8_MMA(1, 0, At, B0); PG8_MMA(1, 1, At, B1); PG8_BAR; PG8_SCHED;
            PG8_LDB(B0, 1, 0); PG8_LDB(B1, 1, 1); PG8_SCHED; PG8_LDA(At, 1, 0); PG8_STAGE(PG8_SA(0, 1), a2, s1);
            PG8_WAIT_V(8); PG8_WAIT_L(0); PG8_BAR; PG8_MMA(0, 0, At, B0); PG8_MMA(0, 1, At, B1); PG8_BAR; PG8_SCHED;
            PG8_LDA(At, 1, 1); PG8_STAGE(PG8_SB(1, 0), b3, voffB); PG8_STAGE(PG8_SB(1, 1), b3 + hstep, voffB); PG8_STAGE(PG8_SA(1, 0), a3, s0);
            PG8_WAIT_V(8); PG8_WAIT_L(0); PG8_BAR; PG8_MMA(1, 0, At, B0); PG8_MMA(1, 1, At, B1); PG8_BAR; PG8_SCHED;
            }
        }
        asm volatile("s_nop 15\n\ts_nop 15" ::: "memory");
        if constexpr (ALIGN_EPI) { if (wr == 0) PG8_BAR; }
        if constexpr (!Epi::AFTER_DRAIN) { E(acc, cur, wr, wc, fr, fq); S.done(cur); }
        if (!has_next) break;
#pragma unroll
        for (int a = 0; a < 2; ++a)
#pragma unroll
            for (int b = 0; b < 2; ++b)
#pragma unroll
                for (int m = 0; m < 4; ++m)
#pragma unroll
                    for (int n = 0; n < 2; ++n) acc[a][b][m][n] = (f32x4){0.f, 0.f, 0.f, 0.f};
        cur = nxt; cB = nB; ++ui;
        _Pragma("unroll") for (int h_ = 0; h_ < 2; ++h_) _Pragma("unroll") for (int i_ = 0; i_ < 2; ++i_) vc[h_][i_] = vn[h_][i_];
        if constexpr (ALIGN_EPI) { if (wr == 1) PG8_BAR; }
    }
    PG8_WAIT_V(0);
    if constexpr (!ALIGN_EPI) { if (wr == 0) PG8_BAR; }
    PG8_BAR;
    if constexpr (Epi::AFTER_DRAIN) { E.fused(acc, cur, wr, wc, fr, fq, lds, wid, lane); S.done(cur); }
#undef PG8_SA
#undef PG8_SB
#undef PG8_STAGE
#undef PG8_IDX_DMA
#undef PG8_IDX_READ
#undef PG8_LD32
#undef PG8_LDA
#undef PG8_LDB
#undef PG8_MMA
#undef PG8_WAIT_V
#undef PG8_WAIT_VE
#undef PG8_WAIT_L
#undef PG8_BAR
#undef PG8_SCHED
}
}
constexpr int NWAVES = 8;
constexpr int BATCH = 4, SEQ = 4096, T = BATCH * SEQ, D = 1024, INW = 6656;
constexpr int C_Q = 0, C_K = 512, C_V = 1024, C_CB = 1536, C_CC = 2048, C_CX = 2560, C_QM = 3072, C_G = 3584;
constexpr int MEMT = 256, MROWS = BATCH * MEMT;
constexpr int NE = 32, FF = 1024, TOPK = 4;
constexpr int MAXTILES = 288, SLOTROWS = MAXTILES * 256;
constexpr float RMS_EPS = 1e-6f;

constexpr size_t MiB = 1u << 20;
constexpr size_t WS_CTL = 0, CTL_ZERO_BYTES = 64 * 1024;
constexpr size_t WS_ROUTE = 1 * MiB;
constexpr size_t WS_WIN = 2 * MiB, WS_WKV = 15 * MiB, WS_WBR = 17 * MiB, WS_WO = 20 * MiB, WS_MEMN = 22 * MiB, WS_KV = 24 * MiB;
constexpr size_t WS_WGU = 26 * MiB, WS_WD = 154 * MiB, WS_XN = 218 * MiB, WS_MERGED = 250 * MiB, WS_Y = 282 * MiB;
constexpr size_t WS_PROJ = 426 * MiB, WS_OBR = 634 * MiB, WS_BO = 682 * MiB, WS_END = 778 * MiB;
constexpr size_t WS_WIN8 = 90 * MiB, WS_XN8 = 100 * MiB;
constexpr size_t WS_HF8 = 426 * MiB, WS_LIST = 458 * MiB;
constexpr size_t WS_SSQ = 460 * MiB;
constexpr size_t WS_XG = 426 * MiB, WS_ACT = 570 * MiB;
static_assert(WS_XG + (size_t)SLOTROWS * 1024 * 2 <= WS_ACT && WS_ACT + (size_t)SLOTROWS * 1024 * 2 <= WS_END, "overlay map");
static_assert(WS_Y + (size_t)SLOTROWS * 1024 * 2 <= WS_PROJ && WS_PROJ + (size_t)T * INW * 2 <= WS_OBR, "d_ws map");
constexpr int CW_BAR = 4096;
constexpr int CW_CNT = 8192;

constexpr int RING_OFF = 0, RING_BYTES = 131072;
constexpr int LDSCTL_OFF = 139264, MISC_OFF = LDSCTL_OFF + 320;
constexpr int TAB_OFF = LDSCTL_OFF + 1024;
constexpr int LDS_BYTES = 147456;

#define GAS __attribute__((address_space(1)))
#define LAS __attribute__((address_space(3)))
typedef unsigned short bf16;
typedef unsigned v4u __attribute__((ext_vector_type(4)));
typedef float f32x4 __attribute__((ext_vector_type(4)));
typedef short bf16x8 __attribute__((ext_vector_type(8)));
typedef GAS unsigned gu32;
typedef GAS unsigned long long gu64;
#define RLX_AGENT __ATOMIC_RELAXED, __HIP_MEMORY_SCOPE_AGENT
#define LDS_WAIT() asm volatile("s_waitcnt lgkmcnt(0)" ::: "memory")
#define VM_WAIT() asm volatile("s_waitcnt vmcnt(0)" ::: "memory")
__device__ __forceinline__ unsigned long long rt() { return __builtin_amdgcn_s_memrealtime(); }
__device__ __forceinline__ unsigned f2bf(float f) { unsigned u = __builtin_bit_cast(unsigned, f); return (u + 0x7fffu + ((u >> 16) & 1u)) >> 16; }
__device__ __forceinline__ unsigned pk2(float lo, float hi) { return f2bf(lo) | (f2bf(hi) << 16); }

#define XB_TMO      128
#define XB_XCNT(j)  (256  + 64 * (j))
#define XB_XSUB(j)  (1280 + 64 * (j))
#define XB_XGEN(j)  (2304 + 64 * (j))
#define XB_TOP      3328
#define XB_TOPGEN   3392
#define XCD_BAR_WORDS 3456
#define XB_SPIN_CAP (1u << 18)

__device__ __forceinline__ unsigned xb_ld(unsigned* p)              { return __hip_atomic_load(p, __ATOMIC_RELAXED, __HIP_MEMORY_SCOPE_AGENT); }
__device__ __forceinline__ unsigned xb_add(unsigned* p, unsigned v) { return __hip_atomic_fetch_add(p, v, __ATOMIC_RELAXED, __HIP_MEMORY_SCOPE_AGENT); }
__device__ __forceinline__ unsigned xb_xcc_id() { return (unsigned)__builtin_amdgcn_s_getreg((3 << 11) | 20) & 0xFu; }
#define XB_SPIN(cond, bar) do { unsigned _sp = 0; while (cond) { __builtin_amdgcn_s_sleep(1); \
    if ((++_sp & 255u) == 0u) { if (xb_ld(&(bar)[XB_TMO])) break; if (_sp > XB_SPIN_CAP) { atomicAdd(&(bar)[XB_TMO], 1u); break; } } } } while (0)

struct XcdBarrier {
    unsigned* bar; unsigned x;
    volatile LAS unsigned* st;
};

__device__ __forceinline__ XcdBarrier xcd_barrier_post(unsigned* bar, volatile LAS unsigned* st) {
    XcdBarrier b; b.bar = bar; b.x = xb_xcc_id(); b.st = st;
    if (threadIdx.x == 0) (void)xb_add(&bar[XB_XCNT(b.x)], 1u);
    return b;
}
__device__ __forceinline__ void xcd_barrier_complete(unsigned* bar, unsigned x, unsigned& nloc, unsigned& nx) {
    const unsigned G = gridDim.x * gridDim.y * gridDim.z;
    unsigned sum, cnt, mine, sp = 0u;
    for (;;) {
        sum = 0u; cnt = 0u; mine = 0u;
#pragma unroll
        for (unsigned j = 0; j < 16; ++j) { const unsigned c = xb_ld(&bar[XB_XCNT(j)]); sum += c; cnt += (c > 0u) ? 1u : 0u; mine = (j == x) ? c : mine; }
        if (sum == G) break;
        __builtin_amdgcn_s_sleep(1);
        if ((++sp & 255u) == 0u) { if (xb_ld(&bar[XB_TMO])) break; if (sp > XB_SPIN_CAP) { atomicAdd(&bar[XB_TMO], 1u); break; } }
    }
    nloc = mine > 0u ? mine : 1u; nx = cnt > 0u ? cnt : 1u;
}

__device__ __forceinline__ void xcd_barrier(const XcdBarrier& b) {
    asm volatile("s_waitcnt vmcnt(0)" ::: "memory");
    __syncthreads();
    if (threadIdx.x == 0) {
        unsigned* bar = b.bar;
        __builtin_amdgcn_s_waitcnt(0);
        unsigned nloc = b.st[0], nx = b.st[1];
        if (nloc == 0u) { xcd_barrier_complete(bar, b.x, nloc, nx); b.st[0] = nloc; b.st[1] = nx; }
        const unsigned old = xb_add(&bar[XB_XSUB(b.x)], 1u);
        const unsigned gen = old / nloc;
        if (old + 1u == (gen + 1u) * nloc) {
            __builtin_amdgcn_fence(__ATOMIC_RELEASE, "agent");
            asm volatile("s_waitcnt vmcnt(0)" ::: "memory");
            const unsigned og = xb_add(&bar[XB_TOP], 1u);
            const unsigned tg = og / nx;
            if (og + 1u == (tg + 1u) * nx) xb_add(&bar[XB_TOPGEN], 1u);
            else XB_SPIN(xb_ld(&bar[XB_TOPGEN]) == tg, bar);
            __builtin_amdgcn_fence(__ATOMIC_ACQUIRE, "agent");
            xb_add(&bar[XB_XGEN(b.x)], 1u);
            asm volatile("s_waitcnt vmcnt(0)" ::: "memory");
        } else {
            XB_SPIN(xb_ld(&bar[XB_XGEN(b.x)]) == gen, bar);
            __builtin_amdgcn_fence(__ATOMIC_ACQUIRE, "agent");
            asm volatile("s_waitcnt vmcnt(0)" ::: "memory");
        }
    }
    __syncthreads();
}

struct Frame {
    LAS unsigned char* lds;
    volatile LAS unsigned* MISC;
    gu32* ctl;
    unsigned char* ws; float* out;
    int tid, lane, wave, vcu, G;
};
typedef const __attribute__((address_space(4))) char* kargp_t;
__device__ __forceinline__ const float* in_ptr(int i) {
    kargp_t kp = (kargp_t)__builtin_amdgcn_kernarg_segment_ptr();
    asm volatile("" : "+s"(kp));
    return *(const float* const __attribute__((address_space(4)))*)(kp + 8 * i);
}
enum { I_X = 0, I_MEM, I_MIXG, I_WIN, I_SBQG, I_SBKG, I_CONVW, I_MEMG, I_WKV, I_MEMQG, I_MEMKG, I_WBRSB, I_WBRCONV, I_WBRMEM, I_WO, I_FFNG, I_WROUTER, I_BROUTER, I_WGU, I_BGU, I_WD, I_BD };
#define WSP(TY, off) ((TY*)(F.ws + (off)))

__device__ __forceinline__ float wave_sum(float v) {
#pragma unroll
    for (int o = 1; o < 64; o <<= 1) v += __shfl_xor(v, o);
    return v;
}
typedef unsigned u32x4s __attribute__((ext_vector_type(4)));
typedef unsigned u32x2s __attribute__((ext_vector_type(2)));
typedef float f32x2s __attribute__((ext_vector_type(2)));
__device__ __forceinline__ float bflo(unsigned w) { return __uint_as_float(w << 16); }
__device__ __forceinline__ float bfhi(unsigned w) { return __uint_as_float(w & 0xffff0000u); }
__device__ __forceinline__ unsigned pk4_fp8(float a, float b, float c, float d) {
    a = fminf(fmaxf(a, -448.f), 448.f); b = fminf(fmaxf(b, -448.f), 448.f); c = fminf(fmaxf(c, -448.f), 448.f); d = fminf(fmaxf(d, -448.f), 448.f);
    int w = __builtin_amdgcn_cvt_pk_fp8_f32(a, b, 0, false);
    w = __builtin_amdgcn_cvt_pk_fp8_f32(c, d, w, true);
    return (unsigned)w;
}

constexpr int CI_IN = 16 * 208, CI_KV = 16 * 32, CI_BR = 8 * 32, CI_O = 16 * 32, CI_SMALL = CI_IN + CI_KV + 3 * CI_BR + CI_O, CI_D = NE * 16 * 32, CI_GU = NE * 16 * 64, CI_ALL = CI_SMALL + CI_D + CI_GU;
__host__ __device__ __forceinline__ bool proj_tile_f8(int pn) { return pn >= 14; }
__host__ __device__ __forceinline__ int wide_slot(int nb) { const int g = nb & 7; return (nb & ~7) + ((g & 1) << 2) + (g >> 1); }
struct ConvItem { const float* W; bf16* WT; int N, K, k0, n0, dst, f8; };
__device__ __forceinline__ ConvItem conv_decode(Frame& F, int it) {
    ConvItem d; int r = it;
    if (r < CI_IN) { const int kb = r / 208, nb = r % 208, pn = nb >> 3; d.f8 = proj_tile_f8(pn) ? 1 : 0; d.W = in_ptr(I_WIN); d.WT = d.f8 ? (bf16*)WSP(unsigned char, WS_WIN8) : WSP(bf16, WS_WIN); d.N = INW; d.K = 1024; d.k0 = 64 * kb; d.n0 = 32 * nb; d.dst = wide_slot(nb) * 32; return d; } r -= CI_IN;
    if (r < CI_KV) { const int kb = r / 32, nb = r % 32; d.W = in_ptr(I_WKV); d.WT = WSP(bf16, WS_WKV); d.N = 1024; d.K = 1024; d.k0 = 64 * kb; d.n0 = 32 * nb; d.dst = wide_slot(nb) * 32; d.f8 = 0; return d; } r -= CI_KV;
    if (r < 3 * CI_BR) { const int br = r / CI_BR, rr = r % CI_BR, kb = rr / 32, nb = rr % 32; d.W = in_ptr(I_WBRSB + br); d.WT = WSP(bf16, WS_WBR) + (size_t)br * 1024 * 512; d.N = 1024; d.K = 512; d.k0 = 64 * kb; d.n0 = 32 * nb; d.dst = 32 * nb; d.f8 = 0; return d; } r -= 3 * CI_BR;
    if (r < CI_O) { const int kb = r / 32, nb = r % 32; d.W = in_ptr(I_WO); d.WT = WSP(bf16, WS_WO); d.N = 1024; d.K = 1024; d.k0 = 64 * kb; d.n0 = 32 * nb; d.dst = 32 * nb; d.f8 = 0; return d; } r -= CI_O;
    if (r < CI_D) { const int e = r / 512, rr = r % 512, kb = rr / 32, nb = rr % 32; d.W = in_ptr(I_WD) + (size_t)e * 1024 * 1024; d.WT = WSP(bf16, WS_WD); d.N = 1024; d.K = 1024; d.k0 = 64 * kb; d.n0 = 32 * nb; d.dst = e * 1024 + 32 * nb; d.f8 = 1; return d; } r -= CI_D;
    { const int e = r / 1024, rr = r % 1024, kb = rr / 64, nb = rr % 64, n0 = 32 * nb, f0 = n0 & 1023;
      d.W = in_ptr(I_WGU) + (size_t)e * 1024 * 2048; d.WT = WSP(bf16, WS_WGU); d.N = 2048; d.K = 1024; d.k0 = 64 * kb; d.n0 = n0;
      d.dst = e * 2048 + (f0 >> 7) * 256 + (n0 >= 1024 ? 128 : 0) + (f0 & 127); d.f8 = 1; return d; }
}
__device__ __forceinline__ void conv_load(const ConvItem& d, f32x4 (&r)[8], int lane) {
    const GAS f32x4* p = (const GAS f32x4*)((const GAS float*)d.W + (size_t)(d.k0 + 8 * (lane >> 3)) * d.N + d.n0 + 4 * (lane & 7));
    const size_t rstep = (size_t)(d.N >> 2);
#pragma unroll
    for (int i = 0; i < 8; ++i) r[i] = p[i * rstep];
}
__device__ __forceinline__ void conv_finish(const ConvItem& d, const f32x4 (&r)[8], LAS float* scr, int lane) {
    const size_t o0 = (size_t)(d.dst + 4 * (lane & 7)) * d.K + d.k0 + 8 * (lane >> 3);
    if (d.f8) {
        GAS unsigned char* o = (GAS unsigned char*)d.WT + o0;
#pragma unroll
        for (int j = 0; j < 4; ++j) { u32x2s w; w.x = pk4_fp8(r[0][j], r[1][j], r[2][j], r[3][j]); w.y = pk4_fp8(r[4][j], r[5][j], r[6][j], r[7][j]); *(GAS u32x2s*)(o + (size_t)j * d.K) = w; }
    } else {
        GAS bf16* o = (GAS bf16*)d.WT + o0;
#pragma unroll
        for (int j = 0; j < 4; ++j) { v4u w; w.x = pk2(r[0][j], r[1][j]); w.y = pk2(r[2][j], r[3][j]); w.z = pk2(r[4][j], r[5][j]); w.w = pk2(r[6][j], r[7][j]); *(GAS v4u*)(o + (size_t)j * d.K) = w; }
    }
}
constexpr int CONV_DEPTH = 6;
constexpr int G_PROJ = 192;
constexpr int CI_D_P0 = P0_WD_EXPERTS * 512;
constexpr int G_GU = 224;
__device__ __forceinline__ void conv_items(Frame& F, int first, int last, int gw, int ngw, LAS float* scr, int skip_lo = 0x7fffffff, int nskip = 0) {
#define CI_RM(i_) ((i_) >= skip_lo ? (i_) + nskip : (i_))
    if (first + gw >= last) return;
    const int n = (last - first - gw + ngw - 1) / ngw, base = first + gw;
    f32x4 r[CONV_DEPTH][8];
#pragma unroll
    for (int q = 0; q < CONV_DEPTH; ++q) { const int j = q < n ? q : n - 1; const ConvItem d = conv_decode(F, CI_RM(base + j * ngw)); conv_load(d, r[q], F.lane); }
    int j0 = 0;
#pragma unroll 1
    for (; j0 + CONV_DEPTH < n; j0 += CONV_DEPTH) {
#pragma unroll
        for (int q = 0; q < CONV_DEPTH; ++q) {
            { const ConvItem d = conv_decode(F, CI_RM(base + (j0 + q) * ngw)); conv_finish(d, r[q], scr, F.lane); }
            { const int jn = j0 + q + CONV_DEPTH, j = jn < n ? jn : n - 1; const ConvItem d = conv_decode(F, CI_RM(base + j * ngw)); conv_load(d, r[q], F.lane); }
        }
    }
#pragma unroll
    for (int q = 0; q < CONV_DEPTH; ++q) { const int jq = j0 + q, j = jq < n ? jq : n - 1; const ConvItem d = conv_decode(F, CI_RM(base + j * ngw)); conv_finish(d, r[q], scr, F.lane); }
}
#undef CI_RM
__device__ __forceinline__ void rms_one(Frame& F, const f32x4 (&v)[4], const f32x4 (&gg)[4], bf16* orow, unsigned char* o8row) {
    const int lane = F.lane;
    float s = 0.f;
#pragma unroll
    for (int j = 0; j < 4; ++j) s += (v[j].x * v[j].x + v[j].y * v[j].y) + (v[j].z * v[j].z + v[j].w * v[j].w);
    const float r = 1.f / sqrtf(wave_sum(s) * (1.f / 1024.f) + RMS_EPS);
    GAS unsigned long long* o8 = (GAS unsigned long long*)orow + lane;
    f32x4 t[4];
#pragma unroll
    for (int j = 0; j < 4; ++j) { t[j].x = v[j].x * (r * gg[j].x); t[j].y = v[j].y * (r * gg[j].y); t[j].z = v[j].z * (r * gg[j].z); t[j].w = v[j].w * (r * gg[j].w);
        o8[64 * j] = (unsigned long long)pk2(t[j].x, t[j].y) | ((unsigned long long)pk2(t[j].z, t[j].w) << 32); }
    if (o8row) { GAS unsigned* o4 = (GAS unsigned*)o8row + lane;
#pragma unroll
        for (int j = 0; j < 4; ++j) o4[64 * j] = pk4_fp8(t[j].x, t[j].y, t[j].z, t[j].w); }
}
__device__ __forceinline__ void rms_rows(Frame& F, int gw, int NGW) {
    const int lane = F.lane;
    const float *px = in_ptr(I_X), *pmixg = in_ptr(I_MIXG), *pmem = in_ptr(I_MEM), *pmemg = in_ptr(I_MEMG);
    if (gw < T) {
        const int n = (T - gw + NGW - 1) / NGW;
        f32x4 gg[4];
#pragma unroll
        for (int j = 0; j < 4; ++j) gg[j] = ((const GAS f32x4*)pmixg)[lane + 64 * j];
        f32x4 va[4], vb[4];
#define RR_LOAD(V, jj) do { const int j_ = (jj) < n ? (jj) : n - 1; const GAS f32x4* xr = (const GAS f32x4*)(px + (size_t)(gw + j_ * NGW) * D) + lane; _Pragma("unroll") for (int q = 0; q < 4; ++q) V[q] = xr[64 * q]; } while (0)
        RR_LOAD(va, 0); RR_LOAD(vb, 1);
#pragma unroll 1
        for (int j = 0; j < n; j += 2) {
            { const int m = gw + j * NGW; f32x4 c[4];
#pragma unroll
              for (int q = 0; q < 4; ++q) c[q] = va[q];
              RR_LOAD(va, j + 2);
              rms_one(F, c, gg, WSP(bf16, WS_XN) + (size_t)m * D, WSP(unsigned char, WS_XN8) + (size_t)m * D); }
            { const int j1 = (j + 1 < n) ? j + 1 : n - 1; const int m = gw + j1 * NGW; f32x4 c[4];
#pragma unroll
              for (int q = 0; q < 4; ++q) c[q] = vb[q];
              RR_LOAD(vb, j + 3);
              rms_one(F, c, gg, WSP(bf16, WS_XN) + (size_t)m * D, WSP(unsigned char, WS_XN8) + (size_t)m * D); }
        }
#undef RR_LOAD
    }
    for (int r = gw; r < MROWS; r += NGW) {
        f32x4 gg[4], v[4];
#pragma unroll
        for (int j = 0; j < 4; ++j) { gg[j] = ((const GAS f32x4*)pmemg)[lane + 64 * j]; v[j] = ((const GAS f32x4*)(pmem + (size_t)r * D))[lane + 64 * j]; }
        rms_one(F, v, gg, WSP(bf16, WS_MEMN) + (size_t)r * D, nullptr);
    }
}
__device__ __forceinline__ void p0_prologue(Frame& F, int nconv, int skip_lo, int nskip) {
    LAS float* scr = (LAS float*)(F.lds + RING_OFF + F.wave * 16384);
    const int gw = F.vcu * NWAVES + F.wave, NGW = F.G * NWAVES;
    rms_rows(F, gw, NGW);
    conv_items(F, 0, nconv, gw, NGW, scr, skip_lo, nskip);
}

typedef float f32x16 __attribute__((ext_vector_type(16)));
__device__ __forceinline__ float swap_max(float v) { auto rr = __builtin_amdgcn_permlane32_swap(__float_as_uint(v), __float_as_uint(v), false, false); return fmaxf(__uint_as_float(rr[0]), __uint_as_float(rr[1])); }
__device__ __forceinline__ float swap_sum(float v) { auto rr = __builtin_amdgcn_permlane32_swap(__float_as_uint(v), __float_as_uint(v), false, false); return __uint_as_float(rr[0]) + __uint_as_float(rr[1]); }
__device__ __forceinline__ float swap_other(float v) { auto rr = __builtin_amdgcn_permlane32_swap(__float_as_uint(v), __float_as_uint(v), false, false); const float a = __uint_as_float(rr[0]), b = __uint_as_float(rr[1]); return (a + b) - v; }
template <int NS> __device__ __forceinline__ void norm_frags(const v4u (&raw)[NS], bf16x8 (&out)[NS], const float* g, int hi, float inv_n, float post) {
    float ss = 0.f;
#pragma unroll
    for (int s = 0; s < NS; ++s) { const v4u c = raw[s]; const float x0 = bflo(c.x), x1 = bfhi(c.x), x2 = bflo(c.y), x3 = bfhi(c.y), x4 = bflo(c.z), x5 = bfhi(c.z), x6 = bflo(c.w), x7 = bfhi(c.w);
        ss += (x0 * x0 + x1 * x1) + (x2 * x2 + x3 * x3) + (x4 * x4 + x5 * x5) + (x6 * x6 + x7 * x7); }
    ss = swap_sum(ss);
    const float r = post * __builtin_amdgcn_rsqf(ss * inv_n + RMS_EPS);
#pragma unroll
    for (int s = 0; s < NS; ++s) { const v4u c = raw[s]; const f32x4 g0 = *(const GAS f32x4*)(g + 16 * s + 8 * hi), g1 = *(const GAS f32x4*)(g + 16 * s + 8 * hi + 4);
        u32x4s w; w.x = pg8::cvt_pk_bf16(bflo(c.x) * r * g0.x, bfhi(c.x) * r * g0.y); w.y = pg8::cvt_pk_bf16(bflo(c.y) * r * g0.z, bfhi(c.y) * r * g0.w);
        w.z = pg8::cvt_pk_bf16(bflo(c.z) * r * g1.x, bfhi(c.z) * r * g1.y); w.w = pg8::cvt_pk_bf16(bflo(c.w) * r * g1.z, bfhi(c.w) * r * g1.w); out[s] = __builtin_bit_cast(bf16x8, w); }
}
template <int NS> __device__ __forceinline__ void norm_frags_plain(const v4u (&raw)[NS], bf16x8 (&out)[NS], float inv_n) {
    float ss = 0.f;
#pragma unroll
    for (int s = 0; s < NS; ++s) { const v4u c = raw[s]; const float x0 = bflo(c.x), x1 = bfhi(c.x), x2 = bflo(c.y), x3 = bfhi(c.y), x4 = bflo(c.z), x5 = bfhi(c.z), x6 = bflo(c.w), x7 = bfhi(c.w);
        ss += (x0 * x0 + x1 * x1) + (x2 * x2 + x3 * x3) + (x4 * x4 + x5 * x5) + (x6 * x6 + x7 * x7); }
    ss = swap_sum(ss);
    const float r = __builtin_amdgcn_rsqf(ss * inv_n + RMS_EPS);
#pragma unroll
    for (int s = 0; s < NS; ++s) { const v4u c = raw[s];
        u32x4s w; w.x = pg8::cvt_pk_bf16(bflo(c.x) * r, bfhi(c.x) * r); w.y = pg8::cvt_pk_bf16(bflo(c.y) * r, bfhi(c.y) * r);
        w.z = pg8::cvt_pk_bf16(bflo(c.z) * r, bfhi(c.z) * r); w.w = pg8::cvt_pk_bf16(bflo(c.w) * r, bfhi(c.w) * r); out[s] = __builtin_bit_cast(bf16x8, w); }
}
template <int NS> __device__ __forceinline__ void norm_frags2(const v4u (&raw)[NS], bf16x8 (&out)[NS], const float* g, const float* g2, int hi, float inv_n, float post) {
    float ss = 0.f;
#pragma unroll
    for (int s = 0; s < NS; ++s) { const v4u c = raw[s]; const float x0 = bflo(c.x), x1 = bfhi(c.x), x2 = bflo(c.y), x3 = bfhi(c.y), x4 = bflo(c.z), x5 = bfhi(c.z), x6 = bflo(c.w), x7 = bfhi(c.w);
        ss += (x0 * x0 + x1 * x1) + (x2 * x2 + x3 * x3) + (x4 * x4 + x5 * x5) + (x6 * x6 + x7 * x7); }
    ss = swap_sum(ss);
    const float r = post * __builtin_amdgcn_rsqf(ss * inv_n + RMS_EPS);
#pragma unroll
    for (int s = 0; s < NS; ++s) { const v4u c = raw[s]; const f32x4 g0 = *(const GAS f32x4*)(g + 16 * s + 8 * hi) * *(const GAS f32x4*)(g2 + 16 * s + 8 * hi), g1 = *(const GAS f32x4*)(g + 16 * s + 8 * hi + 4) * *(const GAS f32x4*)(g2 + 16 * s + 8 * hi + 4);
        u32x4s w; w.x = pg8::cvt_pk_bf16(bflo(c.x) * r * g0.x, bfhi(c.x) * r * g0.y); w.y = pg8::cvt_pk_bf16(bflo(c.y) * r * g0.z, bfhi(c.y) * r * g0.w);
        w.z = pg8::cvt_pk_bf16(bflo(c.z) * r * g1.x, bfhi(c.z) * r * g1.y); w.w = pg8::cvt_pk_bf16(bflo(c.w) * r * g1.z, bfhi(c.w) * r * g1.w); out[s] = __builtin_bit_cast(bf16x8, w); }
}
constexpr float SB_EXIT_LOG2 = -32.0f;
constexpr int SB_VROW = 72;
__device__ __forceinline__ void sb_tile(Frame& F, int bh, int qt, bf16* OSB, const float* qg, const float* kg) {
    const int lane = F.lane, r32 = lane & 31, hi = lane >> 5, b = bh >> 3, h = bh & 7;
    LAS unsigned char* vt = F.lds + RING_OFF + F.wave * 16384;
    const bf16* base = WSP(bf16, WS_PROJ) + (size_t)(b * SEQ) * INW + h * 64;
    const int t = qt * 32 + r32;
    bf16x8 qf[4];
    { v4u raw[4]; const bf16* qp = base + (size_t)t * INW + C_Q + 8 * hi;
#pragma unroll
      for (int s = 0; s < 4; ++s) raw[s] = *(const GAS v4u*)(qp + 16 * s);
      for (int s = 0; s < 4; ++s) qf[s] = __builtin_bit_cast(bf16x8, raw[s]); }
    f32x16 O[2];
#pragma unroll
    for (int d = 0; d < 2; ++d) O[d] = (f32x16){0.f, 0.f, 0.f, 0.f, 0.f, 0.f, 0.f, 0.f, 0.f, 0.f, 0.f, 0.f, 0.f, 0.f, 0.f, 0.f};
    float carry = 0.f;
    v4u kraw[4], vraw[4], knx[4], vnx[4];
    { const bf16* krow = base + (size_t)(qt * 32 + r32) * INW;
#pragma unroll
      for (int s = 0; s < 4; ++s) { kraw[s] = *(const GAS v4u*)(krow + C_K + 16 * s + 8 * hi); vraw[s] = *(const GAS v4u*)(krow + C_V + 32 * hi + 8 * s); } }
#pragma unroll 1
    for (int kt = qt; kt >= 0; --kt) {
        { const bf16* krow = base + (size_t)((kt > 0 ? kt - 1 : 0) * 32 + r32) * INW;
#pragma unroll
          for (int s = 0; s < 4; ++s) { knx[s] = *(const GAS v4u*)(krow + C_K + 16 * s + 8 * hi); vnx[s] = *(const GAS v4u*)(krow + C_V + 32 * hi + 8 * s); } }
        bf16x8 kf[4];
        for (int s = 0; s < 4; ++s) kf[s] = __builtin_bit_cast(bf16x8, kraw[s]);
#pragma unroll
        for (int s = 0; s < 4; ++s) { LAS unsigned short* p = (LAS unsigned short*)(vt + (32 * hi + 8 * s) * SB_VROW + r32 * 2); const v4u v = vraw[s];
            p[0 * (SB_VROW / 2)] = (unsigned short)v.x; p[1 * (SB_VROW / 2)] = (unsigned short)(v.x >> 16); p[2 * (SB_VROW / 2)] = (unsigned short)v.y; p[3 * (SB_VROW / 2)] = (unsigned short)(v.y >> 16);
            p[4 * (SB_VROW / 2)] = (unsigned short)v.z; p[5 * (SB_VROW / 2)] = (unsigned short)(v.z >> 16); p[6 * (SB_VROW / 2)] = (unsigned short)v.w; p[7 * (SB_VROW / 2)] = (unsigned short)(v.w >> 16); }
        f32x16 S = {0.f, 0.f, 0.f, 0.f, 0.f, 0.f, 0.f, 0.f, 0.f, 0.f, 0.f, 0.f, 0.f, 0.f, 0.f, 0.f};
#pragma unroll
        for (int s = 0; s < 4; ++s) S = __builtin_amdgcn_mfma_f32_32x32x16_bf16(kf[s], qf[s], S, 0, 0, 0);
        const bool diag = (kt == qt);
        float ls[16], la[16];
        if (diag) {
#pragma unroll
            for (int r = 0; r < 16; ++r) {
                const int kr = (r & 3) + 8 * (r >> 2) + 4 * hi;
                const bool valid = kr < r32;
                const float z = S[r], e = __builtin_amdgcn_exp2f(-fabsf(z)), L = __builtin_amdgcn_logf(1.f + e);
                ls[r] = valid ? -(fmaxf(z, 0.f) + L) : 0.f;
                la[r] = valid ? fminf(z, 0.f) - L : -INFINITY;
            }
        } else {
#pragma unroll
            for (int r = 0; r < 16; ++r) {
                const float z = S[r], e = __builtin_amdgcn_exp2f(-fabsf(z)), L = __builtin_amdgcn_logf(1.f + e);
                ls[r] = -(fmaxf(z, 0.f) + L);
                la[r] = fminf(z, 0.f) - L;
            }
        }
        float go[4], gp[4];
#pragma unroll
        for (int g = 0; g < 4; ++g) { go[g] = (ls[4 * g] + ls[4 * g + 1]) + (ls[4 * g + 2] + ls[4 * g + 3]); gp[g] = swap_other(go[g]); }
        float after[4];
        after[3] = (hi == 0) ? gp[3] : 0.f;
#pragma unroll
        for (int g = 2; g >= 0; --g) after[g] = after[g + 1] + go[g + 1] + ((hi == 0) ? gp[g] : gp[g + 1]);
        float w[16];
#pragma unroll
        for (int g = 0; g < 4; ++g) {
            const float b3 = carry + after[g], b2 = b3 + ls[4 * g + 3], b1 = b2 + ls[4 * g + 2], b0 = b1 + ls[4 * g + 1];
            w[4 * g + 3] = __builtin_amdgcn_exp2f(la[4 * g + 3] + b3); w[4 * g + 2] = __builtin_amdgcn_exp2f(la[4 * g + 2] + b2);
            w[4 * g + 1] = __builtin_amdgcn_exp2f(la[4 * g + 1] + b1); w[4 * g] = __builtin_amdgcn_exp2f(la[4 * g] + b0);
        }
        carry += ((go[0] + go[1]) + (go[2] + go[3])) + ((gp[0] + gp[1]) + (gp[2] + gp[3]));
        bf16x8 pb[2];
#pragma unroll
        for (int s2 = 0; s2 < 2; ++s2) { u32x4s u; u.x = pg8::cvt_pk_bf16(w[8 * s2], w[8 * s2 + 1]); u.y = pg8::cvt_pk_bf16(w[8 * s2 + 2], w[8 * s2 + 3]); u.z = pg8::cvt_pk_bf16(w[8 * s2 + 4], w[8 * s2 + 5]); u.w = pg8::cvt_pk_bf16(w[8 * s2 + 6], w[8 * s2 + 7]); pb[s2] = __builtin_bit_cast(bf16x8, u); }
        LDS_WAIT(); asm volatile("" ::: "memory");
#pragma unroll
        for (int d = 0; d < 2; ++d)
#pragma unroll
            for (int s2 = 0; s2 < 2; ++s2) {
                const LAS unsigned char* vp = vt + (32 * d + r32) * SB_VROW + (16 * s2 + 4 * hi) * 2;
                const u32x2s lo = *(const LAS u32x2s*)vp, hh = *(const LAS u32x2s*)(vp + 16);
                u32x4s a; a.x = lo.x; a.y = lo.y; a.z = hh.x; a.w = hh.y;
                O[d] = __builtin_amdgcn_mfma_f32_32x32x16_bf16(__builtin_bit_cast(bf16x8, a), pb[s2], O[d], 0, 0, 0);
            }
        LDS_WAIT(); asm volatile("" ::: "memory");
        if (__all(carry < SB_EXIT_LOG2)) break;
#pragma unroll
        for (int s = 0; s < 4; ++s) { kraw[s] = knx[s]; vraw[s] = vnx[s]; }
    }
    bf16* op = OSB + (size_t)(b * SEQ + t) * 512 + h * 64 + 4 * hi;
#pragma unroll
    for (int d = 0; d < 2; ++d)
#pragma unroll
        for (int g = 0; g < 4; ++g) { u32x2s u; u.x = pk2(O[d][4 * g], O[d][4 * g + 1]); u.y = pk2(O[d][4 * g + 2], O[d][4 * g + 3]); *(GAS u32x2s*)(op + 32 * d + 8 * g) = u; }
}
constexpr int MA_KROW = 272, MA_VROW = 520, MA_VOFF = 256 * MA_KROW;
__device__ __forceinline__ void mem_attn_item(Frame& F, int item, bf16* OMEM, const float* mqg, const float* mkg) {
    const int b = item >> 6, h = (item >> 4) & 3, qblk = item & 15, tid = F.tid, lane = F.lane, r32 = lane & 31, hi = lane >> 5;
    LAS unsigned char* kl = F.lds + RING_OFF; LAS unsigned char* vl = kl + MA_VOFF;
    const bf16* kvb = WSP(bf16, WS_KV) + (size_t)(b * MEMT) * 1024 + h * 128;
    __syncthreads();
#pragma unroll
    for (int i = 0; i < 8; ++i) { const int id = tid + 512 * i, row = id >> 4, c = id & 15;
        const v4u cr = *(const GAS v4u*)(kvb + (size_t)row * 1024 + c * 8);
        const float x0 = bflo(cr.x), x1 = bfhi(cr.x), x2 = bflo(cr.y), x3 = bfhi(cr.y), x4 = bflo(cr.z), x5 = bfhi(cr.z), x6 = bflo(cr.w), x7 = bfhi(cr.w);
        float ss = (x0 * x0 + x1 * x1) + (x2 * x2 + x3 * x3) + (x4 * x4 + x5 * x5) + (x6 * x6 + x7 * x7);
        ss += __shfl_xor(ss, 1); ss += __shfl_xor(ss, 2); ss += __shfl_xor(ss, 4); ss += __shfl_xor(ss, 8);
        const float r = __builtin_amdgcn_rsqf(ss * (1.f / 128.f) + RMS_EPS); const f32x4 g0 = *(const GAS f32x4*)(mkg + 8 * c), g1 = *(const GAS f32x4*)(mkg + 8 * c + 4);
        v4u o; o.x = pk2(x0 * r * g0.x, x1 * r * g0.y); o.y = pk2(x2 * r * g0.z, x3 * r * g0.w); o.z = pk2(x4 * r * g1.x, x5 * r * g1.y); o.w = pk2(x6 * r * g1.z, x7 * r * g1.w);
        *(LAS v4u*)(kl + row * MA_KROW + c * 16) = o; }
#pragma unroll
    for (int i = 0; i < 8; ++i) { const int id = tid + 512 * i, key = id & 255, c = id >> 8;
        const v4u v = *(const GAS v4u*)(kvb + (size_t)key * 1024 + 512 + c * 8); LAS unsigned short* vt = (LAS unsigned short*)(vl + (8 * c) * MA_VROW + key * 2);
        vt[0 * (MA_VROW / 2)] = (unsigned short)v.x; vt[1 * (MA_VROW / 2)] = (unsigned short)(v.x >> 16); vt[2 * (MA_VROW / 2)] = (unsigned short)v.y; vt[3 * (MA_VROW / 2)] = (unsigned short)(v.y >> 16);
        vt[4 * (MA_VROW / 2)] = (unsigned short)v.z; vt[5 * (MA_VROW / 2)] = (unsigned short)(v.z >> 16); vt[6 * (MA_VROW / 2)] = (unsigned short)v.w; vt[7 * (MA_VROW / 2)] = (unsigned short)(v.w >> 16); }
    __syncthreads();
    const int t = b * SEQ + qblk * 256 + F.wave * 32 + r32;
    bf16x8 qf[8];
    { v4u raw[8]; const bf16* qp = WSP(bf16, WS_PROJ) + (size_t)t * INW + C_QM + h * 128 + 8 * hi;
#pragma unroll
      for (int s = 0; s < 8; ++s) raw[s] = *(const GAS v4u*)(qp + 16 * s);
      norm_frags<8>(raw, qf, mqg, hi, 1.f / 128.f, 1.f); }
    const LAS unsigned char* kbase = kl + r32 * MA_KROW + hi * 16;
    float gmq = fmaxf(fabsf(mqg[lane]), fabsf(mqg[lane + 64])), gmk = fmaxf(fabsf(mkg[lane]), fabsf(mkg[lane + 64]));
#pragma unroll
    for (int o = 1; o < 64; o <<= 1) { gmq = fmaxf(gmq, __shfl_xor(gmq, o)); gmk = fmaxf(gmk, __shfl_xor(gmk, o)); }
    const float sc2 = 0.08838834764831845f * 1.4426950408889634f;
    float msc = 128.f * gmq * gmk * 1.02f * sc2;
    if (msc > 48.f) {
        float m = -INFINITY;
#pragma unroll 1
        for (int kt = 0; kt < 8; ++kt) {
            f32x16 S = {0.f, 0.f, 0.f, 0.f, 0.f, 0.f, 0.f, 0.f, 0.f, 0.f, 0.f, 0.f, 0.f, 0.f, 0.f, 0.f};
#pragma unroll
            for (int s = 0; s < 8; ++s) S = __builtin_amdgcn_mfma_f32_32x32x16_bf16(*(const LAS bf16x8*)(kbase + kt * 32 * MA_KROW + s * 32), qf[s], S, 0, 0, 0);
#pragma unroll
            for (int r = 0; r < 16; ++r) m = fmaxf(m, S[r]);
        }
        msc = swap_max(m) * sc2;
    }
    float l = 0.f; f32x16 O[4];
#pragma unroll
    for (int d = 0; d < 4; ++d) O[d] = (f32x16){0.f, 0.f, 0.f, 0.f, 0.f, 0.f, 0.f, 0.f, 0.f, 0.f, 0.f, 0.f, 0.f, 0.f, 0.f, 0.f};
    const LAS unsigned char* vbase = vl + r32 * MA_VROW + hi * 8;
#pragma unroll 1
    for (int kt = 0; kt < 8; ++kt) {
        f32x16 S = {0.f, 0.f, 0.f, 0.f, 0.f, 0.f, 0.f, 0.f, 0.f, 0.f, 0.f, 0.f, 0.f, 0.f, 0.f, 0.f};
#pragma unroll
        for (int s = 0; s < 8; ++s) S = __builtin_amdgcn_mfma_f32_32x32x16_bf16(*(const LAS bf16x8*)(kbase + kt * 32 * MA_KROW + s * 32), qf[s], S, 0, 0, 0);
        float p[16];
#pragma unroll
        for (int r = 0; r < 16; ++r) { p[r] = __builtin_amdgcn_exp2f(S[r] * sc2 - msc); l += p[r]; }
        bf16x8 pb[2];
#pragma unroll
        for (int s2 = 0; s2 < 2; ++s2) { u32x4s w; w.x = pg8::cvt_pk_bf16(p[8 * s2], p[8 * s2 + 1]); w.y = pg8::cvt_pk_bf16(p[8 * s2 + 2], p[8 * s2 + 3]); w.z = pg8::cvt_pk_bf16(p[8 * s2 + 4], p[8 * s2 + 5]); w.w = pg8::cvt_pk_bf16(p[8 * s2 + 6], p[8 * s2 + 7]); pb[s2] = __builtin_bit_cast(bf16x8, w); }
#pragma unroll
        for (int d = 0; d < 4; ++d)
#pragma unroll
            for (int s2 = 0; s2 < 2; ++s2) {
                const LAS unsigned char* vp = vbase + d * 32 * MA_VROW + (kt * 32 + s2 * 16) * 2;
                const u32x2s lo = *(const LAS u32x2s*)vp, hh = *(const LAS u32x2s*)(vp + 16);
                u32x4s a; a.x = lo.x; a.y = lo.y; a.z = hh.x; a.w = hh.y;
                O[d] = __builtin_amdgcn_mfma_f32_32x32x16_bf16(__builtin_bit_cast(bf16x8, a), pb[s2], O[d], 0, 0, 0);
            }
    }
    l = swap_sum(l); const float inv = 1.f / l;
    bf16* op = OMEM + (size_t)t * 512 + h * 128 + 4 * hi;
#pragma unroll
    for (int d = 0; d < 4; ++d)
#pragma unroll
        for (int g = 0; g < 4; ++g) { u32x2s w; w.x = pk2(O[d][4 * g] * inv, O[d][4 * g + 1] * inv); w.y = pk2(O[d][4 * g + 2] * inv, O[d][4 * g + 3] * inv);
            *(GAS u32x2s*)(op + 32 * d + 8 * g) = w; }
    __syncthreads();
}
__device__ __forceinline__ void conv_item4(Frame& F, int t0, bf16* OCONV, const float* cw) {
    const int lane = F.lane, pos0 = t0 & (SEQ - 1), c0 = lane * 8;
    const bf16* pr = WSP(bf16, WS_PROJ) + (size_t)t0 * INW + c0;
    v4u a[6], x[6], bq[4];
#pragma unroll
    for (int j = 0; j < 6; ++j) { const int d = j - 2;
        if (pos0 + d >= 0) { a[j] = *(const GAS v4u*)(pr + (long)d * INW + C_CC); x[j] = *(const GAS v4u*)(pr + (long)d * INW + C_CX); }
        else { a[j] = (v4u){0u, 0u, 0u, 0u}; x[j] = (v4u){0u, 0u, 0u, 0u}; } }
#pragma unroll
    for (int j = 0; j < 4; ++j) bq[j] = *(const GAS v4u*)(pr + (long)j * INW + C_CB);
    float w0[8], w1[8], w2[8];
#pragma unroll
    for (int i = 0; i < 8; ++i) { w0[i] = cw[c0 + i]; w1[i] = cw[512 + c0 + i]; w2[i] = cw[1024 + c0 + i]; }
    float u[6][8];
#pragma unroll
    for (int j = 0; j < 6; ++j) { u[j][0] = bflo(a[j].x) * bflo(x[j].x); u[j][1] = bfhi(a[j].x) * bfhi(x[j].x); u[j][2] = bflo(a[j].y) * bflo(x[j].y); u[j][3] = bfhi(a[j].y) * bfhi(x[j].y);
        u[j][4] = bflo(a[j].z) * bflo(x[j].z); u[j][5] = bfhi(a[j].z) * bfhi(x[j].z); u[j][6] = bflo(a[j].w) * bflo(x[j].w); u[j][7] = bfhi(a[j].w) * bfhi(x[j].w); }
#pragma unroll
    for (int j = 0; j < 4; ++j) {
        const float cb[8] = {bflo(bq[j].x), bfhi(bq[j].x), bflo(bq[j].y), bfhi(bq[j].y), bflo(bq[j].z), bfhi(bq[j].z), bflo(bq[j].w), bfhi(bq[j].w)};
        float r[8];
#pragma unroll
        for (int i = 0; i < 8; ++i) r[i] = cb[i] * (w0[i] * u[j][i] + w1[i] * u[j + 1][i] + w2[i] * u[j + 2][i]);
        v4u o; o.x = pk2(r[0], r[1]); o.y = pk2(r[2], r[3]); o.z = pk2(r[4], r[5]); o.w = pk2(r[6], r[7]);
        *(GAS v4u*)(OCONV + (size_t)(t0 + j) * 512 + c0) = o;
    }
}
#ifndef MIXREP
#define MIXREP 0
#endif
__device__ __forceinline__ void p2_mixers(Frame& F) {
    bf16* OSB = WSP(bf16, WS_OBR); bf16* OCONV = WSP(bf16, WS_OBR) + (size_t)T * 512; bf16* OMEM = WSP(bf16, WS_OBR) + (size_t)2 * T * 512;
    const int gw = F.vcu * NWAVES + F.wave, NGW = F.G * NWAVES;
    { const float* mqg = in_ptr(I_MEMQG); const float* mkg = in_ptr(I_MEMKG);
      for (int item = F.vcu; item < 256; item += F.G) mem_attn_item(F, item, OMEM, mqg, mkg); }
    { const float* qg = in_ptr(I_SBQG); const float* kg = in_ptr(I_SBKG);
      for (int it = F.vcu; it < BATCH * 128; it += F.G) sb_tile(F, (it >> 7) * 8 + F.wave, it & 127, OSB, qg, kg); }
    { const float* cw = in_ptr(I_CONVW);
      for (int t4 = gw; t4 < T / 4; t4 += NGW) conv_item4(F, t4 * 4, OCONV, cw); }
}

__device__ __forceinline__ void p5_route(Frame& F) {
    const int lane = F.lane, w = F.wave, r32 = lane & 31, hi = lane >> 5, tid = F.tid;
    constexpr int TROW = 516;
    LAS float* tile = (LAS float*)(F.lds + RING_OFF);
    LAS float* part = tile + 32 * TROW;
    LAS int* lcnt = (LAS int*)(part + 8 * 32 * 33);
    LAS int* lbase = lcnt + 32;
    LAS float* r2s = (LAS float*)(lbase + 32);
    const float* wrt = in_ptr(I_WROUTER); const float* fg = in_ptr(I_FFNG); const float be = in_ptr(I_BROUTER)[r32];
    const float* ssqp = WSP(float, WS_SSQ);
    f32x4 gq[4];
#pragma unroll
    for (int j = 0; j < 4; ++j) gq[j] = ((const GAS f32x4*)fg)[lane + 64 * j];
    for (int task = F.vcu; task < T / 32; task += F.G) {
        const int tb = task * 32;
        f32x4 xs[4][4]; float rinv4[4];
#pragma unroll
        for (int rr = 0; rr < 4; ++rr) { const int row = tb + 4 * w + rr; const GAS f32x4* xr = (const GAS f32x4*)(F.out + (size_t)row * D) + lane;
#pragma unroll
            for (int j = 0; j < 4; ++j) xs[rr][j] = xr[64 * j];
            const GAS f32x4* sp = (const GAS f32x4*)(ssqp + (size_t)row * 16); const f32x4 s0 = sp[0], s1 = sp[1], s2 = sp[2], s3 = sp[3];
            const float ss = ((s0.x + s0.y) + (s0.z + s0.w)) + ((s1.x + s1.y) + (s1.z + s1.w)) + ((s2.x + s2.y) + (s2.z + s2.w)) + ((s3.x + s3.y) + (s3.z + s3.w));
            rinv4[rr] = 1.f / sqrtf(ss * (1.f / 1024.f) + RMS_EPS); }
#pragma unroll
        for (int rr = 0; rr < 4; ++rr) { const int row = tb + 4 * w + rr; GAS unsigned* o4 = (GAS unsigned*)(WSP(unsigned char, WS_HF8) + (size_t)row * 1024) + lane; const float ri = rinv4[rr];
#pragma unroll
            for (int j = 0; j < 4; ++j) { xs[rr][j] = xs[rr][j] * gq[j]; o4[64 * j] = pk4_fp8(xs[rr][j].x * ri, xs[rr][j].y * ri, xs[rr][j].z * ri, xs[rr][j].w * ri); }
            if (lane == 0) r2s[4 * w + rr] = ri; }
        f32x16 C = {0.f, 0.f, 0.f, 0.f, 0.f, 0.f, 0.f, 0.f, 0.f, 0.f, 0.f, 0.f, 0.f, 0.f, 0.f, 0.f};
#pragma unroll
        for (int hk = 0; hk < 2; ++hk) {
            if (hk) __syncthreads();
#pragma unroll
            for (int rr = 0; rr < 4; ++rr)
#pragma unroll
                for (int jj = 0; jj < 2; ++jj) *(LAS f32x4*)(tile + (4 * w + rr) * TROW + 4 * (lane + 64 * jj)) = xs[rr][2 * hk + jj];
            __syncthreads();
            const int lc = w * 64 + 32 * hi;
            f32x4 xv[8];
#pragma unroll
            for (int i = 0; i < 8; ++i) xv[i] = *(const LAS f32x4*)(tile + r32 * TROW + lc + 4 * i);
            const GAS float* wp = (const GAS float*)wrt + (size_t)(hk * 512 + lc) * 32 + r32;
#pragma unroll
            for (int st = 0; st < 32; ++st) C = __builtin_amdgcn_mfma_f32_32x32x2f32(wp[st * 32], xv[st >> 2][st & 3], C, 0, 0, 0);
        }
#pragma unroll
        for (int r = 0; r < 16; ++r) part[(w * 32 + (r & 3) + 8 * (r >> 2) + 4 * hi) * 33 + r32] = C[r];
        if (tid < 32) lcnt[tid] = 0;
        __syncthreads();
        int my_e[2], loc[2]; float my_g[2];
#pragma unroll
        for (int u = 0; u < 2; ++u) {
            const int j = 4 * w + 2 * hi + u;
            float lg = 0.f;
#pragma unroll
            for (int ww = 0; ww < 8; ++ww) lg += part[(ww * 32 + r32) * 33 + j];
            float val = lg * r2s[j] + be;
            float tv[4]; int ti[4];
#pragma unroll
            for (int rr = 0; rr < 4; ++rr) {
                float bv = val; int bi = r32;
#define TOPK_DPP(ctrl) do { const float ov = __builtin_bit_cast(float, __builtin_amdgcn_update_dpp(0, __builtin_bit_cast(int, bv), ctrl, 0xf, 0xf, false)); const int oi = __builtin_amdgcn_update_dpp(0, bi, ctrl, 0xf, 0xf, false); \
                    if (ov > bv || (ov == bv && oi < bi)) { bv = ov; bi = oi; } } while (0)
                TOPK_DPP(0xB1); TOPK_DPP(0x4E); TOPK_DPP(0x141); TOPK_DPP(0x140);
#undef TOPK_DPP
                { const float ov = __shfl_xor(bv, 16); const int oi = __shfl_xor(bi, 16); if (ov > bv || (ov == bv && oi < bi)) { bv = ov; bi = oi; } }
                tv[rr] = bv; ti[rr] = bi; if (r32 == bi) val = -INFINITY;
            }
            const float e1 = __expf(tv[1] - tv[0]), e2 = __expf(tv[2] - tv[0]), e3 = __expf(tv[3] - tv[0]); const float inv = 1.f / (1.f + e1 + e2 + e3);
            my_e[u] = r32 == 0 ? ti[0] : (r32 == 1 ? ti[1] : (r32 == 2 ? ti[2] : ti[3]));
            my_g[u] = (r32 == 0 ? 1.f : (r32 == 1 ? e1 : (r32 == 2 ? e2 : e3))) * inv;
            loc[u] = 0;
            if (r32 < 4) loc[u] = __hip_atomic_fetch_add((LAS int*)lcnt + my_e[u], 1, __ATOMIC_RELAXED, __HIP_MEMORY_SCOPE_WORKGROUP);
        }
        __syncthreads();
        if (tid < 32) { const int c = lcnt[tid]; int base = 0;
            if (c > 0) base = (int)__hip_atomic_fetch_add((unsigned*)(F.ctl + CW_CNT + 64 * tid), (unsigned)c, __ATOMIC_RELAXED, __HIP_MEMORY_SCOPE_AGENT);
            lbase[tid] = base; }
        __syncthreads();
        if (r32 < 4) {
#pragma unroll
            for (int u = 0; u < 2; ++u) { const int t = tb + 4 * w + 2 * hi + u; const int pos = lbase[my_e[u]] + loc[u];
                WSP(int, WS_ROUTE)[t * 4 + r32] = my_e[u]; WSP(float, WS_ROUTE + 256 * 1024)[t * 4 + r32] = my_g[u]; WSP(int, WS_ROUTE + 512 * 1024)[t * 4 + r32] = pos;
                WSP(int, WS_LIST)[my_e[u] * 16384 + pos] = t; }
        }
        __syncthreads();
    }
}
__device__ __forceinline__ void moe_table(Frame& F) {
    volatile LAS int* tab = (volatile LAS int*)(F.lds + TAB_OFF);
    if (F.tid < 64) {
        const int e = F.tid & 31;
        const unsigned c = __hip_atomic_load((unsigned*)(F.ctl + CW_CNT + 64 * e), __ATOMIC_RELAXED, __HIP_MEMORY_SCOPE_AGENT);
        const int tiles = (int)((c + 255u) >> 8); int inc = tiles;
#pragma unroll
        for (int o = 1; o < 32; o <<= 1) { const int up = __shfl_up(inc, o, 32); if (e >= o) inc += up; }
        if (F.tid < 32) { tab[e] = inc - tiles; tab[48 + e] = (int)c; if (e == 31) { tab[NE] = inc; tab[40] = inc; } }
    }
    __syncthreads();
}
__device__ __forceinline__ void p8_combine(Frame& F) {
    const int gw = F.vcu * NWAVES + F.wave, NGW = F.G * NWAVES, lane = F.lane;
    typedef int i32x4c __attribute__((ext_vector_type(4)));
    const GAS i32x4c* ridx = (const GAS i32x4c*)WSP(int, WS_ROUTE); const GAS i32x4c* rpos = (const GAS i32x4c*)WSP(int, WS_ROUTE + 512 * 1024); const GAS f32x4* rgate = (const GAS f32x4*)WSP(float, WS_ROUTE + 256 * 1024);
    const volatile LAS int* tab = (const volatile LAS int*)(F.lds + TAB_OFF);
    constexpr int TB = 4;
    for (int t0 = gw * TB; t0 < T; t0 += NGW * TB) {
        i32x4c sl[TB]; f32x4 gt[TB];
#pragma unroll
        for (int i = 0; i < TB; ++i) { const i32x4c e4 = ridx[t0 + i], p4 = rpos[t0 + i]; gt[i] = rgate[t0 + i];
#pragma unroll
            for (int k = 0; k < 4; ++k) sl[i][k] = tab[e4[k]] * 256 + p4[k]; }
        f32x4 v[TB][4]; unsigned y[TB][4][4];
#pragma unroll
        for (int i = 0; i < TB; ++i) { const GAS f32x4* xr = (const GAS f32x4*)(F.out + (size_t)(t0 + i) * D) + lane;
#pragma unroll
            for (int j = 0; j < 4; ++j) v[i][j] = xr[64 * j];
#pragma unroll
            for (int k = 0; k < 4; ++k) { const GAS unsigned* y4 = (const GAS unsigned*)(WSP(unsigned char, WS_Y) + (size_t)sl[i][k] * 1024) + lane;
#pragma unroll
                for (int j = 0; j < 4; ++j) y[i][k][j] = y4[64 * j]; } }
#pragma unroll
        for (int i = 0; i < TB; ++i) { GAS f32x4* xw = (GAS f32x4*)(F.out + (size_t)(t0 + i) * D) + lane;
#pragma unroll
            for (int k = 0; k < 4; ++k) { const float g = gt[i][k];
#pragma unroll
                for (int j = 0; j < 4; ++j) { const unsigned w = y[i][k][j]; const f32x2s lo = __builtin_amdgcn_cvt_pk_f32_fp8(w, false), hi = __builtin_amdgcn_cvt_pk_f32_fp8(w, true);
                    v[i][j].x += g * lo.x; v[i][j].y += g * lo.y; v[i][j].z += g * hi.x; v[i][j].w += g * hi.y; } }
#pragma unroll
            for (int j = 0; j < 4; ++j) xw[64 * j] = v[i][j]; }
    }
}

struct EpiGate {
    static constexpr bool PERM = true, AFTER_DRAIN = false, KEEP_ACC = true; static constexpr int NST = 0;
    const pg8::bf16_t* gates; pg8::bf16_t* sum;
    __device__ __forceinline__ bool keep_acc(const pg8::Unit& u) const { return (u.pn >> 2) < 2; }
    static __device__ __forceinline__ float expneg(float g) { return __builtin_amdgcn_exp2f(__builtin_amdgcn_fmed3f(-1.4426950408889634f * g, -86.f, 86.f)); }
    __device__ __forceinline__ void operator()(pg8::f32x4 (&acc)[2][2][4][2], const pg8::Unit& u, int wr, int wc, int fr, int fq) const {
        const int br = u.pn >> 2, col0 = (u.pn & 3) * pg8::BM + wc * 32 + 8 * fq, row0 = (u.pm & 63) * pg8::BM + wr * 64 + fr;
        const pg8::bf16_t* gp = gates + br * 1024 + (size_t)row0 * INW + col0;
        if (br < 2) {
#pragma unroll
            for (int ai = 0; ai < 2; ++ai)
#pragma unroll
                for (int m = 0; m < 4; ++m) { const size_t r = (size_t)(ai * pg8::HALF + m * 16);
#pragma unroll
                    for (int bj = 0; bj < 2; ++bj) {
                        const pg8::u32x4 ga = *(const pg8::u32x4*)(gp + r * INW + bj * pg8::HALF), gb = *(const pg8::u32x4*)(gp + 1024 + r * INW + bj * pg8::HALF);
                        const float av[8] = {bflo(ga.x), bfhi(ga.x), bflo(ga.y), bfhi(ga.y), bflo(ga.z), bfhi(ga.z), bflo(ga.w), bfhi(ga.w)};
                        const float bv[8] = {bflo(gb.x), bfhi(gb.x), bflo(gb.y), bfhi(gb.y), bflo(gb.z), bfhi(gb.z), bflo(gb.w), bfhi(gb.w)};
#pragma unroll
                        for (int i = 0; i < 8; ++i) acc[ai][bj][m][i >> 2][i & 3] *= (1.f + expneg(bv[i])) * __builtin_amdgcn_rcpf(1.f + expneg(av[i])); }
                    if (m & 1) asm volatile("" ::: "memory"); }
        } else {
            pg8::bf16_t* sp = sum + (size_t)row0 * 1024 + col0;
#pragma unroll
            for (int ai = 0; ai < 2; ++ai)
#pragma unroll
                for (int m = 0; m < 4; ++m) { const size_t r = (size_t)(ai * pg8::HALF + m * 16);
#pragma unroll
                    for (int bj = 0; bj < 2; ++bj) {
                        const pg8::u32x4 ga = *(const pg8::u32x4*)(gp + r * INW + bj * pg8::HALF);
                        const float av[8] = {bflo(ga.x), bfhi(ga.x), bflo(ga.y), bfhi(ga.y), bflo(ga.z), bfhi(ga.z), bflo(ga.w), bfhi(ga.w)};
                        float o[8];
#pragma unroll
                        for (int i = 0; i < 8; ++i) o[i] = acc[ai][bj][m][i >> 2][i & 3] * __builtin_amdgcn_rcpf(1.f + expneg(av[i]));
                        pg8::u32x4 w; w.x = pg8::cvt_pk_bf16(o[0], o[1]); w.y = pg8::cvt_pk_bf16(o[2], o[3]); w.z = pg8::cvt_pk_bf16(o[4], o[5]); w.w = pg8::cvt_pk_bf16(o[6], o[7]);
                        *(pg8::u32x4*)(sp + r * 1024 + bj * pg8::HALF) = w; }
                    if (m & 1) asm volatile("" ::: "memory"); }
        }
    }
};
struct BranchOrder {
    pg8::StaticOrder so;
    __device__ __forceinline__ bool next(int i, pg8::Unit& u) const {
        pg8::Unit tu; const int tile = i / 3, br = i - 3 * tile; if (!so.next(tile, tu)) return false;
        u.pm = br * (T / 256) + tu.pm; u.pn = br * 4 + tu.pn; return true;
    }
    __device__ __forceinline__ void a_ready(const pg8::Unit&) const {}
    __device__ __forceinline__ void done(const pg8::Unit&) const {}
};
struct EpiResF32 {
    static constexpr bool PERM = false, AFTER_DRAIN = false, KEEP_ACC = false; static constexpr int NST = 32;
    const float* base; float* out; int ldc; float* ssq;
    __device__ __forceinline__ void operator()(const pg8::f32x4 (&acc)[2][2][4][2], const pg8::Unit& u, int wr, int wc, int fr, int fq) const {
        const int col0 = u.pn * pg8::BM + wc * 32 + 4 * fq;
#pragma unroll
        for (int ai = 0; ai < 2; ++ai)
#pragma unroll
            for (int m = 0; m < 4; ++m) { const int row = u.pm * pg8::BM + ai * pg8::HALF + wr * 64 + m * 16 + fr; const size_t off = (size_t)row * ldc + col0; float sq = 0.f;
#pragma unroll
                for (int bj = 0; bj < 2; ++bj)
#pragma unroll
                    for (int n = 0; n < 2; ++n) { const pg8::f32x4 bs = *(const pg8::f32x4*)(base + off + bj * pg8::HALF + n * 16); const pg8::f32x4 o = bs + acc[ai][bj][m][n];
                        *(pg8::f32x4*)(out + off + bj * pg8::HALF + n * 16) = o; sq += (o[0] * o[0] + o[1] * o[1]) + (o[2] * o[2] + o[3] * o[3]); }
                sq += __shfl_xor(sq, 16); sq += __shfl_xor(sq, 32);
                if (fq == 0) ssq[row * 16 + u.pn * 4 + wc] = sq;
                asm volatile("" ::: "memory"); }
    }
};
struct EpiSwiglu {
    static constexpr bool PERM = true, AFTER_DRAIN = false; static constexpr int NST = 4;
    unsigned char* O; const float* bias;
    __device__ __forceinline__ void operator()(const pg8::f32x4 (&acc)[2][2][4][2], const pg8::Unit& u, int wr, int wc, int fr, int fq) const {
        const int e = u.pn >> 3, pl = u.pn & 7, f0 = pl * 128 + wc * 32 + 8 * fq, row0 = u.pm * pg8::BM + wr * 64 + fr, par = fq & 1;
        const float* bg = bias + e * 2048 + f0;
        pg8::f32x4 bgv[2], blv[2];
#pragma unroll
        for (int n = 0; n < 2; ++n) { bgv[n] = *(const pg8::f32x4*)(bg + 4 * n); blv[n] = *(const pg8::f32x4*)(bg + 1024 + 4 * n); }
#pragma unroll
        for (int ai = 0; ai < 2; ++ai)
#pragma unroll
            for (int mp = 0; mp < 2; ++mp) { u32x2s w[2];
#pragma unroll
                for (int mm = 0; mm < 2; ++mm) { const int m = 2 * mp + mm; float a[8];
#pragma unroll
                    for (int n = 0; n < 2; ++n) { const pg8::f32x4 g4 = acc[ai][0][m][n] + bgv[n], l4 = acc[ai][1][m][n] + blv[n];
#pragma unroll
                        for (int j = 0; j < 4; ++j) { const float g = fminf(g4[j], 7.f), l = fminf(fmaxf(l4[j], -7.f), 7.f); a[4 * n + j] = g * (l + 1.f) * __builtin_amdgcn_rcpf(1.f + __builtin_amdgcn_exp2f(-1.702f * 1.4426950408889634f * g)); } }
                    w[mm].x = pk4_fp8(a[0], a[1], a[2], a[3]); w[mm].y = pk4_fp8(a[4], a[5], a[6], a[7]); }
                const auto sx = __builtin_amdgcn_permlane16_swap(w[0].x, w[1].x, false, false), sy = __builtin_amdgcn_permlane16_swap(w[0].y, w[1].y, false, false);
                u32x4s o; o.x = sx[0]; o.y = sy[0]; o.z = sx[1]; o.w = sy[1];
                *(u32x4s*)(O + (size_t)(row0 + ai * pg8::HALF + (2 * mp + par) * 16) * 1024 + f0 - 8 * par) = o; }
    }
};
struct EpiF8Bias {
    static constexpr bool PERM = true, AFTER_DRAIN = false; static constexpr int NST = 8;
    unsigned char* O; int ldc; const float* bias; int split_cols;
    __device__ __forceinline__ void operator()(const pg8::f32x4 (&acc)[2][2][4][2], const pg8::Unit& u, int wr, int wc, int fr, int fq) const {
        const int row0 = u.pm * pg8::BM + wr * 64 + fr, par = fq & 1; int colt = u.pn * pg8::BM; colt -= (colt / split_cols) * split_cols;
        const int col0 = colt + wc * 32 + 8 * fq, bcol0 = u.pn * pg8::BM + wc * 32 + 8 * fq;
        pg8::f32x4 bv[2][2];
#pragma unroll
        for (int bj = 0; bj < 2; ++bj)
#pragma unroll
            for (int n = 0; n < 2; ++n) bv[bj][n] = *(const pg8::f32x4*)(bias + bcol0 + bj * pg8::HALF + 4 * n);
#pragma unroll
        for (int ai = 0; ai < 2; ++ai)
#pragma unroll
            for (int mp = 0; mp < 2; ++mp)
#pragma unroll
                for (int bj = 0; bj < 2; ++bj) { u32x2s w[2];
#pragma unroll
                    for (int mm = 0; mm < 2; ++mm) { const pg8::f32x4 v0 = acc[ai][bj][2 * mp + mm][0] + bv[bj][0], v1 = acc[ai][bj][2 * mp + mm][1] + bv[bj][1];
                        w[mm].x = pk4_fp8(v0[0], v0[1], v0[2], v0[3]); w[mm].y = pk4_fp8(v1[0], v1[1], v1[2], v1[3]); }
                    const auto sx = __builtin_amdgcn_permlane16_swap(w[0].x, w[1].x, false, false), sy = __builtin_amdgcn_permlane16_swap(w[0].y, w[1].y, false, false);
                    u32x4s o; o.x = sx[0]; o.y = sy[0]; o.z = sx[1]; o.w = sy[1];
                    *(u32x4s*)(O + (size_t)(row0 + ai * pg8::HALF + (2 * mp + par) * 16) * ldc + col0 - 8 * par + bj * pg8::HALF) = o; }
    }
};
struct EpiBf16L {
    static constexpr bool PERM = true, AFTER_DRAIN = false, KEEP_ACC = false; static constexpr int NST = 16;
    pg8::bf16_t* O; int ldc; const float* qg; const float* kg;
    __device__ __forceinline__ void operator()(const pg8::f32x4 (&acc)[2][2][4][2], const pg8::Unit& u, int wr, int wc, int fr, int fq) const {
        pg8::bf16_t* p = O + (size_t)(u.pm * pg8::BM + wr * 64 + fr) * ldc + u.pn * pg8::BM + wc * 64 + 8 * fq;
        if (qg != nullptr && u.pn < 4) {
            const bool isq = u.pn < 2;
            pg8::f32x4 gn[2][2];
#pragma unroll
            for (int bj = 0; bj < 2; ++bj)
#pragma unroll
                for (int n = 0; n < 2; ++n) { gn[bj][n] = (pg8::f32x4){1.f, 1.f, 1.f, 1.f};
                    if (isq) gn[bj][n] = *(const pg8::f32x4*)(qg + 32 * bj + 8 * fq + 4 * n) * *(const pg8::f32x4*)(kg + 32 * bj + 8 * fq + 4 * n); }
            const float post = isq ? 0.125f * 1.4426950408889634f : 1.f;
#pragma unroll
            for (int ai = 0; ai < 2; ++ai)
#pragma unroll
                for (int m = 0; m < 4; ++m) { pg8::bf16_t* rowp = p + (size_t)(ai * pg8::HALF + m * 16) * ldc; float ss = 0.f;
#pragma unroll
                    for (int bj = 0; bj < 2; ++bj)
#pragma unroll
                        for (int n = 0; n < 2; ++n) { const pg8::f32x4 v = acc[ai][bj][m][n]; ss += (v[0] * v[0] + v[1] * v[1]) + (v[2] * v[2] + v[3] * v[3]); }
                    ss += __shfl_xor(ss, 16); ss += __shfl_xor(ss, 32);
                    const float r = post * __builtin_amdgcn_rsqf(ss * (1.f / 64.f) + RMS_EPS);
#pragma unroll
                    for (int bj = 0; bj < 2; ++bj) { const pg8::f32x4 v0 = acc[ai][bj][m][0] * gn[bj][0] * r, v1 = acc[ai][bj][m][1] * gn[bj][1] * r;
                        pg8::u32x4 w; w.x = pg8::cvt_pk_bf16(v0[0], v0[1]); w.y = pg8::cvt_pk_bf16(v0[2], v0[3]); w.z = pg8::cvt_pk_bf16(v1[0], v1[1]); w.w = pg8::cvt_pk_bf16(v1[2], v1[3]);
                        *(pg8::u32x4*)(rowp + bj * 32) = w; } }
            return;
        }
#pragma unroll
        for (int ai = 0; ai < 2; ++ai)
#pragma unroll
            for (int m = 0; m < 4; ++m) { pg8::bf16_t* rowp = p + (size_t)(ai * pg8::HALF + m * 16) * ldc;
#pragma unroll
                for (int bj = 0; bj < 2; ++bj) { const pg8::f32x4 v0 = acc[ai][bj][m][0], v1 = acc[ai][bj][m][1];
                    pg8::u32x4 w; w.x = pg8::cvt_pk_bf16(v0[0], v0[1]); w.y = pg8::cvt_pk_bf16(v0[2], v0[3]); w.z = pg8::cvt_pk_bf16(v1[0], v1[1]); w.w = pg8::cvt_pk_bf16(v1[2], v1[3]);
                    *(pg8::u32x4*)(rowp + bj * 32) = w; } }
    }
};
struct PartOrder {
    pg8::StaticOrder so; int f8;
    __device__ __forceinline__ bool next(int i, pg8::Unit& u) const {
        pg8::StaticOrder s2 = so; int ii = i;
        if (f8 && so.G == 192) { if (so.c >= 128 && so.c < 144 && i >= 3) return false; if (so.c >= 144 && so.c < 160 && i == 4) { ii = 3; s2.c = so.c - 16; } }
        pg8::Unit tu; if (!s2.next(ii, tu)) return false;
        u.pm = tu.pm; u.pn = f8 ? tu.pn + 14 : tu.pn; return true;
    }
    __device__ __forceinline__ void a_ready(const pg8::Unit&) const {}
    __device__ __forceinline__ void done(const pg8::Unit&) const {}
};
struct MoeOrder {
    const volatile LAS int* tab; int nN, ntiles, G, c; const int* list;
    __device__ __forceinline__ bool next(int i, pg8::Unit& u) const {
        const long L = (long)i * G + c; const int nwg = ntiles * nN; if (L >= (long)nwg) return false;
        int wgid = (int)L; { const int q = nwg / 8, r = nwg % 8, xcd = wgid % 8, off = wgid / 8; wgid = (xcd < r ? xcd * (q + 1) : r * (q + 1) + (xcd - r) * q) + off; }
        const int nig = 8 * nN, gid = wgid / nig, fm = gid * 8, gsz = (ntiles - fm) < 8 ? (ntiles - fm) : 8;
        const int pm = fm + ((wgid % nig) % gsz), pl = (wgid % nig) / gsz;
        const int lj = (int)(threadIdx.x & 63); const int tv = tab[lj & 31];
        const int e = (int)__popcll(__ballot(lj >= 1 && lj < NE && tv <= pm));
        u.pm = __builtin_amdgcn_readfirstlane(pm); u.pn = __builtin_amdgcn_readfirstlane(e * nN + pl); return true;
    }
    __device__ __forceinline__ const int* rows_list(const pg8::Unit& u) const { const int e = u.pn / nN; return list + __builtin_amdgcn_readfirstlane(e * 16384 + (u.pm - tab[e]) * 256); }
    __device__ __forceinline__ int nrows(const pg8::Unit& u) const { const int e = u.pn / nN; return __builtin_amdgcn_readfirstlane(tab[48 + e] - (u.pm - tab[e]) * 256); }
    __device__ __forceinline__ void a_ready(const pg8::Unit&) const {}
    __device__ __forceinline__ void done(const pg8::Unit&) const {}
};

struct Args { const float* in[22]; float* out; unsigned char* ws; int ph_lo, ph_hi; };
__global__ void __launch_bounds__(NWAVES * 64, 2) fwd_kernel(Args args) {
    extern __shared__ __attribute__((aligned(16))) unsigned char lds[];
    Frame F;
    F.lds = (LAS unsigned char*)lds;
    F.MISC = (volatile LAS unsigned*)(F.lds + MISC_OFF);
    F.tid = threadIdx.x; F.lane = F.tid & 63; F.wave = __builtin_amdgcn_readfirstlane(F.tid >> 6);
    F.G = gridDim.x; { const int bx = blockIdx.x; F.vcu = (F.G % 8 == 0) ? (bx % 8) * (F.G / 8) + bx / 8 : bx; }
    F.ws = args.ws; F.out = args.out; F.ctl = (gu32*)(F.ws + WS_CTL);
    for (int u = F.tid; u < (LDS_BYTES - LDSCTL_OFF) / 4; u += NWAVES * 64) ((LAS unsigned*)(F.lds + LDSCTL_OFF))[u] = 0u;
    __syncthreads();
    XcdBarrier bar = xcd_barrier_post((unsigned*)(F.ctl + CW_BAR), F.MISC + 8);
    const int lo = args.ph_lo, hi = args.ph_hi;
#ifndef REPMASK
#define REPMASK 0
#endif
#define IN(k) (lo <= (k) && (k) < hi)
#define NREP(k) (((REPMASK >> (k)) & 1) ? 2 : 1)
#define GRID_BAR() xcd_barrier(bar)

    const bool split = (F.G == 256);
    const int g1 = split ? G_PROJ : F.G;
    constexpr int CI_LATE = 3 * CI_BR + CI_O;
    if (IN(0)) { if (split) p0_prologue(F, CI_SMALL - CI_LATE + CI_D_P0, CI_SMALL - CI_LATE, CI_LATE); else p0_prologue(F, CI_ALL, 0x7fffffff, 0); GRID_BAR(); }
    if (IN(1)) {
        const bool gemm_role = (int)blockIdx.x < g1;
        if (gemm_role) {
            { pg8::Gemm g{WSP(bf16, WS_XN), WSP(bf16, WS_WIN), T, INW, D}; PartOrder S; S.so.init(T, 14 * 256, g1, (int)blockIdx.x); S.f8 = 0;
              EpiBf16L E{WSP(bf16, WS_PROJ), INW, in_ptr(I_SBQG), in_ptr(I_SBKG)};
              pg8::gemm_phase<EpiBf16L, PartOrder, true, true>(F.lds + RING_OFF, g, S, E); }
            { pg8::Gemm8 g{WSP(unsigned char, WS_XN8), WSP(unsigned char, WS_WIN8), T, INW, D}; PartOrder S; S.so.init(T, 12 * 256, g1, (int)blockIdx.x); S.f8 = 1;
              EpiBf16L E{WSP(bf16, WS_PROJ), INW, nullptr, nullptr};
              pg8::gemm_phase_f8<EpiBf16L, PartOrder, true, true>(F.lds + RING_OFF, g, S, E); } }
        if (!split || ((int)blockIdx.x >= 128 && (int)blockIdx.x < 144)) {
            pg8::Gemm g{WSP(bf16, WS_MEMN), WSP(bf16, WS_WKV), MROWS, 1024, D}; pg8::StaticOrder S; S.init(MROWS, 1024, split ? 16 : F.G, split ? (int)blockIdx.x - 128 : (int)blockIdx.x);
            EpiBf16L E{WSP(bf16, WS_KV), 1024, nullptr, nullptr};
            pg8::gemm_phase<EpiBf16L, pg8::StaticOrder, true, true>(F.lds + RING_OFF, g, S, E); }
        if (!gemm_role) conv_items(F, CI_SMALL + CI_D, CI_ALL, ((int)blockIdx.x - g1) * NWAVES + F.wave, (F.G - g1) * NWAVES, nullptr);
        else if (split && g1 == 192 && (int)blockIdx.x >= 160) conv_items(F, CI_SMALL - CI_LATE, CI_SMALL, ((int)blockIdx.x - 160) * NWAVES + F.wave, 32 * NWAVES, nullptr);
        GRID_BAR();
    }
    if (IN(3)) { _Pragma("unroll 1") for (int rep = 0; rep < NREP(3); ++rep) { p2_mixers(F); GRID_BAR(); } }
    if (IN(4)) _Pragma("unroll 1") for (int rep = 0; rep < NREP(4); ++rep) {
        pg8::Gemm g{WSP(bf16, WS_OBR), WSP(bf16, WS_WBR), 3 * T, 3 * 1024, 512}; BranchOrder S; S.so.init(T, D, F.G, (int)blockIdx.x);
        EpiGate E{WSP(bf16, WS_PROJ) + C_G, WSP(bf16, WS_MERGED)};
        pg8::gemm_phase<EpiGate, BranchOrder, true, true>(F.lds + RING_OFF, g, S, E);
        GRID_BAR();
    }
    if (IN(6)) _Pragma("unroll 1") for (int rep = 0; rep < NREP(6); ++rep) {
        pg8::Gemm g{WSP(bf16, WS_MERGED), WSP(bf16, WS_WO), T, D, D}; pg8::StaticOrder S; S.init(T, D, F.G, (int)blockIdx.x);
        EpiResF32 E{in_ptr(I_X), F.out, D, WSP(float, WS_SSQ)};
        pg8::gemm_phase<EpiResF32, pg8::StaticOrder, true, true>(F.lds + RING_OFF, g, S, E);
        GRID_BAR();
    }
    if (IN(7)) { p5_route(F); GRID_BAR(); }
    if (IN(9)) _Pragma("unroll 1") for (int rep = 0; rep < NREP(9); ++rep) {
        moe_table(F);
        const volatile LAS int* tab = (const volatile LAS int*)(F.lds + TAB_OFF);
        const int g9 = split ? G_GU : F.G;
        const int rem9 = split ? (__builtin_amdgcn_readfirstlane(tab[40]) * 8) % g9 : 0, nlight = rem9 ? g9 - rem9 : 0, ci_tail = nlight * NWAVES * 4;
        if ((int)blockIdx.x < g9) {
        pg8::Gemm8 g{WSP(unsigned char, WS_HF8), WSP(unsigned char, WS_WGU), T, NE * 2048, D}; MoeOrder S{tab, 8, __builtin_amdgcn_readfirstlane(tab[40]), g9, (int)blockIdx.x, WSP(int, WS_LIST)};
        EpiSwiglu E{WSP(unsigned char, WS_ACT), in_ptr(I_BGU)};
        pg8::gemm_phase_f8g<EpiSwiglu, MoeOrder, true, true>(F.lds + RING_OFF, (LAS int*)(F.lds + TAB_OFF + 2048), g, S, E);
        if (ci_tail && (int)blockIdx.x >= rem9) conv_items(F, CI_SMALL + CI_D - ci_tail, CI_SMALL + CI_D, ((int)blockIdx.x - rem9) * NWAVES + F.wave, nlight * NWAVES, nullptr);
        } else conv_items(F, CI_SMALL + CI_D_P0, CI_SMALL + CI_D - ci_tail, ((int)blockIdx.x - g9) * NWAVES + F.wave, (F.G - g9) * NWAVES, nullptr);
        GRID_BAR();
    }
    if (IN(10)) _Pragma("unroll 1") for (int rep = 0; rep < NREP(10); ++rep) {
        if (!IN(9)) moe_table(F);
        const volatile LAS int* tab = (const volatile LAS int*)(F.lds + TAB_OFF);
        pg8::Gemm8 g{WSP(unsigned char, WS_ACT), WSP(unsigned char, WS_WD), SLOTROWS, NE * 1024, FF}; MoeOrder S{tab, 4, __builtin_amdgcn_readfirstlane(tab[40]), F.G, (int)blockIdx.x, nullptr};
        EpiF8Bias E{WSP(unsigned char, WS_Y), D, in_ptr(I_BD), 1024};
        pg8::gemm_phase_f8<EpiF8Bias, MoeOrder, true, true>(F.lds + RING_OFF, g, S, E);
        GRID_BAR();
    }
    if (IN(11)) { p8_combine(F); }
#undef IN
#undef GRID_BAR
}

extern "C" void kernel_launch(void* const* d_in, const int* in_sizes, int n_in, void* d_out, int out_size, void* d_ws, size_t ws_size, hipStream_t stream) {
    static int grid = 0;
    if (grid == 0) {
        if (n_in != 22 || out_size != T * D || ws_size < WS_END) { fprintf(stderr, "kernel_launch: unexpected problem (n_in %d, out %d, ws %zu)\n", n_in, out_size, ws_size); grid = -1; return; }
        int dev = 0, cus = 0, per_cu = 0;
        if (hipGetDevice(&dev) != hipSuccess || hipDeviceGetAttribute(&cus, hipDeviceAttributeMultiprocessorCount, dev) != hipSuccess) { grid = -1; return; }
        if (hipFuncSetAttribute((const void*)fwd_kernel, hipFuncAttributeMaxDynamicSharedMemorySize, LDS_BYTES) != hipSuccess) { fprintf(stderr, "kernel_launch: hipFuncSetAttribute failed\n"); grid = -1; return; }
        if (hipOccupancyMaxActiveBlocksPerMultiprocessor(&per_cu, (const void*)fwd_kernel, NWAVES * 64, LDS_BYTES) != hipSuccess || per_cu < 1) { fprintf(stderr, "kernel_launch: occupancy query says %d\n", per_cu); (void)hipGetLastError(); grid = -1; return; }
        grid = cus;
    }
    if (grid < 0) return;
    if (hipMemsetAsync((char*)d_ws + WS_CTL, 0, CTL_ZERO_BYTES, stream) != hipSuccess) { fprintf(stderr, "kernel_launch: memset failed\n"); return; }
    Args a{};
    for (int i = 0; i < 22; ++i) a.in[i] = (const float*)d_in[i];
    a.out = (float*)d_out; a.ws = (unsigned char*)d_ws; a.ph_lo = 0; a.ph_hi = 12;
    void* kargs[] = {&a};
    const hipError_t le = hipLaunchCooperativeKernel((const void*)fwd_kernel, dim3(grid), dim3(NWAVES * 64), kargs, LDS_BYTES, stream);
    if (le != hipSuccess) fprintf(stderr, "kernel_launch: launch failed: %s (grid %d)\n", hipGetErrorName(le), grid);
}
```
